# Optimizing an MI355X kernel written in HIP

```python
import math
import jax
import jax.numpy as jnp
from jax import lax
import numpy as np

D_MODEL = 1024
BATCH = 8
SEQ = 2048
DEPTH = 2
DEC_BATCH = 128
DEC_SEQ = 1
PAST_LEN = 16384
PAGE_SIZE = 128

N_EVEN = (DEPTH + 1) // 2
N_ODD = DEPTH // 2
EXPAND = 2
W_MIX = EXPAND * D_MODEL
H_A = 8
DK_A = 128
DV_A = 128
CONV_W = 4
CONV_CH_A = H_A * (2 * DK_A + DV_A)
CHUNK_A = 64
H_B = 8
DK_B = 64
DV_B = 128
CHUNK_B = 64
H_C = 4
DK_C = 128
DV_C = 256
GLA_RANK = 16
GLA_TAU = 16.0
CHUNK_C = 16
H_D = 4
DK_D = 128
DV_D = 256
CHUNK_D = 64
ROPE_BASE = 10000.0
EPS = 1e-6

EVEN_SPLIT = [CONV_CH_A, H_A, H_A, H_B * DK_B, H_B * DK_B, H_B * DV_B, 2 * H_B, H_B * DV_B, W_MIX]
ODD_SPLIT = [H_C * DK_C, H_C * DK_C, H_C * DV_C, GLA_RANK, H_D * DK_D, H_D * DK_D, H_D * DV_D, W_MIX]
P_EVEN = sum(EVEN_SPLIT)
P_ODD = sum(ODD_SPLIT)

kernel_name = 'hybrid_gdn_mlstm_gla_retnet_step'


def _split(x, sizes):
    idx = [int(i) for i in np.cumsum(sizes)[:-1]]
    return jnp.split(x, idx, axis=-1)


def _rms(x, w):
    xf = x.astype(jnp.float32)
    y = xf * lax.rsqrt(jnp.mean(xf * xf, axis=-1, keepdims=True) + EPS)
    return (y * w.astype(jnp.float32)).astype(x.dtype)


def _l2n(x):
    return x * lax.rsqrt(jnp.sum(x * x, axis=-1, keepdims=True) + EPS)


def _to_chunks(x, L):
    B, T = x.shape[:2]
    return jnp.moveaxis(x.reshape((B, T // L, L) + x.shape[2:]), 1, 0)


def _from_chunks(y):
    y = jnp.moveaxis(y, 0, 1)
    return y.reshape((y.shape[0], y.shape[1] * y.shape[2]) + y.shape[3:])


def _causal_conv(u, buf, w):
    T = u.shape[1]
    full = jnp.concatenate([buf, u], axis=1)
    y = full[:, 0:T] * w[0]
    for j in range(1, CONV_W):
        y = y + full[:, j:j + T] * w[j]
    return y, full[:, T:]


def _rotary(x, pos):
    half = x.shape[-1] // 2
    inv = ROPE_BASE ** (-jnp.arange(half, dtype=jnp.float32) / half)
    ang = pos.astype(jnp.float32)[:, None] * inv[None, :]
    cos = jnp.cos(ang)[:, None, :]
    sin = jnp.sin(ang)[:, None, :]
    x1, x2 = x[..., :half], x[..., half:]
    return jnp.concatenate([x1 * cos - x2 * sin, x1 * sin + x2 * cos], axis=-1)


def _gated_delta(q, k, v, beta, g, S0):
    L = math.gcd(q.shape[1], CHUNK_A)
    tri_incl = jnp.tril(jnp.ones((L, L), bool))
    tri_strict = jnp.tril(jnp.ones((L, L), bool), -1)
    eye = jnp.eye(L, dtype=jnp.float32)

    def step(S, inp):
        qc, kc, vc, bc, gc = inp
        bh = jnp.moveaxis(jnp.cumsum(gc, axis=1), 1, 2)
        decay = jnp.exp(jnp.where(tri_incl, bh[..., :, None] - bh[..., None, :], -jnp.inf))
        beta_h = jnp.moveaxis(bc, 1, 2)
        kk = jnp.einsum('bthd,bshd->bhts', kc, kc)
        A = jnp.where(tri_strict, decay * kk, 0.0) * beta_h[..., :, None]
        gam = jnp.exp(bh)[..., None]
        rhs = beta_h[..., None] * (jnp.moveaxis(vc, 1, 2) - gam * jnp.einsum('bthd,bhde->bhte', kc, S))
        U = lax.linalg.triangular_solve(A + eye, rhs, left_side=True, lower=True, unit_diagonal=True)
        qk = jnp.einsum('bthd,bshd->bhts', qc, kc) * decay
        o = gam * jnp.einsum('bthd,bhde->bhte', qc, S) + jnp.einsum('bhts,bhse->bhte', qk, U)
        last = bh[..., -1:]
        S_new = jnp.exp(last)[..., None] * S + jnp.einsum('bshd,bhs,bhse->bhde', kc, jnp.exp(last - bh), U)
        return S_new, jnp.moveaxis(o, 1, 2)

    S, o = lax.scan(step, S0, tuple(_to_chunks(a, L) for a in (q, k, v, beta, g)))
    return _from_chunks(o), S


def _mlstm(q, k, v, ig, fg, C0, n0, m0):
    L = math.gcd(q.shape[1], CHUNK_B)
    tri = jnp.tril(jnp.ones((L, L), bool))

    def step(carry, inp):
        C, n, m = carry
        qc, kc, vc, ic, fc = inp
        b = jnp.moveaxis(jnp.cumsum(jax.nn.log_sigmoid(fc), axis=1), 1, 2)
        ih = jnp.moveaxis(ic, 1, 2)
        D = jnp.where(tri, b[..., :, None] - b[..., None, :] + ih[..., None, :], -jnp.inf)
        w0 = b + m[..., None]
        m_t = jnp.maximum(w0, jnp.max(D, axis=-1))
        P = jnp.exp(D - m_t[..., None]) * jnp.einsum('bthd,bshd->bhts', qc, kc)
        s0 = jnp.exp(w0 - m_t)
        num = s0[..., None] * jnp.einsum('bthd,bhde->bhte', qc, C) + jnp.einsum('bhts,bshe->bhte', P, vc)
        den = s0 * jnp.einsum('bthd,bhd->bht', qc, n) + jnp.sum(P, axis=-1)
        h = num / jnp.maximum(jnp.abs(den), jnp.exp(-m_t))[..., None]
        m_end = m_t[..., -1]
        we = jnp.exp(b[..., -1:] - b + ih - m_end[..., None])
        se = jnp.exp(b[..., -1] + m - m_end)
        C_new = se[..., None, None] * C + jnp.einsum('bshd,bhs,bshe->bhde', kc, we, vc)
        n_new = se[..., None] * n + jnp.einsum('bshd,bhs->bhd', kc, we)
        return (C_new, n_new, m_end), jnp.moveaxis(h, 1, 2)

    (C, n, m), h = lax.scan(step, (C0, n0, m0), tuple(_to_chunks(a, L) for a in (q, k, v, ig, fg)))
    return _from_chunks(h), C, n, m


def _gla(q, k, v, g, S0):
    L = math.gcd(q.shape[1], CHUNK_C)
    tri = jnp.tril(jnp.ones((L, L), bool))[None, :, :, None, None]

    def step(S, inp):
        qc, kc, vc, gc = inp
        b = jnp.cumsum(gc, axis=1)
        dec = jnp.exp(jnp.where(tri, b[:, :, None] - b[:, None, :], -jnp.inf))
        att = jnp.sum(qc[:, :, None] * kc[:, None] * dec, axis=-1)
        o = jnp.einsum('bthd,bhde->bthe', qc * jnp.exp(b), S) + jnp.einsum('btsh,bshe->bthe', att, vc)
        bl = b[:, -1]
        S_new = jnp.exp(bl)[..., None] * S + jnp.einsum('bshd,bshe->bhde', kc * jnp.exp(bl[:, None] - b), vc)
        return S_new, o

    S, o = lax.scan(step, S0, tuple(_to_chunks(a, L) for a in (q, k, v, g)))
    return _from_chunks(o), S


def _retention(q, k, v, S0):
    L = math.gcd(q.shape[1], CHUNK_D)
    lg = jnp.log(1.0 - 2.0 ** (-5.0 - jnp.arange(H_D, dtype=jnp.float32)))
    idx = jnp.arange(L, dtype=jnp.float32)
    rel = idx[:, None] - idx[None, :]
    Dm = jnp.where(rel >= 0, jnp.exp(lg[:, None, None] * jnp.maximum(rel, 0.0)), 0.0)
    inner = jnp.exp(lg[None, :] * (idx[:, None] + 1.0))
    end = jnp.exp(lg[None, :] * (L - 1.0 - idx[:, None]))
    gL = jnp.exp(lg * L)

    def step(S, inp):
        qc, kc, vc = inp
        att = jnp.einsum('bthd,bshd->bhts', qc, kc) * Dm
        o = jnp.einsum('bthd,bhde->bthe', qc, S) * inner[None, :, :, None] + jnp.einsum('bhts,bshe->bthe', att, vc)
        S_new = gL[:, None, None] * S + jnp.einsum('bshd,bshe->bhde', kc * end[None, :, :, None], vc)
        return S_new, o

    S, o = lax.scan(step, S0, tuple(_to_chunks(a, L) for a in (q, k, v)))
    return _from_chunks(o), S


def _even_mixer(h, s_gdn, s_conv, s_mc, s_mn, s_mm, w_in, w_out, conv_w, a_log, dt_bias,
                gdn_norm_w, gate_b, mlstm_norm_w):
    B, T, _ = h.shape
    f32 = jnp.float32
    proj = (h @ w_in).astype(f32)
    u_a, beta_pre, a_pre, q_b, k_b, v_b, if_pre, o_pre, z = _split(proj, EVEN_SPLIT)
    u_conv, new_conv = _causal_conv(u_a, s_conv.astype(f32), conv_w.astype(f32))
    q_a, k_a, v_a = _split(jax.nn.silu(u_conv), [H_A * DK_A, H_A * DK_A, H_A * DV_A])
    q_a = _l2n(q_a.reshape(B, T, H_A, DK_A)) * (DK_A ** -0.5)
    k_a = _l2n(k_a.reshape(B, T, H_A, DK_A))
    v_a = v_a.reshape(B, T, H_A, DV_A)
    beta = jax.nn.sigmoid(beta_pre)
    g_a = -jnp.exp(a_log.astype(f32)) * jax.nn.softplus(a_pre + dt_bias.astype(f32))
    o_a, new_gdn = _gated_delta(q_a, k_a, v_a, beta, g_a, s_gdn.astype(f32))
    o_a = _rms(o_a, gdn_norm_w).reshape(B, T, H_A * DV_A)
    if_pre = if_pre + gate_b.astype(f32)
    q_b = q_b.reshape(B, T, H_B, DK_B)
    k_b = k_b.reshape(B, T, H_B, DK_B) * (DK_B ** -0.5)
    v_b = v_b.reshape(B, T, H_B, DV_B)
    h_b, new_mc, new_mn, new_mm = _mlstm(q_b, k_b, v_b, if_pre[..., :H_B], if_pre[..., H_B:],
                                         s_mc.astype(f32), s_mn.astype(f32), s_mm.astype(f32))
    h_b = jax.nn.sigmoid(o_pre) * _rms(h_b, mlstm_norm_w).reshape(B, T, H_B * DV_B)
    y = jnp.concatenate([o_a, h_b], axis=-1) * jax.nn.silu(z)
    return y.astype(h.dtype) @ w_out, new_gdn, new_conv, new_mc, new_mn, new_mm


def _odd_mixer(h, pos, s_gla, s_ret, w_in, w_out, gla_w2, gla_b2, gla_norm_w, ret_norm_w):
    B, T, _ = h.shape
    f32 = jnp.float32
    proj = (h @ w_in).astype(f32)
    q_c, k_c, v_c, g_lr, q_d, k_d, v_d, z = _split(proj, ODD_SPLIT)
    g_c = jax.nn.log_sigmoid(g_lr @ gla_w2.astype(f32) + gla_b2.astype(f32)) / GLA_TAU
    o_c, new_gla = _gla(q_c.reshape(B, T, H_C, DK_C) * (DK_C ** -0.5), k_c.reshape(B, T, H_C, DK_C),
                        v_c.reshape(B, T, H_C, DV_C), g_c.reshape(B, T, H_C, DK_C), s_gla.astype(f32))
    o_c = _rms(o_c, gla_norm_w).reshape(B, T, H_C * DV_C)
    q_d = _rotary(q_d.reshape(B, T, H_D, DK_D), pos)
    k_d = _rotary(k_d.reshape(B, T, H_D, DK_D), pos) * (DK_D ** -0.5)
    o_d, new_ret = _retention(q_d, k_d, v_d.reshape(B, T, H_D, DV_D), s_ret.astype(f32))
    o_d = _rms(o_d, ret_norm_w).reshape(B, T, H_D * DV_D)
    y = jnp.concatenate([o_c, o_d], axis=-1) * jax.nn.silu(z)
    return y.astype(h.dtype) @ w_out, new_gla, new_ret


def _trunk(x, c, pos, st_gdn, st_conv, st_mc, st_mn, st_mm, st_gla, st_ret,
           ada_w, ada_b, norm_w, ev_w_in, ev_w_out, gdn_conv_w, gdn_a_log, gdn_dt_bias, gdn_norm_w,
           mlstm_gate_b, mlstm_norm_w, od_w_in, od_w_out, gla_w2, gla_b2, gla_norm_w, ret_norm_w,
           final_norm_w):
    dt = x.dtype
    n_gdn, n_conv, n_mc, n_mn, n_mm, n_gla, n_ret = [], [], [], [], [], [], []
    cs = jax.nn.silu(c)
    for layer in range(DEPTH):
        mod = cs @ ada_w[layer] + ada_b[layer]
        shift, scale, gate = jnp.split(mod[:, None, :], 3, axis=-1)
        h = _rms(x, norm_w[layer]) * (1.0 + scale) + shift
        j = layer // 2
        if layer % 2 == 0:
            y, s1, s2, s3, s4, s5 = _even_mixer(h, st_gdn[j], st_conv[j], st_mc[j], st_mn[j], st_mm[j],
                                                ev_w_in[j], ev_w_out[j], gdn_conv_w[j], gdn_a_log[j],
                                                gdn_dt_bias[j], gdn_norm_w[j], mlstm_gate_b[j], mlstm_norm_w[j])
            n_gdn.append(s1.astype(dt))
            n_conv.append(s2.astype(dt))
            n_mc.append(s3.astype(dt))
            n_mn.append(s4.astype(dt))
            n_mm.append(s5.astype(dt))
        else:
            y, s6, s7 = _odd_mixer(h, pos, st_gla[j], st_ret[j], od_w_in[j], od_w_out[j], gla_w2[j],
                                   gla_b2[j], gla_norm_w[j], ret_norm_w[j])
            n_gla.append(s6.astype(dt))
            n_ret.append(s7.astype(dt))
        x = x + gate * y
    return (_rms(x, final_norm_w), jnp.stack(n_gdn), jnp.stack(n_conv), jnp.stack(n_mc),
            jnp.stack(n_mn), jnp.stack(n_mm), jnp.stack(n_gla), jnp.stack(n_ret))


def setup_inputs(seed: int = 0) -> dict:
    key = jax.random.key(seed)
    k = jax.random.split(key, 32)
    f32 = jnp.float32

    def nrm(i, shape, s=1.0):
        return s * jax.random.normal(k[i], shape, f32)

    dt0 = jnp.exp(jax.random.uniform(k[18], (N_EVEN, H_A), f32, math.log(1e-3), math.log(1e-1)))
    return {
        'x_prompt': nrm(0, (BATCH, SEQ, D_MODEL)),
        'x_sample': nrm(1, (DEC_BATCH, DEC_SEQ, D_MODEL)),
        'c_prompt': nrm(2, (BATCH, D_MODEL)),
        'c_sample': nrm(3, (DEC_BATCH, D_MODEL)),
        'state_gdn': nrm(4, (N_EVEN, DEC_BATCH, H_A, DK_A, DV_A), 0.1),
        'state_gdn_conv': nrm(5, (N_EVEN, DEC_BATCH, CONV_W - 1, CONV_CH_A)),
        'state_mlstm_c': nrm(6, (N_EVEN, DEC_BATCH, H_B, DK_B, DV_B), 0.1),
        'state_mlstm_n': nrm(7, (N_EVEN, DEC_BATCH, H_B, DK_B), 0.3),
        'state_mlstm_m': nrm(8, (N_EVEN, DEC_BATCH, H_B)),
        'state_gla': nrm(9, (N_ODD, DEC_BATCH, H_C, DK_C, DV_C), 0.1),
        'state_ret': nrm(10, (N_ODD, DEC_BATCH, H_D, DK_D, DV_D), 0.1),
        'ada_w': nrm(11, (DEPTH, D_MODEL, 3 * D_MODEL), 0.5 * D_MODEL ** -0.5),
        'ada_b': nrm(12, (DEPTH, 3 * D_MODEL), 0.02),
        'norm_w': 1.0 + nrm(13, (DEPTH, D_MODEL), 0.05),
        'ev_w_in': nrm(14, (N_EVEN, D_MODEL, P_EVEN), D_MODEL ** -0.5),
        'ev_w_out': nrm(15, (N_EVEN, W_MIX, D_MODEL), W_MIX ** -0.5),
        'gdn_conv_w': nrm(16, (N_EVEN, CONV_W, CONV_CH_A), 0.5),
        'gdn_a_log': jnp.log(jax.random.uniform(k[17], (N_EVEN, H_A), f32, 1.0, 16.0)),
        'gdn_dt_bias': dt0 + jnp.log(-jnp.expm1(-dt0)),
        'gdn_norm_w': 1.0 + nrm(19, (N_EVEN, DV_A), 0.05),
        'mlstm_gate_b': jnp.concatenate([nrm(20, (N_EVEN, H_B), 0.1),
                                         jnp.linspace(3.0, 6.0, H_B, dtype=f32)[None, :] + nrm(21, (N_EVEN, H_B), 0.1)], axis=-1),
        'mlstm_norm_w': 1.0 + nrm(22, (N_EVEN, DV_B), 0.05),
        'od_w_in': nrm(23, (N_ODD, D_MODEL, P_ODD), D_MODEL ** -0.5),
        'od_w_out': nrm(24, (N_ODD, W_MIX, D_MODEL), W_MIX ** -0.5),
        'gla_w2': nrm(25, (N_ODD, GLA_RANK, H_C * DK_C), GLA_RANK ** -0.5),
        'gla_b2': nrm(26, (N_ODD, H_C * DK_C), 0.1),
        'gla_norm_w': 1.0 + nrm(27, (N_ODD, DV_C), 0.05),
        'ret_norm_w': 1.0 + nrm(28, (N_ODD, DV_D), 0.05),
        'final_norm_w': 1.0 + nrm(29, (D_MODEL,), 0.05),
    }


def reference(x_prompt, x_sample, c_prompt, c_sample, state_gdn, state_gdn_conv, state_mlstm_c,
              state_mlstm_n, state_mlstm_m, state_gla, state_ret, ada_w, ada_b, norm_w, ev_w_in,
              ev_w_out, gdn_conv_w, gdn_a_log, gdn_dt_bias, gdn_norm_w, mlstm_gate_b, mlstm_norm_w,
              od_w_in, od_w_out, gla_w2, gla_b2, gla_norm_w, ret_norm_w, final_norm_w):
    weights = (ada_w, ada_b, norm_w, ev_w_in, ev_w_out, gdn_conv_w, gdn_a_log, gdn_dt_bias, gdn_norm_w,
               mlstm_gate_b, mlstm_norm_w, od_w_in, od_w_out, gla_w2, gla_b2, gla_norm_w, ret_norm_w,
               final_norm_w)
    f32 = jnp.float32
    Bp, Tp = x_prompt.shape[0], x_prompt.shape[1]
    z_gdn = jnp.zeros((N_EVEN, Bp, H_A, DK_A, DV_A), f32)
    z_conv = jnp.zeros((N_EVEN, Bp, CONV_W - 1, CONV_CH_A), f32)
    z_mc = jnp.zeros((N_EVEN, Bp, H_B, DK_B, DV_B), f32)
    z_mn = jnp.zeros((N_EVEN, Bp, H_B, DK_B), f32)
    z_mm = jnp.zeros((N_EVEN, Bp, H_B), f32)
    z_gla = jnp.zeros((N_ODD, Bp, H_C, DK_C, DV_C), f32)
    z_ret = jnp.zeros((N_ODD, Bp, H_D, DK_D, DV_D), f32)
    pos_p = jnp.arange(Tp)
    pos_s = PAST_LEN + jnp.arange(x_sample.shape[1])
    y_prompt, p_gdn, p_conv, p_mc, p_mn, p_mm, p_gla, p_ret = _trunk(
        x_prompt, c_prompt, pos_p, z_gdn, z_conv, z_mc, z_mn, z_mm, z_gla, z_ret, *weights)
    y_sample, s_gdn, s_conv, s_mc, s_mn, s_mm, s_gla, s_ret = _trunk(
        x_sample, c_sample, pos_s, state_gdn, state_gdn_conv, state_mlstm_c, state_mlstm_n,
        state_mlstm_m, state_gla, state_ret, *weights)
    return (y_prompt, y_sample, p_gdn, p_conv, p_mc, p_mn, p_mm, p_gla, p_ret,
            s_gdn, s_conv, s_mc, s_mn, s_mm, s_gla, s_ret)
```

```cpp
#include <hip/hip_runtime.h>
#include <hip/hip_cooperative_groups.h>
#include <cstdio>
#include <cstdint>
namespace cg = cooperative_groups;

#ifndef MK_SPLIT
#define MK_SPLIT 0
#endif

#define LAS __attribute__((address_space(3)))
typedef unsigned short bf16_t;
typedef short bf16x8 __attribute__((ext_vector_type(8)));
typedef float f32x4 __attribute__((ext_vector_type(4)));
typedef float f32x2 __attribute__((ext_vector_type(2)));
typedef float f32x3 __attribute__((ext_vector_type(3)));
typedef unsigned u32x4 __attribute__((ext_vector_type(4)));
typedef unsigned u32x2 __attribute__((ext_vector_type(2)));

constexpr int DM = 1024, NTP = 16384, NTS = 128, NTOK = NTP + NTS, MPAD = 16640, TSEQ = 2048;
constexpr int NSEQ = 136;
constexpr float EPS = 1e-6f;
constexpr int PE_MAIN = 8192, PE_PAD = 8448, PO_MAIN = 6144, PO_PAD = 6400;
constexpr int E_QA = 0, E_KA = 1024, E_VA = 2048, E_QB = 3072, E_KB = 3584, E_VB = 4096, E_OP = 5120, E_Z = 6144;
constexpr int O_QC = 0, O_KC = 512, O_VC = 1024, O_QD = 2048, O_KD = 2560, O_VD = 3072, O_Z = 4096;
constexpr size_t OUT_Y = 0, OUT_PGDN = 16908288, OUT_PCONV = 17956864, OUT_PMC = 18030592, OUT_PMN = 18554880, OUT_PMM = 18558976,
                 OUT_PGLA = 18559040, OUT_PRET = 19607616, OUT_SGDN = 20656192, OUT_SCONV = 37433408, OUT_SMC = 38613056,
                 OUT_SMN = 47001664, OUT_SMM = 47067200, OUT_SGLA = 47068224, OUT_SRET = 63845440;
constexpr size_t WS_CTL = 0, WS_WIN0 = 16384, WS_WOUT0 = WS_WIN0 + (size_t)PE_PAD * 1024 * 2, WS_WIN1 = WS_WOUT0 + (size_t)1024 * 2048 * 2,
                 WS_WOUT1 = WS_WIN1 + (size_t)PO_PAD * 1024 * 2, WS_ADAT = WS_WOUT1 + (size_t)1024 * 2048 * 2, WS_CBF = WS_ADAT + (size_t)6144 * 1024 * 2,
                 WS_MOD = WS_CBF + (size_t)256 * 1024 * 2, WS_ROPE = WS_MOD + (size_t)NSEQ * 6144 * 4, WS_GATES = WS_ROPE + 1049600,
                 WS_GA = WS_GATES + (size_t)NTOK * 32 * 4, WS_GB = WS_GA + (size_t)NTOK * 32 * 4, WS_PROJ = WS_GB + (size_t)NTOK * 32 * 4,
                 WS_Y = WS_PROJ + (size_t)NTOK * PE_MAIN * 2, WS_END = WS_Y + (size_t)MPAD * 2048 * 2;
constexpr size_t WS_ALPHA = WS_PROJ + (size_t)NTOK * PO_MAIN * 2;
constexpr size_t DO_ABUF = OUT_SGLA * 4;
constexpr size_t DO_HBUF = OUT_SRET * 4 + (size_t)67108864 - (size_t)MPAD * 1024 * 2;

struct Params {
    const float* in[29];
    float* out;
    unsigned char* ws;
    int ph_lo, ph_hi;
};

__device__ __forceinline__ float bflo(unsigned u) { return __uint_as_float(u << 16); }
__device__ __forceinline__ float bfhi(unsigned u) { return __uint_as_float(u & 0xffff0000u); }
__device__ __forceinline__ float bf1(bf16_t b) { return __uint_as_float(((unsigned)b) << 16); }
__device__ __forceinline__ unsigned pk2(float lo, float hi) { unsigned r; asm("v_cvt_pk_bf16_f32 %0, %1, %2" : "=v"(r) : "v"(lo), "v"(hi)); return r; }
__device__ __forceinline__ void unpack8(u32x4 p, float* f) {
    f[0] = bflo(p.x); f[1] = bfhi(p.x); f[2] = bflo(p.y); f[3] = bfhi(p.y); f[4] = bflo(p.z); f[5] = bfhi(p.z); f[6] = bflo(p.w); f[7] = bfhi(p.w);
}
__device__ __forceinline__ u32x4 pack8(const float* f) { u32x4 o; o.x = pk2(f[0], f[1]); o.y = pk2(f[2], f[3]); o.z = pk2(f[4], f[5]); o.w = pk2(f[6], f[7]); return o; }
template <int CTRL> __device__ __forceinline__ float dppf(float x) { return __int_as_float(__builtin_amdgcn_update_dpp(0, __float_as_int(x), CTRL, 0xf, 0xf, true)); }
__device__ __forceinline__ float ar4(float x) { x += dppf<0xB1>(x); x += dppf<0x4E>(x); return x; }
__device__ __forceinline__ float ar8(float x) { x = ar4(x); x += dppf<0x141>(x); return x; }
__device__ __forceinline__ void ar8x4(float& a, float& b, float& c, float& d) {
    asm volatile(
        "s_nop 1\n\t"
        "v_add_f32_dpp %0, %0, %0 quad_perm:[1,0,3,2] row_mask:0xf bank_mask:0xf bound_ctrl:1\n\t"
        "v_add_f32_dpp %1, %1, %1 quad_perm:[1,0,3,2] row_mask:0xf bank_mask:0xf bound_ctrl:1\n\t"
        "v_add_f32_dpp %2, %2, %2 quad_perm:[1,0,3,2] row_mask:0xf bank_mask:0xf bound_ctrl:1\n\t"
        "v_add_f32_dpp %3, %3, %3 quad_perm:[1,0,3,2] row_mask:0xf bank_mask:0xf bound_ctrl:1\n\t"
        "v_add_f32_dpp %0, %0, %0 quad_perm:[2,3,0,1] row_mask:0xf bank_mask:0xf bound_ctrl:1\n\t"
        "v_add_f32_dpp %1, %1, %1 quad_perm:[2,3,0,1] row_mask:0xf bank_mask:0xf bound_ctrl:1\n\t"
        "v_add_f32_dpp %2, %2, %2 quad_perm:[2,3,0,1] row_mask:0xf bank_mask:0xf bound_ctrl:1\n\t"
        "v_add_f32_dpp %3, %3, %3 quad_perm:[2,3,0,1] row_mask:0xf bank_mask:0xf bound_ctrl:1\n\t"
        "v_add_f32_dpp %0, %0, %0 row_half_mirror row_mask:0xf bank_mask:0xf bound_ctrl:1\n\t"
        "v_add_f32_dpp %1, %1, %1 row_half_mirror row_mask:0xf bank_mask:0xf bound_ctrl:1\n\t"
        "v_add_f32_dpp %2, %2, %2 row_half_mirror row_mask:0xf bank_mask:0xf bound_ctrl:1\n\t"
        "v_add_f32_dpp %3, %3, %3 row_half_mirror row_mask:0xf bank_mask:0xf bound_ctrl:1\n\t"
        : "+v"(a), "+v"(b), "+v"(c), "+v"(d));
}
__device__ __forceinline__ void ar16x4(float& a, float& b, float& c, float& d) {
    asm volatile(
        "s_nop 1\n\t"
        "v_add_f32_dpp %0, %0, %0 quad_perm:[1,0,3,2] row_mask:0xf bank_mask:0xf bound_ctrl:1\n\t"
        "v_add_f32_dpp %1, %1, %1 quad_perm:[1,0,3,2] row_mask:0xf bank_mask:0xf bound_ctrl:1\n\t"
        "v_add_f32_dpp %2, %2, %2 quad_perm:[1,0,3,2] row_mask:0xf bank_mask:0xf bound_ctrl:1\n\t"
        "v_add_f32_dpp %3, %3, %3 quad_perm:[1,0,3,2] row_mask:0xf bank_mask:0xf bound_ctrl:1\n\t"
        "v_add_f32_dpp %0, %0, %0 quad_perm:[2,3,0,1] row_mask:0xf bank_mask:0xf bound_ctrl:1\n\t"
        "v_add_f32_dpp %1, %1, %1 quad_perm:[2,3,0,1] row_mask:0xf bank_mask:0xf bound_ctrl:1\n\t"
        "v_add_f32_dpp %2, %2, %2 quad_perm:[2,3,0,1] row_mask:0xf bank_mask:0xf bound_ctrl:1\n\t"
        "v_add_f32_dpp %3, %3, %3 quad_perm:[2,3,0,1] row_mask:0xf bank_mask:0xf bound_ctrl:1\n\t"
        "v_add_f32_dpp %0, %0, %0 row_half_mirror row_mask:0xf bank_mask:0xf bound_ctrl:1\n\t"
        "v_add_f32_dpp %1, %1, %1 row_half_mirror row_mask:0xf bank_mask:0xf bound_ctrl:1\n\t"
        "v_add_f32_dpp %2, %2, %2 row_half_mirror row_mask:0xf bank_mask:0xf bound_ctrl:1\n\t"
        "v_add_f32_dpp %3, %3, %3 row_half_mirror row_mask:0xf bank_mask:0xf bound_ctrl:1\n\t"
        "v_add_f32_dpp %0, %0, %0 row_mirror row_mask:0xf bank_mask:0xf bound_ctrl:1\n\t"
        "v_add_f32_dpp %1, %1, %1 row_mirror row_mask:0xf bank_mask:0xf bound_ctrl:1\n\t"
        "v_add_f32_dpp %2, %2, %2 row_mirror row_mask:0xf bank_mask:0xf bound_ctrl:1\n\t"
        "v_add_f32_dpp %3, %3, %3 row_mirror row_mask:0xf bank_mask:0xf bound_ctrl:1\n\t"
        : "+v"(a), "+v"(b), "+v"(c), "+v"(d));
}
__device__ __forceinline__ void ar16x2(float& a, float& b) {
    asm volatile(
        "s_nop 1\n\t"
        "v_add_f32_dpp %0, %0, %0 quad_perm:[1,0,3,2] row_mask:0xf bank_mask:0xf bound_ctrl:1\n\t"
        "v_add_f32_dpp %1, %1, %1 quad_perm:[1,0,3,2] row_mask:0xf bank_mask:0xf bound_ctrl:1\n\t"
        "s_nop 0\n\t"
        "v_add_f32_dpp %0, %0, %0 quad_perm:[2,3,0,1] row_mask:0xf bank_mask:0xf bound_ctrl:1\n\t"
        "v_add_f32_dpp %1, %1, %1 quad_perm:[2,3,0,1] row_mask:0xf bank_mask:0xf bound_ctrl:1\n\t"
        "s_nop 0\n\t"
        "v_add_f32_dpp %0, %0, %0 row_half_mirror row_mask:0xf bank_mask:0xf bound_ctrl:1\n\t"
        "v_add_f32_dpp %1, %1, %1 row_half_mirror row_mask:0xf bank_mask:0xf bound_ctrl:1\n\t"
        "s_nop 0\n\t"
        "v_add_f32_dpp %0, %0, %0 row_mirror row_mask:0xf bank_mask:0xf bound_ctrl:1\n\t"
        "v_add_f32_dpp %1, %1, %1 row_mirror row_mask:0xf bank_mask:0xf bound_ctrl:1\n\t"
        : "+v"(a), "+v"(b));
}
__device__ __forceinline__ float ar16(float x) { x = ar8(x); x += dppf<0x140>(x); return x; }
__device__ __forceinline__ float ar32(float x) { x = ar16(x); x += __shfl_xor(x, 16); return x; }
__device__ __forceinline__ float ar64(float x) { x = ar32(x); x += __shfl_xor(x, 32); return x; }
__device__ __forceinline__ float sigmoidf_(float x) { return __builtin_amdgcn_rcpf(1.f + __expf(-x)); }
__device__ __forceinline__ float siluf_(float x) { return x * __builtin_amdgcn_rcpf(1.f + __expf(-x)); }
__device__ __forceinline__ float gla_alpha_(float x) { const float t = __expf(-x); const float sp = x < -15.f ? -x : __logf(1.f + t); return __expf(-sp * 0.0625f); }
__device__ __forceinline__ float softplusf_(float x) { return x > 20.f ? x : log1pf(expf(x)); }
__device__ __forceinline__ float rdl(float v, int l) { return __int_as_float(__builtin_amdgcn_readlane(__float_as_int(v), l)); }
__device__ __forceinline__ unsigned rdlu(unsigned v, int l) { return (unsigned)__builtin_amdgcn_readlane((int)v, l); }

__device__ __forceinline__ int map_even(int c) { if (c < 3072) return c; if (c < 5120) return c + 16; if (c < 8192) return c + 32; if (c < 8208) return c - 8192 + 3072; if (c < 8224) return c - 8208 + 5136; return -1; }
__device__ __forceinline__ int map_odd(int c) { if (c < 2048) return c; if (c < 6144) return c + 16; if (c < 6160) return c - 6144 + 2048; return -1; }

namespace pg8 {
constexpr int BM = 256, BK = 64, HALF = 128, HTB = HALF * BK * 2, STAGE_BYTES = 8 * HTB, NXCD = 8, WGM = 8;
__device__ __forceinline__ int lds_byte(int r, int c) { const int st = (r >> 4) * 2 + (c >> 5), rr = r & 15, cc = c & 31, ob = rr * 64 + cc * 2; return st * 1024 + (ob ^ (((ob >> 9) & 1) << 5)); }
__device__ __forceinline__ void stage_rc(int b, int& R, int& C) { const int st = b / 1024, sb = b % 1024, swz = sb ^ (((sb >> 9) & 1) << 5); R = (st >> 1) * 16 + swz / 64; C = (st & 1) * 32 + (swz % 64) / 2; }
struct Unit { int pm, pn; };
struct Gemm { const bf16_t* A; const bf16_t* Bt; int M, N, K; };
struct StaticOrder {
    int nM, nN, nwg, G, c;
    __device__ void init(int M, int N, int G_, int c_) { nM = M / BM; nN = N / BM; nwg = nM * nN; G = G_; c = c_; }
    __device__ bool next(int i, Unit& u) const {
        const long L = (long)i * G + c; if (L >= nwg) return false;
        int wgid = (int)L; { const int q = nwg / NXCD, r = nwg % NXCD, xcd = wgid % NXCD, off = wgid / NXCD; wgid = (xcd < r ? xcd * (q + 1) : r * (q + 1) + (xcd - r) * q) + off; }
        const int nig = WGM * nN, gid = wgid / nig, fm = gid * WGM, gsz = (nM - fm) < WGM ? (nM - fm) : WGM;
        u.pm = fm + ((wgid % nig) % gsz); u.pn = (wgid % nig) / gsz; return true;
    }
};

struct Epi {
    int kind;
    float* mod; const float* ada_b;
    bf16_t* P; int ldp; int ntile_main; float* G; int ng;
    const float* xp; const float* xs; float* xo; const float* gate; int layer;
    __device__ __forceinline__ void operator()(const f32x4 (&acc)[2][2][4][2], const Unit& u, int wr, int wc, int fr, int fq) const {
        const int row0 = u.pm * BM + wr * 64 + fr;
        const int col0 = u.pn * BM + wc * 32 + 4 * fq;
        if (kind == 0) {
#pragma unroll
            for (int ai = 0; ai < 2; ++ai)
#pragma unroll
                for (int m = 0; m < 4; ++m) { const int row = row0 + ai * HALF + m * 16;
                    if (row < NSEQ) {
#pragma unroll
                        for (int bj = 0; bj < 2; ++bj)
#pragma unroll
                            for (int n = 0; n < 2; ++n) { const int c = col0 + bj * HALF + n * 16; const f32x4 b = *(const f32x4*)(ada_b + c);
                                *(f32x4*)(mod + (size_t)row * 6144 + c) = acc[ai][bj][m][n] + b; } } }
        } else if (kind == 1) {
            if (u.pn < ntile_main) {
#pragma unroll
                for (int ai = 0; ai < 2; ++ai)
#pragma unroll
                    for (int m = 0; m < 4; ++m) { const int row = row0 + ai * HALF + m * 16;
                        if (row < NTOK) { bf16_t* rowp = P + (size_t)row * ldp + col0;
#pragma unroll
                            for (int bj = 0; bj < 2; ++bj)
#pragma unroll
                                for (int n = 0; n < 2; ++n) { const f32x4 v = acc[ai][bj][m][n]; u32x2 o; o.x = pk2(v[0], v[1]); o.y = pk2(v[2], v[3]);
                                    *(u32x2*)(rowp + bj * HALF + n * 16) = o; } } }
            } else {
#pragma unroll
                for (int ai = 0; ai < 2; ++ai)
#pragma unroll
                    for (int m = 0; m < 4; ++m) { const int row = row0 + ai * HALF + m * 16;
#pragma unroll
                        for (int bj = 0; bj < 2; ++bj)
#pragma unroll
                            for (int n = 0; n < 2; ++n) { const int c = bj * HALF + wc * 32 + n * 16 + 4 * fq;
                                if (row < NTOK && c < ng) *(f32x4*)(G + (size_t)row * ng + c) = acc[ai][bj][m][n]; } }
            }
        } else {
#pragma unroll
            for (int ai = 0; ai < 2; ++ai)
#pragma unroll
                for (int m = 0; m < 4; ++m) { const int row = row0 + ai * HALF + m * 16;
                    if (row < NTOK) {
                        const int seq = row < NTP ? (row >> 11) : (8 + row - NTP);
                        const float* xin = layer == 0 ? (row < NTP ? xp + (size_t)row * DM : xs + (size_t)(row - NTP) * DM) : xo + (size_t)row * DM;
                        const float* gp = gate + (size_t)seq * 6144 + layer * 3072 + 2048;
                        float* xw = xo + (size_t)row * DM;
#pragma unroll
                        for (int bj = 0; bj < 2; ++bj)
#pragma unroll
                            for (int n = 0; n < 2; ++n) { const int c = col0 + bj * HALF + n * 16;
                                const f32x4 xv = *(const f32x4*)(xin + c), gv = *(const f32x4*)(gp + c);
                                *(f32x4*)(xw + c) = xv + gv * acc[ai][bj][m][n]; } } }
        }
    }
};

__device__ __forceinline__ void gemm_phase(LAS unsigned char* lds, const Gemm g, const StaticOrder& S, const Epi& E, const int tid) {
    const int wid = __builtin_amdgcn_readfirstlane(tid >> 6), lane = tid & 63, wr = wid >> 2, wc = wid & 3, fr = lane & 15, fq = lane >> 4;
    const int K = g.K, nt = K / BK;
    unsigned voffA[2], voffB[2];
#pragma unroll
    for (int i = 0; i < 2; ++i) { int R, C; stage_rc(tid * 16 + i * 8192, R, C); voffA[i] = (unsigned)(R * K + C) * 2u; voffB[i] = voffA[i]; }
    const size_t kstep = (size_t)(BK * 2);
    const size_t hstep = (size_t)HALF * K * 2;
    const size_t tstep = 2 * hstep;
    const unsigned ldsw = (unsigned)wid * 1024u;
    const int aoff = lds_byte(wr * 64 + fr, fq * 8), boff = lds_byte(wc * 32 + fr, fq * 8);
#define PG8_SA(b, h) (((b) * 2 + (h)) * HTB)
#define PG8_SB(b, h) ((4 + (b) * 2 + (h)) * HTB)
#define PG8_STAGE(bufoff, gbase, voff) do { _Pragma("unroll") for (int _i = 0; _i < 2; ++_i) \
        __builtin_amdgcn_global_load_lds((const unsigned*)((const char*)(gbase) + (voff)[_i]), (LAS unsigned*)(lds + (bufoff) + ldsw + _i * 8192), 16, 0, 0); } while (0)
#define PG8_LDA(dst, b, h) do { _Pragma("unroll") for (int m = 0; m < 4; ++m) _Pragma("unroll") for (int k = 0; k < 2; ++k) dst[m][k] = *(const LAS bf16x8*)(lds + PG8_SA(b, h) + aoff + m * 2048 + k * 1024); } while (0)
#define PG8_LDB(dst, b, h) do { _Pragma("unroll") for (int n = 0; n < 2; ++n) _Pragma("unroll") for (int k = 0; k < 2; ++k) dst[n][k] = *(const LAS bf16x8*)(lds + PG8_SB(b, h) + boff + n * 2048 + k * 1024); } while (0)
#define PG8_MMA(ai, bj, At, Bt) do { __builtin_amdgcn_s_setprio(1); _Pragma("unroll") for (int m = 0; m < 4; ++m) _Pragma("unroll") for (int n = 0; n < 2; ++n) _Pragma("unroll") for (int k = 0; k < 2; ++k) \
        acc[ai][bj][m][n] = __builtin_amdgcn_mfma_f32_16x16x32_bf16(Bt[n][k], At[m][k], acc[ai][bj][m][n], 0, 0, 0); __builtin_amdgcn_s_setprio(0); } while (0)
#define PG8_WAIT_V(n) asm volatile("s_waitcnt vmcnt(" #n ")" ::: "memory")
#define PG8_WAIT_L(n) asm volatile("s_waitcnt lgkmcnt(" #n ")" ::: "memory")
#define PG8_BAR __builtin_amdgcn_s_barrier()
#define PG8_SCHED __builtin_amdgcn_sched_barrier(0)
    Unit cur, nxt; int ui = 0;
    if (!S.next(0, cur)) return;
    f32x4 acc[2][2][4][2];
#pragma unroll
    for (int a = 0; a < 2; ++a)
#pragma unroll
        for (int b = 0; b < 2; ++b)
#pragma unroll
            for (int m = 0; m < 4; ++m)
#pragma unroll
                for (int n = 0; n < 2; ++n) acc[a][b][m][n] = (f32x4){0.f, 0.f, 0.f, 0.f};
    bf16x8 At[4][2], B0[2][2], B1[2][2];
    const char* cA = (const char*)g.A + (size_t)cur.pm * tstep; const char* cB = (const char*)g.Bt + (size_t)cur.pn * tstep;
    PG8_STAGE(PG8_SB(0, 0), cB, voffB); PG8_STAGE(PG8_SA(0, 0), cA, voffA); PG8_STAGE(PG8_SB(0, 1), cB + hstep, voffB); PG8_STAGE(PG8_SA(0, 1), cA + hstep, voffA);
    if (wr == 1) PG8_BAR;
    PG8_WAIT_V(4); PG8_BAR;
    PG8_STAGE(PG8_SB(1, 0), cB + kstep, voffB); PG8_STAGE(PG8_SA(1, 0), cA + kstep, voffA); PG8_STAGE(PG8_SB(1, 1), cB + hstep + kstep, voffB);
    PG8_WAIT_V(6); PG8_BAR;
    for (;;) {
        const bool has_next = S.next(ui + 1, nxt);
        const char* nA = has_next ? (const char*)g.A + (size_t)nxt.pm * tstep : cA; const char* nB = has_next ? (const char*)g.Bt + (size_t)nxt.pn * tstep : cB;
        for (int t = 0; t < nt; t += 2) {
            const bool last = (t == nt - 2);
            const char* a1 = cA + (size_t)(t + 1) * kstep;
            const char* a2 = last ? nA : cA + (size_t)(t + 2) * kstep; const char* b2 = last ? nB : cB + (size_t)(t + 2) * kstep;
            const char* a3 = a2 + kstep; const char* b3 = b2 + kstep;
            PG8_LDB(B0, 0, 0); PG8_SCHED; PG8_LDA(At, 0, 0); PG8_STAGE(PG8_SA(1, 1), a1 + hstep, voffA);
            PG8_WAIT_L(8); PG8_BAR; PG8_WAIT_L(0); PG8_MMA(0, 0, At, B0); PG8_BAR; PG8_SCHED;
            PG8_LDB(B1, 0, 1); PG8_STAGE(PG8_SB(0, 0), b2, voffB);
            PG8_BAR; PG8_WAIT_L(0); PG8_MMA(0, 1, At, B1); PG8_BAR;
            PG8_LDA(At, 0, 1); PG8_STAGE(PG8_SA(0, 0), a2, voffA);
            PG8_BAR; PG8_WAIT_L(0); PG8_MMA(1, 0, At, B0); PG8_BAR; PG8_SCHED;
            PG8_STAGE(PG8_SB(0, 1), b2 + hstep, voffB);
            PG8_WAIT_V(6); PG8_BAR; PG8_MMA(1, 1, At, B1); PG8_BAR;
            PG8_LDB(B0, 1, 0); PG8_SCHED; PG8_LDA(At, 1, 0); PG8_STAGE(PG8_SA(0, 1), a2 + hstep, voffA);
            PG8_WAIT_L(8); PG8_BAR; PG8_WAIT_L(0); PG8_MMA(0, 0, At, B0); PG8_BAR; PG8_SCHED;
            PG8_LDB(B1, 1, 1); PG8_STAGE(PG8_SB(1, 0), b3, voffB);
            PG8_BAR; PG8_WAIT_L(0); PG8_MMA(0, 1, At, B1); PG8_BAR;
            PG8_LDA(At, 1, 1); PG8_STAGE(PG8_SA(1, 0), a3, voffA);
            PG8_BAR; PG8_WAIT_L(0); PG8_MMA(1, 0, At, B0); PG8_BAR; PG8_SCHED;
            PG8_STAGE(PG8_SB(1, 1), b3 + hstep, voffB);
            PG8_WAIT_V(6); PG8_BAR; PG8_MMA(1, 1, At, B1); PG8_BAR;
        }
        E(acc, cur, wr, wc, fr, fq);
        if (!has_next) break;
#pragma unroll
        for (int a = 0; a < 2; ++a)
#pragma unroll
            for (int b = 0; b < 2; ++b)
#pragma unroll
                for (int m = 0; m < 4; ++m)
#pragma unroll
                    for (int n = 0; n < 2; ++n) acc[a][b][m][n] = (f32x4){0.f, 0.f, 0.f, 0.f};
        cur = nxt; cA = nA; cB = nB; ++ui;
    }
    PG8_WAIT_V(0);
    if (wr == 0) PG8_BAR;
    PG8_BAR;
#undef PG8_SA
#undef PG8_SB
#undef PG8_STAGE
#undef PG8_LDA
#undef PG8_LDB
#undef PG8_MMA
#undef PG8_WAIT_V
#undef PG8_WAIT_L
#undef PG8_BAR
#undef PG8_SCHED
}
}

typedef const __attribute__((address_space(4))) Params* KP;
struct Ctx {
    int lane, wave, gw, ngw, bid, nblk, tid;
    LAS unsigned char* lds;
};
#define WSP(T, off) ((T*)(P->ws + (off)))
#define DOP(T, off) ((T*)((unsigned char*)P->out + (off)))

__device__ __forceinline__ void transpose_item(const float* W, int ldw, bf16_t* WT, int K, int k0, int n0, int mapkind, LAS float* scr, int lane) {
    const int n = n0 + (lane & 31);
    const int sc = mapkind == 0 ? map_even(n) : (mapkind == 1 ? map_odd(n) : n);
#pragma unroll
    for (int i = 0; i < 32; ++i) { const int kk = 2 * i + (lane >> 5); scr[kk * 33 + (lane & 31)] = sc >= 0 ? W[(size_t)(k0 + kk) * ldw + sc] : 0.f; }
    asm volatile("s_waitcnt lgkmcnt(0)" ::: "memory");
    const int c = lane & 7;
#pragma unroll
    for (int j = 0; j < 4; ++j) { const int nn = (lane >> 3) + 8 * j; const LAS float* s = scr + (8 * c) * 33 + nn;
        u32x4 o; o.x = pk2(s[0 * 33], s[1 * 33]); o.y = pk2(s[2 * 33], s[3 * 33]); o.z = pk2(s[4 * 33], s[5 * 33]); o.w = pk2(s[6 * 33], s[7 * 33]);
        *(u32x4*)(WT + (size_t)(n0 + nn) * K + k0 + 8 * c) = o; }
    asm volatile("s_waitcnt lgkmcnt(0)" ::: "memory");
}

__device__ __forceinline__ void prep_weights(KP P, const Ctx& C, int gw, int ngw) {
    LAS float* scr = (LAS float*)(C.lds + C.wave * 8704);
    constexpr int I_WIN0 = 16 * (PE_PAD / 32), I_WIN1 = 16 * (PO_PAD / 32), I_WOUT = 32 * 32;
    constexpr int NIT = I_WIN0 + I_WIN1 + 2 * I_WOUT;
    for (int it = gw; it < NIT; it += ngw) {
        int r = it;
        if (r < I_WIN0) { const int nb = r % (PE_PAD / 32), kb = r / (PE_PAD / 32); transpose_item(P->in[14], 8224, WSP(bf16_t, WS_WIN0), 1024, kb * 64, nb * 32, 0, scr, C.lane); continue; } r -= I_WIN0;
        if (r < I_WIN1) { const int nb = r % (PO_PAD / 32), kb = r / (PO_PAD / 32); transpose_item(P->in[22], 6160, WSP(bf16_t, WS_WIN1), 1024, kb * 64, nb * 32, 1, scr, C.lane); continue; } r -= I_WIN1;
        if (r < I_WOUT) { const int nb = r % 32, kb = r / 32; transpose_item(P->in[15], 1024, WSP(bf16_t, WS_WOUT0), 2048, kb * 64, nb * 32, 2, scr, C.lane); continue; } r -= I_WOUT;
        { const int nb = r % 32, kb = r / 32; transpose_item(P->in[23], 1024, WSP(bf16_t, WS_WOUT1), 2048, kb * 64, nb * 32, 2, scr, C.lane); }
    }
}
__device__ __forceinline__ void phase_prep0(KP P, const Ctx& C) {
    LAS float* scr = (LAS float*)(C.lds + C.wave * 8704);
    constexpr int I_ADA = 2 * 16 * 96;
    for (int r = C.gw; r < I_ADA; r += C.ngw) {
        const int l = r / (16 * 96), rr = r % (16 * 96), nb = rr % 96, kb = rr / 96;
        transpose_item(P->in[11] + (size_t)l * 1024 * 3072, 3072, WSP(bf16_t, WS_ADAT) + (size_t)l * 3072 * 1024, 1024, kb * 64, nb * 32, 2, scr, C.lane);
    }
    const int gt = C.bid * 512 + C.tid, ngt = C.nblk * 512;
    bf16_t* cbf = WSP(bf16_t, WS_CBF);
    for (int i = gt; i < 256 * 512; i += ngt) { const int row = i >> 9, c2 = (i & 511) * 2; float a = 0.f, b = 0.f;
        if (row < NSEQ) { const float* cp = row < 8 ? P->in[2] + row * 1024 : P->in[3] + (row - 8) * 1024; a = siluf_(cp[c2]); b = siluf_(cp[c2 + 1]); }
        *(unsigned*)(cbf + (size_t)row * 1024 + c2) = pk2(a, b); }
    f32x2* rope = WSP(f32x2, WS_ROPE);
    for (int i = gt; i < 2049 * 64; i += ngt) { const int p = i >> 6, fi = i & 63; const float pos = p < 2048 ? (float)p : 16384.f;
        const float inv = expf(-(float)fi * (1.f / 64.f) * 9.210340371976184f); const float ang = pos * inv;
        const double ad = (double)ang; const double n = rint(ad * 0.15915494309189535); const float rr = (float)(ad - n * 6.283185307179586);
        rope[i] = (f32x2){cosf(rr), sinf(rr)}; }
    unsigned* hz = (unsigned*)(DOP(bf16_t, DO_HBUF) + (size_t)NTOK * 1024);
    for (int i = gt; i < 128 * 512; i += ngt) hz[i] = 0u;
    unsigned* yz = (unsigned*)(WSP(bf16_t, WS_Y) + (size_t)NTOK * 2048);
    for (int i = gt; i < 128 * 1024; i += ngt) yz[i] = 0u;
}

__device__ __forceinline__ void phase_hnorm(KP P, const Ctx& C, int layer) {
    const float* mod = WSP(float, WS_MOD); const float* nw = P->in[13] + layer * 1024; bf16_t* hb = DOP(bf16_t, DO_HBUF);
    for (int tok = C.gw; tok < NTOK; tok += C.ngw) {
        const float* xr = layer == 0 ? (tok < NTP ? P->in[0] + (size_t)tok * DM : P->in[1] + (size_t)(tok - NTP) * DM) : P->out + (size_t)tok * DM;
        const int seq = tok < NTP ? (tok >> 11) : (8 + tok - NTP);
        const float* md = mod + (size_t)seq * 6144 + layer * 3072;
        f32x4 v[4]; float ss = 0.f;
#pragma unroll
        for (int j = 0; j < 4; ++j) { v[j] = ((const f32x4*)xr)[C.lane + 64 * j]; ss += v[j].x * v[j].x + v[j].y * v[j].y + v[j].z * v[j].z + v[j].w * v[j].w; }
        ss = ar64(ss); const float rstd = rsqrtf(ss * (1.f / 1024.f) + EPS);
#pragma unroll
        for (int j = 0; j < 4; ++j) { const int idx = (C.lane + 64 * j) * 4;
            const f32x4 w = *(const f32x4*)(nw + idx), sh = *(const f32x4*)(md + idx), sc = *(const f32x4*)(md + 1024 + idx);
            const f32x4 h = v[j] * rstd * w * (sc + 1.f) + sh; u32x2 o; o.x = pk2(h.x, h.y); o.y = pk2(h.z, h.w);
            *(u32x2*)(hb + (size_t)tok * 1024 + idx) = o; }
    }
}

__device__ __forceinline__ void phase_prep_even(KP P, const Ctx& C) {
    const bf16_t* proj = WSP(bf16_t, WS_PROJ); const float* G = WSP(float, WS_GATES); float* GA = WSP(float, WS_GA); float* GB = WSP(float, WS_GB);
    bf16_t* ab = DOP(bf16_t, DO_ABUF); const float* cw = P->in[16]; const int lane = C.lane;
    for (int tok = C.gw; tok < NTOK; tok += C.ngw) {
        const bool isP = tok < NTP; const int t = isP ? (tok & 2047) : 0; const int si = tok - NTP;
        if (lane < 8) { const int h = lane; const float* g = G + (size_t)tok * 32;
            const float beta = sigmoidf_(g[h]); const float a = expf(-expf(P->in[17][h]) * softplusf_(g[8 + h] + P->in[18][h]));
            GA[(size_t)tok * 32 + h * 4] = a; GA[(size_t)tok * 32 + h * 4 + 1] = beta;
            const float ig = g[16 + h] + P->in[20][h], fg = g[24 + h] + P->in[20][8 + h];
            GB[(size_t)tok * 32 + h * 4] = ig; GB[(size_t)tok * 32 + h * 4 + 1] = -softplusf_(-fg); }
#pragma unroll 1
        for (int i = 0; i < 2; ++i) {
            float val[3][8];
#pragma unroll
            for (int s = 0; s < 3; ++s) { const int c0 = s * 1024 + i * 512 + lane * 8;
                float y[8];
#pragma unroll
                for (int e = 0; e < 8; ++e) y[e] = 0.f;
#pragma unroll
                for (int j = 0; j < 4; ++j) {
                    const int back = 3 - j; float u[8];
                    if (t >= back) unpack8(*(const u32x4*)(proj + (size_t)(tok - back) * PE_MAIN + c0), u);
                    else if (!isP) { const float* bp = P->in[5] + ((size_t)si * 3 + (t + j)) * 3072 + c0; const f32x4 b0 = *(const f32x4*)bp, b1 = *(const f32x4*)(bp + 4);
                        u[0] = b0.x; u[1] = b0.y; u[2] = b0.z; u[3] = b0.w; u[4] = b1.x; u[5] = b1.y; u[6] = b1.z; u[7] = b1.w; }
                    else {
#pragma unroll
                        for (int e = 0; e < 8; ++e) u[e] = 0.f; }
                    const f32x4 w0 = *(const f32x4*)(cw + j * 3072 + c0), w1 = *(const f32x4*)(cw + j * 3072 + c0 + 4);
                    y[0] += w0.x * u[0]; y[1] += w0.y * u[1]; y[2] += w0.z * u[2]; y[3] += w0.w * u[3];
                    y[4] += w1.x * u[4]; y[5] += w1.y * u[5]; y[6] += w1.z * u[6]; y[7] += w1.w * u[7];
                    if (isP) { if (j == 3 && t >= 2045) { float* pc = P->out + OUT_PCONV + ((size_t)(tok >> 11) * 3 + (t - 2045)) * 3072 + c0;
                            *(f32x4*)pc = (f32x4){u[0], u[1], u[2], u[3]}; *(f32x4*)(pc + 4) = (f32x4){u[4], u[5], u[6], u[7]}; } }
                    else if (j >= 1) { float* sc = P->out + OUT_SCONV + ((size_t)si * 3 + (j - 1)) * 3072 + c0;
                        *(f32x4*)sc = (f32x4){u[0], u[1], u[2], u[3]}; *(f32x4*)(sc + 4) = (f32x4){u[4], u[5], u[6], u[7]}; }
                }
#pragma unroll
                for (int e = 0; e < 8; ++e) val[s][e] = siluf_(y[e]);
            }
            float sq = 0.f, sk = 0.f, d = 0.f;
#pragma unroll
            for (int e = 0; e < 8; ++e) { sq += val[0][e] * val[0][e]; sk += val[1][e] * val[1][e]; d += val[0][e] * val[1][e]; }
            sq = ar16(sq); sk = ar16(sk); d = ar16(d);
            const float rq = rsqrtf(sq + EPS) * 0.08838834764831845f, rk = rsqrtf(sk + EPS);
#pragma unroll
            for (int e = 0; e < 8; ++e) { val[0][e] *= rq; val[1][e] *= rk; }
            *(u32x4*)(ab + (size_t)tok * 3072 + i * 512 + lane * 8) = pack8(val[0]);
            *(u32x4*)(ab + (size_t)tok * 3072 + 1024 + i * 512 + lane * 8) = pack8(val[1]);
            *(u32x4*)(ab + (size_t)tok * 3072 + 2048 + i * 512 + lane * 8) = pack8(val[2]);
            if ((lane & 15) == 0) GA[(size_t)tok * 32 + (4 * i + (lane >> 4)) * 4 + 2] = d * rq * rk;
        }
    }
}

template <int NLANES> __device__ __forceinline__ float arN(float x) { return NLANES == 16 ? ar16(x) : (NLANES == 8 ? ar8(x) : ar4(x)); }
template <int MODE, int DKL, int DR> __device__ __forceinline__ void rec_item(KP P, int item, int lane) {
    constexpr int DK = (MODE == 1 || MODE == 4) ? 64 : 128;
    constexpr int NL = DK / DKL;
    constexpr int CW = (64 / NL) * 2;
    constexpr int DV = (MODE == 0 || MODE == 1) ? 128 : (MODE == 4 ? CW : 256);
    constexpr int NCB = DV / CW;
    constexpr int NH = (MODE >= 2 && MODE <= 3) ? 4 : 8;
    constexpr int LD = MODE == 0 ? 3072 : ((MODE == 1 || MODE == 4) ? PE_MAIN : PO_MAIN);
    const int bh = item / NCB, cb = item % NCB, b = bh / NH, h = bh % NH;
    const int r = lane & (NL - 1), dv = cb * CW + (lane / NL) * 2;
    const bf16_t* src = (MODE == 0 ? DOP(bf16_t, DO_ABUF) : WSP(bf16_t, WS_PROJ)) + (size_t)b * TSEQ * LD;
    const int ko = (MODE == 0 ? 1024 + h * 128 : (MODE == 1 || MODE == 4) ? E_KB + h * 64 : MODE == 2 ? O_KC + h * 128 : O_KD + h * 128) + r * DKL;
    const int qo = (MODE == 0 ? h * 128 : (MODE == 1 || MODE == 4) ? E_QB + h * 64 : MODE == 2 ? O_QC + h * 128 : O_QD + h * 128) + r * DKL;
    const int vo = (MODE == 0 ? 2048 + h * 128 : MODE == 1 ? E_VB + h * 128 : MODE == 2 ? O_VC + h * 256 : O_VD + h * 256) + dv;
    float* gsrc = (MODE == 0 ? WSP(float, WS_GA) : WSP(float, WS_GB)) + (size_t)b * TSEQ * 32 + h * 4;
    const float* asrc = WSP(float, WS_ALPHA) + (size_t)b * TSEQ * 512 + h * 128 + r * DKL;
    bf16_t* yb = WSP(bf16_t, WS_Y) + (size_t)b * TSEQ * 2048 + (MODE == 0 ? h * 128 : MODE == 1 ? 1024 + h * 128 : MODE == 2 ? h * 256 : 1024 + h * 256) + dv;
    const float gam = 1.f - exp2f(-5.f - (float)h);
    struct TokIn { u32x4 k0, k1, q0, q1; unsigned v; f32x4 g; f32x4 a0, a1, a2, a3; };
    f32x2 S[DKL];
#pragma unroll
    for (int i = 0; i < DKL; ++i) S[i] = (f32x2){0.f, 0.f};
    float m = 0.f, A = 1.f;
    auto load = [&](TokIn& x, int t) {
        const int tt = t;
        const bf16_t* p = src + (size_t)tt * LD;
        x.k0 = *(const u32x4*)(p + ko); x.q0 = *(const u32x4*)(p + qo);
        if (DKL == 16) { x.k1 = *(const u32x4*)(p + ko + 8); x.q1 = *(const u32x4*)(p + qo + 8); }
        if (MODE != 4) x.v = *(const unsigned*)(p + vo);
        if (MODE == 0) { const f32x3 g3 = *(const f32x3*)(gsrc + (size_t)tt * 32); x.g.x = g3.x; x.g.y = g3.y; x.g.z = g3.z; }
        if (MODE == 1 || MODE == 4) { const f32x2 g2 = *(const f32x2*)(gsrc + (size_t)tt * 32); x.g.x = g2.x; x.g.y = g2.y; }
        if (MODE == 2) { const float* ap = asrc + (size_t)tt * 512; x.a0 = *(const f32x4*)ap; x.a1 = *(const f32x4*)(ap + 4);
            if (DKL == 16) { x.a2 = *(const f32x4*)(ap + 8); x.a3 = *(const f32x4*)(ap + 12); } }
    };
    auto step = [&](const TokIn& x, int t) {
        float k[16], q[16]; unpack8(x.k0, k); unpack8(x.q0, q);
        if (DKL == 16) { unpack8(x.k1, k + 8); unpack8(x.q1, q + 8); }
        f32x2 v = {1.f, 1.f};
        if (MODE != 4) v = (f32x2){bflo(x.v), bfhi(x.v)};
        f32x2 o = {0.f, 0.f};
        if (MODE == 0) {
            const float a = x.g.x, be = x.g.y, qk = x.g.z;
            f32x2 pka[4], pqa[4];
#pragma unroll
            for (int i = 0; i < 4; ++i) { pka[i] = S[i] * k[i]; pqa[i] = S[i] * q[i]; }
#pragma unroll
            for (int i = 4; i < DKL; ++i) { pka[i & 3] += S[i] * k[i]; pqa[i & 3] += S[i] * q[i]; }
            f32x2 pk = (pka[0] + pka[1]) + (pka[2] + pka[3]), pq = (pqa[0] + pqa[1]) + (pqa[2] + pqa[3]);
            { float p0 = pk.x, p1 = pk.y, p2 = pq.x, p3 = pq.y;
              if (NL == 8) ar8x4(p0, p1, p2, p3); else if (NL == 16) ar16x4(p0, p1, p2, p3); else { p0 = arN<NL>(p0); p1 = arN<NL>(p1); p2 = arN<NL>(p2); p3 = arN<NL>(p3); }
              pk = (f32x2){p0, p1}; pq = (f32x2){p2, p3}; }
            float An = a * A;
            const f32x2 u = (v - pk * An) * be;
            o = pq * An + u * qk;
            if (An < 1e-12f) {
#pragma unroll
                for (int i = 0; i < DKL; ++i) S[i] = S[i] * An;
                An = 1.f; }
            const f32x2 uh = u * __builtin_amdgcn_rcpf(An);
#pragma unroll
            for (int i = 0; i < DKL; ++i) S[i] = S[i] + uh * k[i];
            A = An;
        } else if (MODE == 1 || MODE == 4) {
            const float ig = x.g.x, lf = x.g.y;
            const float mn = fmaxf(lf + m, ig); const float dec = __expf(lf + m - mn), isc = __expf(ig - mn) * 0.125f; m = mn;
            const f32x2 u = v * isc;
            f32x2 oa[4] = {o, o, o, o};
#pragma unroll
            for (int i = 0; i < DKL; ++i) { S[i] = S[i] * dec + u * k[i]; oa[i & 3] += S[i] * q[i]; }
            o = (oa[0] + oa[1]) + (oa[2] + oa[3]);
            o.x = arN<NL>(o.x); if (MODE == 1) o.y = arN<NL>(o.y);
        } else if (MODE == 2) {
            const float al[16] = {x.a0.x, x.a0.y, x.a0.z, x.a0.w, x.a1.x, x.a1.y, x.a1.z, x.a1.w, x.a2.x, x.a2.y, x.a2.z, x.a2.w, x.a3.x, x.a3.y, x.a3.z, x.a3.w};
            f32x2 oa[4] = {o, o, o, o};
#pragma unroll
            for (int i = 0; i < DKL; ++i) { S[i] = S[i] * al[i] + v * k[i]; oa[i & 3] += S[i] * q[i]; }
            o = (oa[0] + oa[1]) + (oa[2] + oa[3]);
            if (NL == 16) { float p0 = o.x, p1 = o.y; ar16x2(p0, p1); o = (f32x2){p0, p1}; } else { o.x = arN<NL>(o.x); o.y = arN<NL>(o.y); }
            o *= 0.08838834764831845f;
        } else {
            f32x2 oa[4] = {o, o, o, o};
#pragma unroll
            for (int i = 0; i < DKL; ++i) { S[i] = S[i] * gam + v * k[i]; oa[i & 3] += S[i] * q[i]; }
            o = (oa[0] + oa[1]) + (oa[2] + oa[3]);
            if (NL == 16) { float p0 = o.x, p1 = o.y; ar16x2(p0, p1); o = (f32x2){p0, p1}; } else { o.x = arN<NL>(o.x); o.y = arN<NL>(o.y); }
        }
        if (MODE == 4) { if (lane == 0) gsrc[(size_t)t * 32 + 2] = __builtin_amdgcn_rcpf(fmaxf(fabsf(o.x), __expf(-m))); }
        else if (r == 0) *(unsigned*)(yb + (size_t)t * 2048) = pk2(o.x, o.y);
    };
    TokIn X[DR];
#pragma unroll
    for (int d = 0; d < DR; ++d) load(X[d], d);
    for (int t0 = 0; t0 < TSEQ; t0 += DR) {
#pragma unroll
        for (int d = 0; d < DR; ++d) { const int t = t0 + d;
            if (t < TSEQ) step(X[d], t);
            load(X[d], t + DR); }
    }
    if (MODE == 4) {
        if (lane < NL) {
#pragma unroll
            for (int i = 0; i < DKL; ++i) P->out[OUT_PMN + (size_t)bh * 64 + r * DKL + i] = S[i].x; }
        if (lane == 0) P->out[OUT_PMM + bh] = m;
    } else {
        float* ps = P->out + (MODE == 0 ? OUT_PGDN : MODE == 1 ? OUT_PMC : MODE == 2 ? OUT_PGLA : OUT_PRET) + (size_t)bh * DK * DV;
#pragma unroll
        for (int i = 0; i < DKL; ++i) *(f32x2*)(ps + (size_t)(r * DKL + i) * DV + dv) = (MODE == 0) ? S[i] * A : S[i];
    }
}

__device__ __forceinline__ void gdn_sample_item(KP P, int idx, int lane) {
    const int si = idx >> 3, h = idx & 7, tok = NTP + si;
    const float* Sin = P->in[4] + (size_t)idx * 128 * 128; float* Sout = P->out + OUT_SGDN + (size_t)idx * 128 * 128;
    const bf16_t* ab = DOP(bf16_t, DO_ABUF) + (size_t)tok * 3072 + h * 128;
    const float* ga = WSP(float, WS_GA) + (size_t)tok * 32;
    const unsigned kpk = *(const unsigned*)(ab + 1024 + 2 * lane), qpk = *(const unsigned*)(ab + 2 * lane), vpk = *(const unsigned*)(ab + 2048 + 2 * lane);
    const float a = ga[h * 4], be = ga[h * 4 + 1], qk = ga[h * 4 + 2];
    f32x2 pk = {0.f, 0.f}, pq = {0.f, 0.f};
#pragma unroll 8
    for (int d2 = 0; d2 < 64; ++d2) { const unsigned ku = rdlu(kpk, d2), qu = rdlu(qpk, d2);
        const f32x2 s0 = *(const f32x2*)(Sin + (size_t)(2 * d2) * 128 + 2 * lane), s1 = *(const f32x2*)(Sin + (size_t)(2 * d2 + 1) * 128 + 2 * lane);
        pk += s0 * bflo(ku) + s1 * bfhi(ku); pq += s0 * bflo(qu) + s1 * bfhi(qu); }
    const f32x2 v = {bflo(vpk), bfhi(vpk)};
    const f32x2 u = (v - pk * a) * be; const f32x2 o = pq * a + u * qk;
#pragma unroll 8
    for (int d2 = 0; d2 < 64; ++d2) { const unsigned ku = rdlu(kpk, d2);
        const f32x2 s0 = *(const f32x2*)(Sin + (size_t)(2 * d2) * 128 + 2 * lane), s1 = *(const f32x2*)(Sin + (size_t)(2 * d2 + 1) * 128 + 2 * lane);
        *(f32x2*)(Sout + (size_t)(2 * d2) * 128 + 2 * lane) = s0 * a + u * bflo(ku);
        *(f32x2*)(Sout + (size_t)(2 * d2 + 1) * 128 + 2 * lane) = s1 * a + u * bfhi(ku); }
    *(unsigned*)(WSP(bf16_t, WS_Y) + (size_t)tok * 2048 + h * 128 + 2 * lane) = pk2(o.x, o.y);
}

__device__ __forceinline__ void mlstm_sample_item(KP P, int idx, int lane) {
    const int si = idx >> 3, h = idx & 7, tok = NTP + si;
    const float* Cin = P->in[6] + (size_t)idx * 64 * 128; float* Cout = P->out + OUT_SMC + (size_t)idx * 64 * 128;
    const bf16_t* pr = WSP(bf16_t, WS_PROJ) + (size_t)tok * PE_MAIN;
    float* gb = WSP(float, WS_GB) + (size_t)tok * 32;
    const float m0 = P->in[8][idx], ig = gb[h * 4], lf = gb[h * 4 + 1];
    const float mn = fmaxf(lf + m0, ig); const float dec = expf(lf + m0 - mn), isc = expf(ig - mn) * 0.125f;
    const unsigned kpk = *(const unsigned*)(pr + E_KB + h * 64 + 2 * (lane & 31)), qpk = *(const unsigned*)(pr + E_QB + h * 64 + 2 * (lane & 31));
    const unsigned vpk = *(const unsigned*)(pr + E_VB + h * 128 + 2 * lane);
    const f32x2 uv = (f32x2){bflo(vpk), bfhi(vpk)} * isc;
    f32x2 num = {0.f, 0.f};
#pragma unroll 8
    for (int d2 = 0; d2 < 32; ++d2) { const unsigned ku = rdlu(kpk, d2), qu = rdlu(qpk, d2);
        const f32x2 s0 = *(const f32x2*)(Cin + (size_t)(2 * d2) * 128 + 2 * lane), s1 = *(const f32x2*)(Cin + (size_t)(2 * d2 + 1) * 128 + 2 * lane);
        const f32x2 n0 = s0 * dec + uv * bflo(ku), n1 = s1 * dec + uv * bfhi(ku);
        *(f32x2*)(Cout + (size_t)(2 * d2) * 128 + 2 * lane) = n0; *(f32x2*)(Cout + (size_t)(2 * d2 + 1) * 128 + 2 * lane) = n1;
        num += n0 * bflo(qu) + n1 * bfhi(qu); }
    const float kl = bf1(pr[E_KB + h * 64 + lane]), ql = bf1(pr[E_QB + h * 64 + lane]);
    const float nl = dec * P->in[7][(size_t)idx * 64 + lane] + isc * kl;
    const float den = ar64(nl * ql);
    P->out[OUT_SMN + (size_t)idx * 64 + lane] = nl;
    if (lane == 0) { P->out[OUT_SMM + idx] = mn; gb[h * 4 + 2] = 1.f / fmaxf(fabsf(den), expf(-mn)); }
    *(unsigned*)(WSP(bf16_t, WS_Y) + (size_t)tok * 2048 + 1024 + h * 128 + 2 * lane) = pk2(num.x, num.y);
}

__device__ __forceinline__ void phase_rec_even(KP P, const Ctx& C) {
    const int lane = C.lane;
    { const int slot = C.bid * 4 + (C.wave & 3), nslot = C.nblk * 4;
        if (C.wave < 4) { for (int g = slot; g < 1024; g += nslot) rec_item<0, 8, 8>(P, g, lane); }
        else { for (int q = slot; q < 576; q += nslot) { if (q < 512) rec_item<1, 8, 8>(P, q, lane); else rec_item<4, 8, 8>(P, q - 512, lane); } } }
    unsigned* ctr = WSP(unsigned, WS_CTL);
    for (;;) {
        int idx = 0; if (lane == 0) idx = (int)atomicAdd(ctr, 1u);
        idx = __builtin_amdgcn_readfirstlane(idx);
        if (idx >= 2048) break;
        if (idx < 1024) gdn_sample_item(P, idx, lane); else mlstm_sample_item(P, idx - 1024, lane);
    }
}

__device__ __forceinline__ void phase_post_even(KP P, const Ctx& C) {
    bf16_t* Y = WSP(bf16_t, WS_Y); const bf16_t* proj = WSP(bf16_t, WS_PROJ); const float* GB = WSP(float, WS_GB); const int lane = C.lane;
    for (int tok = C.gw; tok < NTOK; tok += C.ngw) {
#pragma unroll
        for (int i = 0; i < 4; ++i) { const int ch0 = i * 512 + lane * 8; float o[8], z[8], y[8];
            unpack8(*(const u32x4*)(Y + (size_t)tok * 2048 + ch0), o); unpack8(*(const u32x4*)(proj + (size_t)tok * PE_MAIN + E_Z + ch0), z);
            if (i < 2) { float ss = 0.f;
#pragma unroll
                for (int e = 0; e < 8; ++e) ss += o[e] * o[e];
                ss = ar16(ss); const float rs = rsqrtf(ss * (1.f / 128.f) + EPS); const float* w = P->in[19] + (ch0 & 127);
#pragma unroll
                for (int e = 0; e < 8; ++e) y[e] = o[e] * rs * w[e] * siluf_(z[e]);
            } else { const int hh = (ch0 - 1024) >> 7; const float dn = GB[(size_t)tok * 32 + hh * 4 + 2]; float ss = 0.f; float op[8];
                unpack8(*(const u32x4*)(proj + (size_t)tok * PE_MAIN + E_OP + ch0 - 1024), op);
#pragma unroll
                for (int e = 0; e < 8; ++e) { o[e] *= dn; ss += o[e] * o[e]; }
                ss = ar16(ss); const float rs = rsqrtf(ss * (1.f / 128.f) + EPS); const float* w = P->in[21] + (ch0 & 127);
#pragma unroll
                for (int e = 0; e < 8; ++e) y[e] = sigmoidf_(op[e]) * o[e] * rs * w[e] * siluf_(z[e]);
            }
            *(u32x4*)(Y + (size_t)tok * 2048 + ch0) = pack8(y);
        }
    }
}

__device__ __forceinline__ void phase_prep_odd(KP P, const Ctx& C) {
    bf16_t* proj = WSP(bf16_t, WS_PROJ); const float* G = WSP(float, WS_GATES); float* AL = WSP(float, WS_ALPHA); const f32x2* rope = WSP(f32x2, WS_ROPE);
    const float* w2 = P->in[24]; const float* b2 = P->in[25]; const int lane = C.lane;
    for (int tok = C.gw; tok < NTOK; tok += C.ngw) {
        const bool isP = tok < NTP; const int t = isP ? (tok & 2047) : 2048;
        float g[16];
#pragma unroll
        for (int r4 = 0; r4 < 4; ++r4) { const f32x4 gv = *(const f32x4*)(G + (size_t)tok * 16 + r4 * 4); g[r4 * 4] = gv.x; g[r4 * 4 + 1] = gv.y; g[r4 * 4 + 2] = gv.z; g[r4 * 4 + 3] = gv.w; }
        float x[8];
#pragma unroll
        for (int e = 0; e < 8; ++e) x[e] = b2[lane * 8 + e];
#pragma unroll
        for (int r = 0; r < 16; ++r) { const f32x4 wa = *(const f32x4*)(w2 + r * 512 + lane * 8), wb = *(const f32x4*)(w2 + r * 512 + lane * 8 + 4);
            x[0] += g[r] * wa.x; x[1] += g[r] * wa.y; x[2] += g[r] * wa.z; x[3] += g[r] * wa.w; x[4] += g[r] * wb.x; x[5] += g[r] * wb.y; x[6] += g[r] * wb.z; x[7] += g[r] * wb.w; }
        f32x4 a0, a1;
        a0.x = gla_alpha_(x[0]); a0.y = gla_alpha_(x[1]); a0.z = gla_alpha_(x[2]); a0.w = gla_alpha_(x[3]);
        a1.x = gla_alpha_(x[4]); a1.y = gla_alpha_(x[5]); a1.z = gla_alpha_(x[6]); a1.w = gla_alpha_(x[7]);
        *(f32x4*)(AL + (size_t)tok * 512 + lane * 8) = a0; *(f32x4*)(AL + (size_t)tok * 512 + lane * 8 + 4) = a1;
        const f32x2 cs = rope[t * 64 + lane];
        bf16_t* pr = proj + (size_t)tok * PO_MAIN;
#pragma unroll
        for (int h = 0; h < 4; ++h) {
            { bf16_t* q = pr + O_QD + h * 128; const float x1 = bf1(q[lane]), x2 = bf1(q[64 + lane]);
              const unsigned o = pk2(x1 * cs.x - x2 * cs.y, x1 * cs.y + x2 * cs.x); q[lane] = (bf16_t)(o & 0xffffu); q[64 + lane] = (bf16_t)(o >> 16); }
            { bf16_t* k = pr + O_KD + h * 128; const float x1 = bf1(k[lane]) * 0.08838834764831845f, x2 = bf1(k[64 + lane]) * 0.08838834764831845f;
              const unsigned o = pk2(x1 * cs.x - x2 * cs.y, x1 * cs.y + x2 * cs.x); k[lane] = (bf16_t)(o & 0xffffu); k[64 + lane] = (bf16_t)(o >> 16); }
        }
    }
}

template <bool GLA> __device__ __forceinline__ void odd_sample_item(KP P, int idx, int lane) {
    const int si = idx >> 2, h = idx & 3, tok = NTP + si;
    const float* Sin = P->in[GLA ? 9 : 10] + (size_t)idx * 128 * 256; float* Sout = P->out + (GLA ? OUT_SGLA : OUT_SRET) + (size_t)idx * 128 * 256;
    const bf16_t* pr = WSP(bf16_t, WS_PROJ) + (size_t)tok * PO_MAIN;
    const unsigned kpk = *(const unsigned*)(pr + (GLA ? O_KC : O_KD) + h * 128 + 2 * lane), qpk = *(const unsigned*)(pr + (GLA ? O_QC : O_QD) + h * 128 + 2 * lane);
    const u32x2 vpk = *(const u32x2*)(pr + (GLA ? O_VC : O_VD) + h * 256 + 4 * lane);
    const f32x4 v = {bflo(vpk.x), bfhi(vpk.x), bflo(vpk.y), bfhi(vpk.y)};
    const float gam = 1.f - exp2f(-5.f - (float)h);
    f32x2 alp = {gam, gam};
    if (GLA) alp = *(const f32x2*)(WSP(float, WS_ALPHA) + (size_t)tok * 512 + h * 128 + 2 * lane);
    f32x4 o = {0.f, 0.f, 0.f, 0.f};
#pragma unroll 8
    for (int d2 = 0; d2 < 64; ++d2) { const unsigned ku = rdlu(kpk, d2), qu = rdlu(qpk, d2); const float a0 = rdl(alp.x, d2), a1 = rdl(alp.y, d2);
        const f32x4 s0 = *(const f32x4*)(Sin + (size_t)(2 * d2) * 256 + 4 * lane), s1 = *(const f32x4*)(Sin + (size_t)(2 * d2 + 1) * 256 + 4 * lane);
        const f32x4 n0 = s0 * a0 + v * bflo(ku), n1 = s1 * a1 + v * bfhi(ku);
        *(f32x4*)(Sout + (size_t)(2 * d2) * 256 + 4 * lane) = n0; *(f32x4*)(Sout + (size_t)(2 * d2 + 1) * 256 + 4 * lane) = n1;
        o += n0 * bflo(qu) + n1 * bfhi(qu); }
    if (GLA) o *= 0.08838834764831845f;
    u32x2 op; op.x = pk2(o.x, o.y); op.y = pk2(o.z, o.w);
    *(u32x2*)(WSP(bf16_t, WS_Y) + (size_t)tok * 2048 + (GLA ? 0 : 1024) + h * 256 + 4 * lane) = op;
}

__device__ __forceinline__ void phase_rec_odd(KP P, const Ctx& C) {
    const int lane = C.lane;
    { const int slot = C.bid * 4 + (C.wave & 3), nslot = C.nblk * 4;
        if (C.wave < 4) { for (int g = slot; g < 1024; g += nslot) rec_item<2, 8, 8>(P, g, lane); }
        else { for (int g = slot; g < 1024; g += nslot) rec_item<3, 8, 8>(P, g, lane); } }
    unsigned* ctr = WSP(unsigned, WS_CTL) + 64;
    for (;;) {
        int idx = 0; if (lane == 0) idx = (int)atomicAdd(ctr, 1u);
        idx = __builtin_amdgcn_readfirstlane(idx);
        if (idx >= 1024) break;
        if (idx < 512) odd_sample_item<true>(P, idx, lane); else odd_sample_item<false>(P, idx - 512, lane);
    }
}

__device__ __forceinline__ void phase_post_odd(KP P, const Ctx& C) {
    bf16_t* Y = WSP(bf16_t, WS_Y); const bf16_t* proj = WSP(bf16_t, WS_PROJ); const int lane = C.lane;
    for (int tok = C.gw; tok < NTOK; tok += C.ngw) {
#pragma unroll
        for (int i = 0; i < 4; ++i) { const int ch0 = i * 512 + lane * 8; float o[8], z[8], y[8];
            unpack8(*(const u32x4*)(Y + (size_t)tok * 2048 + ch0), o); unpack8(*(const u32x4*)(proj + (size_t)tok * PO_MAIN + O_Z + ch0), z);
            float ss = 0.f;
#pragma unroll
            for (int e = 0; e < 8; ++e) ss += o[e] * o[e];
            ss = ar32(ss); const float rs = rsqrtf(ss * (1.f / 256.f) + EPS); const float* w = P->in[i < 2 ? 26 : 27] + (ch0 & 255);
#pragma unroll
            for (int e = 0; e < 8; ++e) y[e] = o[e] * rs * w[e] * siluf_(z[e]);
            *(u32x4*)(Y + (size_t)tok * 2048 + ch0) = pack8(y);
        }
    }
}

__device__ __forceinline__ void phase_final(KP P, const Ctx& C) {
    const float* fw = P->in[28];
    for (int tok = C.gw; tok < NTOK; tok += C.ngw) {
        float* xr = P->out + (size_t)tok * DM; f32x4 v[4]; float ss = 0.f;
#pragma unroll
        for (int j = 0; j < 4; ++j) { v[j] = ((const f32x4*)xr)[C.lane + 64 * j]; ss += v[j].x * v[j].x + v[j].y * v[j].y + v[j].z * v[j].z + v[j].w * v[j].w; }
        ss = ar64(ss); const float rstd = rsqrtf(ss * (1.f / 1024.f) + EPS);
#pragma unroll
        for (int j = 0; j < 4; ++j) { const int idx = (C.lane + 64 * j) * 4; ((f32x4*)xr)[C.lane + 64 * j] = v[j] * rstd * *(const f32x4*)(fw + idx); }
    }
}

__device__ __forceinline__ void sample_outproj(KP P, const Ctx& C, int layer) {
    const bf16_t* Y = WSP(bf16_t, WS_Y) + (size_t)NTP * 2048; const bf16_t* W = WSP(bf16_t, layer == 0 ? WS_WOUT0 : WS_WOUT1);
    const float* mod = WSP(float, WS_MOD); LAS float* red = (LAS float*)C.lds;
    const int lane = C.lane, w = C.wave;
    for (int task = C.bid; task < 256; task += C.nblk) {
        const int r0 = (task >> 5) * 16, c0 = (task & 31) * 32;
        f32x4 acc0 = {0.f, 0.f, 0.f, 0.f}, acc1 = acc0;
        const bf16_t* ap = Y + (size_t)(r0 + (lane & 15)) * 2048 + w * 256 + (lane >> 4) * 8;
        const bf16_t* bp0 = W + (size_t)(c0 + (lane & 15)) * 2048 + w * 256 + (lane >> 4) * 8; const bf16_t* bp1 = bp0 + (size_t)16 * 2048;
#pragma unroll
        for (int ks = 0; ks < 8; ++ks) { const bf16x8 a = *(const bf16x8*)(ap + ks * 32), b0 = *(const bf16x8*)(bp0 + ks * 32), b1 = *(const bf16x8*)(bp1 + ks * 32);
            acc0 = __builtin_amdgcn_mfma_f32_16x16x32_bf16(a, b0, acc0, 0, 0, 0); acc1 = __builtin_amdgcn_mfma_f32_16x16x32_bf16(a, b1, acc1, 0, 0, 0); }
        __syncthreads();
        *(LAS f32x4*)(red + ((w * 2 + 0) * 64 + lane) * 4) = acc0; *(LAS f32x4*)(red + ((w * 2 + 1) * 64 + lane) * 4) = acc1;
        __syncthreads();
        { const int e = C.tid, tile = e >> 8, idx = e & 255, ln = idx >> 2, j = idx & 3; float sum = 0.f;
#pragma unroll
          for (int ww = 0; ww < 8; ++ww) sum += red[((ww * 2 + tile) * 64 + ln) * 4 + j];
          const int row = r0 + (ln >> 4) * 4 + j, col = c0 + tile * 16 + (ln & 15);
          const float xin = layer == 0 ? P->in[1][(size_t)row * DM + col] : P->out[(size_t)(NTP + row) * DM + col];
          const float gt = mod[(size_t)(8 + row) * 6144 + layer * 3072 + 2048 + col];
          P->out[(size_t)(NTP + row) * DM + col] = xin + gt * sum; }
    }
    __syncthreads();
}

#define XB_XCNT(j)  (256  + 64 * (j))
#define XB_XSUB(j)  (1280 + 64 * (j))
#define XB_XGEN(j)  (2304 + 64 * (j))
#define XB_TOP      3328
#define XB_TOPGEN   3392
__device__ __forceinline__ unsigned xb_ld(unsigned* p) { return __hip_atomic_load(p, __ATOMIC_RELAXED, __HIP_MEMORY_SCOPE_AGENT); }
__device__ __forceinline__ unsigned xb_add(unsigned* p, unsigned v) { return __hip_atomic_fetch_add(p, v, __ATOMIC_RELAXED, __HIP_MEMORY_SCOPE_AGENT); }
__device__ __forceinline__ unsigned xb_xcc_id() { return (unsigned)__builtin_amdgcn_s_getreg((3 << 11) | 20) & 0xFu; }
__device__ __forceinline__ void xcd_bar(unsigned* bar, volatile unsigned* st) {
    asm volatile("s_waitcnt vmcnt(0)" ::: "memory");
    __syncthreads();
    if (threadIdx.x == 0) {
        __builtin_amdgcn_s_waitcnt(0);
        const unsigned x = xb_xcc_id();
        unsigned nloc = st[0], nx = st[1];
        if (nloc == 0u) {
            unsigned cnt, mine, sum;
            for (;;) { cnt = 0u; mine = 0u; sum = 0u;
#pragma unroll
                for (unsigned j = 0; j < 16; ++j) { const unsigned c = xb_ld(&bar[XB_XCNT(j)]); sum += c; cnt += (c > 0u) ? 1u : 0u; mine = (j == x) ? c : mine; }
                if (sum == gridDim.x) break;
                __builtin_amdgcn_s_sleep(1); }
            nloc = mine > 0u ? mine : 1u; nx = cnt > 0u ? cnt : 1u; st[0] = nloc; st[1] = nx;
        }
        const unsigned old = xb_add(&bar[XB_XSUB(x)], 1u);
        const unsigned gen = old / nloc;
        if (old + 1u == (gen + 1u) * nloc) {
            __builtin_amdgcn_fence(__ATOMIC_RELEASE, "agent");
            asm volatile("s_waitcnt vmcnt(0)" ::: "memory");
            const unsigned og = xb_add(&bar[XB_TOP], 1u);
            const unsigned tg = og / nx;
            if (og + 1u == (tg + 1u) * nx) xb_add(&bar[XB_TOPGEN], 1u);
            else { while (xb_ld(&bar[XB_TOPGEN]) == tg) __builtin_amdgcn_s_sleep(1); }
            __builtin_amdgcn_fence(__ATOMIC_ACQUIRE, "agent");
            xb_add(&bar[XB_XGEN(x)], 1u);
            asm volatile("s_waitcnt vmcnt(0)" ::: "memory");
        } else {
            while (xb_ld(&bar[XB_XGEN(x)]) == gen) __builtin_amdgcn_s_sleep(1);
            __builtin_amdgcn_fence(__ATOMIC_ACQUIRE, "agent");
            asm volatile("s_waitcnt vmcnt(0)" ::: "memory");
        }
    }
    __syncthreads();
}

#ifndef PH_MASK
#define PH_MASK 0x7fff
#endif
#define PH_ON(n) (((PH_MASK) >> (n)) & 1)
#ifndef PH_REP
#define PH_REP 0
#endif
#define PH_RP(n) (((PH_REP) >> (n)) & 1)
constexpr int NPHASE = 15;
__global__ void __launch_bounds__(512, 2) fwd_megakernel(Params PV) {
    extern __shared__ __attribute__((aligned(16))) unsigned char shm[];
    __shared__ __attribute__((aligned(16))) unsigned xb_st[4];
    Ctx C; C.lds = (LAS unsigned char*)shm;
    if (threadIdx.x == 0) { xb_st[0] = 0u; xb_st[1] = 0u; if (PV.ph_hi - PV.ph_lo > 1) (void)xb_add(((unsigned*)PV.ws) + XB_XCNT(xb_xcc_id()), 1u); }
    __syncthreads();
    for (int ph = PV.ph_lo; ph < PV.ph_hi; ++ph) {
        KP P = (KP)__builtin_amdgcn_kernarg_segment_ptr(); asm volatile("" : "+s"(P));
        { int tid = threadIdx.x; asm volatile("" : "+v"(tid)); int bid = blockIdx.x; asm volatile("" : "+s"(bid)); int nblk = gridDim.x; asm volatile("" : "+s"(nblk));
          C.tid = tid; C.bid = bid; C.nblk = nblk; C.lane = tid & 63; C.wave = __builtin_amdgcn_readfirstlane(tid >> 6); C.gw = bid * 8 + C.wave; C.ngw = nblk * 8; }
        const bool is_gemm = (ph == 1 || ph == 3 || ph == 7 || ph == 9 || ph == 13);
        if (is_gemm && PH_ON(1)) {
            pg8::Gemm g; pg8::Epi E; E.kind = 0; E.mod = WSP(float, WS_MOD); E.ada_b = P->in[12]; E.P = WSP(bf16_t, WS_PROJ); E.ldp = PE_MAIN; E.ntile_main = 32; E.G = WSP(float, WS_GATES); E.ng = 32;
            E.xp = P->in[0]; E.xs = P->in[1]; E.xo = P->out; E.gate = WSP(float, WS_MOD); E.layer = 0;
            if (ph == 1) { g.A = WSP(bf16_t, WS_CBF); g.Bt = WSP(bf16_t, WS_ADAT); g.M = 256; g.N = 6144; g.K = 1024; E.kind = 0; }
            else if (ph == 3) { g.A = DOP(bf16_t, DO_HBUF); g.Bt = WSP(bf16_t, WS_WIN0); g.M = MPAD; g.N = PE_PAD; g.K = 1024; E.kind = 1; }
            else if (ph == 7) { g.A = WSP(bf16_t, WS_Y); g.Bt = WSP(bf16_t, WS_WOUT0); g.M = NTP; g.N = 1024; g.K = 2048; E.kind = 2; E.layer = 0; }
            else if (ph == 9) { g.A = DOP(bf16_t, DO_HBUF); g.Bt = WSP(bf16_t, WS_WIN1); g.M = MPAD; g.N = PO_PAD; g.K = 1024; E.kind = 1; E.ldp = PO_MAIN; E.ntile_main = 24; E.ng = 16; }
            else { g.A = WSP(bf16_t, WS_Y); g.Bt = WSP(bf16_t, WS_WOUT1); g.M = NTP; g.N = 1024; g.K = 2048; E.kind = 2; E.layer = 1; }
            pg8::StaticOrder S; S.init(g.M, g.N, C.nblk, C.bid);
            for (int rep = 0; rep < 1 + PH_RP(ph); ++rep) { asm volatile("" : "+s"(rep)); pg8::gemm_phase(C.lds, g, S, E, C.tid); }
            if (E.kind == 2) sample_outproj(P, C, E.layer);
            if (ph == 1) { if (C.nblk > 24) { if (C.bid >= 24) prep_weights(P, C, (C.bid - 24) * 8 + C.wave, (C.nblk - 24) * 8); } else prep_weights(P, C, C.gw, C.ngw); }
        } else {
            switch (ph) {
                case 0: if (PH_ON(0)) phase_prep0(P, C); if (PH_RP(0)) { asm volatile("" : "+s"(P)); phase_prep0(P, C); } break;
                case 2: if (PH_ON(2)) phase_hnorm(P, C, 0); if (PH_RP(2)) { asm volatile("" : "+s"(P)); phase_hnorm(P, C, 0); } break;
                case 4: if (PH_ON(4)) phase_prep_even(P, C); if (PH_RP(4)) { asm volatile("" : "+s"(P)); phase_prep_even(P, C); } break;
                case 5: if (PH_ON(5)) phase_rec_even(P, C); if (PH_RP(5)) { asm volatile("" : "+s"(P)); phase_rec_even(P, C); } break;
                case 6: if (PH_ON(6)) phase_post_even(P, C); break;
                case 8: if (PH_ON(8)) phase_hnorm(P, C, 1); if (PH_RP(8)) { asm volatile("" : "+s"(P)); phase_hnorm(P, C, 1); } break;
                case 10: if (PH_ON(10)) phase_prep_odd(P, C); break;
                case 11: if (PH_ON(11)) phase_rec_odd(P, C); if (PH_RP(11)) { asm volatile("" : "+s"(P)); phase_rec_odd(P, C); } break;
                case 12: if (PH_ON(12)) phase_post_odd(P, C); break;
                case 14: if (PH_ON(14)) phase_final(P, C); break;
                default: break;
            }
        }
        if (ph + 1 < PV.ph_hi) {
            if (PV.ph_lo > 0 && ph == PV.ph_lo) cg::this_grid().sync();
            else xcd_bar(WSP(unsigned, WS_CTL), xb_st);
        }
    }
}

extern "C" void kernel_launch(void* const* d_in, const int* in_sizes, int n_in, void* d_out, int out_size, void* d_ws, size_t ws_size, hipStream_t stream) {
    constexpr size_t kDynLds = 131072;
    static int grid_blocks = 0;
    if (!grid_blocks) {
        if (n_in != 29 || ws_size < WS_END) { fprintf(stderr, "kernel_launch: unexpected n_in %d or ws_size %zu (need %zu)\n", n_in, ws_size, (size_t)WS_END); }
        int dev = 0, cus = 0, per_cu = 0;
        hipGetDevice(&dev);
        hipDeviceGetAttribute(&cus, hipDeviceAttributeMultiprocessorCount, dev);
        hipFuncSetAttribute((const void*)fwd_megakernel, hipFuncAttributeMaxDynamicSharedMemorySize, (int)kDynLds);
        hipOccupancyMaxActiveBlocksPerMultiprocessor(&per_cu, (const void*)fwd_megakernel, 512, kDynLds);
        if (per_cu < 1) { fprintf(stderr, "kernel_launch: occupancy query says %d blocks/CU\n", per_cu); per_cu = 1; }
        if (per_cu > 1) per_cu = 1;
        grid_blocks = cus * per_cu;
        (void)hipGetLastError();
    }
    hipMemsetAsync((char*)d_ws + WS_CTL, 0, 16384, stream);
    Params p{};
    for (int i = 0; i < 29; ++i) p.in[i] = (const float*)d_in[i];
    p.out = (float*)d_out; p.ws = (unsigned char*)d_ws;
#if MK_SPLIT
    for (int ph = 0; ph < NPHASE; ++ph) { p.ph_lo = ph; p.ph_hi = ph + 1;
        hipLaunchKernelGGL(fwd_megakernel, dim3(grid_blocks), dim3(512), kDynLds, stream, p); }
#else
    p.ph_lo = 0; p.ph_hi = NPHASE;
    void* args[] = {&p};
    hipError_t e = hipLaunchCooperativeKernel((const void*)fwd_megakernel, dim3(grid_blocks), dim3(512), args, kDynLds, stream);
    if (e != hipSuccess) fprintf(stderr, "cooperative launch failed: %s (grid %d)\n", hipGetErrorString(e), grid_blocks);
#endif
}
```

```cpp
#include <hip/hip_runtime.h>
#include <hip/hip_cooperative_groups.h>
#include <cstdio>
#include <cstdint>
namespace cg = cooperative_groups;

#ifndef MK_SPLIT
#define MK_SPLIT 0
#endif

#define LAS __attribute__((address_space(3)))
typedef unsigned short bf16_t;
typedef short bf16x8 __attribute__((ext_vector_type(8)));
typedef float f32x4 __attribute__((ext_vector_type(4)));
typedef float f32x2 __attribute__((ext_vector_type(2)));
typedef float f32x3 __attribute__((ext_vector_type(3)));
typedef unsigned u32x4 __attribute__((ext_vector_type(4)));
typedef unsigned u32x2 __attribute__((ext_vector_type(2)));

constexpr int DM = 1024, NTP = 16384, NTS = 128, NTOK = NTP + NTS, MPAD = 16640, TSEQ = 2048;
constexpr int NSEQ = 136;
constexpr float EPS = 1e-6f;
constexpr int PE_MAIN = 8192, PE_PAD = 8448, PO_MAIN = 6144, PO_PAD = 6400;
constexpr int E_QA = 0, E_KA = 1024, E_VA = 2048, E_QB = 3072, E_KB = 3584, E_VB = 4096, E_OP = 5120, E_Z = 6144;
constexpr int O_QC = 0, O_KC = 512, O_VC = 1024, O_QD = 2048, O_KD = 2560, O_VD = 3072, O_Z = 4096;
constexpr size_t OUT_Y = 0, OUT_PGDN = 16908288, OUT_PCONV = 17956864, OUT_PMC = 18030592, OUT_PMN = 18554880, OUT_PMM = 18558976,
                 OUT_PGLA = 18559040, OUT_PRET = 19607616, OUT_SGDN = 20656192, OUT_SCONV = 37433408, OUT_SMC = 38613056,
                 OUT_SMN = 47001664, OUT_SMM = 47067200, OUT_SGLA = 47068224, OUT_SRET = 63845440;
constexpr size_t WS_CTL = 0, WS_WIN0 = 16384, WS_WOUT0 = WS_WIN0 + (size_t)PE_PAD * 1024 * 2, WS_WIN1 = WS_WOUT0 + (size_t)1024 * 2048 * 2,
                 WS_WOUT1 = WS_WIN1 + (size_t)PO_PAD * 1024 * 2, WS_ADAT = WS_WOUT1 + (size_t)1024 * 2048 * 2, WS_CBF = WS_ADAT + (size_t)6144 * 1024 * 2,
                 WS_MOD = WS_CBF + (size_t)256 * 1024 * 2, WS_ROPE = WS_MOD + (size_t)NSEQ * 6144 * 4, WS_GATES = WS_ROPE + 1049600,
                 WS_GA = WS_GATES + (size_t)NTOK * 32 * 4, WS_GB = WS_GA + (size_t)NTOK * 32 * 4, WS_PROJ = WS_GB + (size_t)NTOK * 32 * 4,
                 WS_Y = WS_PROJ + (size_t)NTOK * PE_MAIN * 2, WS_END = WS_Y + (size_t)MPAD * 2048 * 2;
constexpr size_t WS_ALPHA = WS_PROJ + (size_t)NTOK * PO_MAIN * 2;
constexpr size_t DO_ABUF = OUT_SGLA * 4;
constexpr size_t DO_HBUF = OUT_SRET * 4 + (size_t)67108864 - (size_t)MPAD * 1024 * 2;

struct Params {
    const float* in[29];
    float* out;
    unsigned char* ws;
    int ph_lo, ph_hi;
};

__device__ __forceinline__ float bflo(unsigned u) { return __uint_as_float(u << 16); }
__device__ __forceinline__ float bfhi(unsigned u) { return __uint_as_float(u & 0xffff0000u); }
__device__ __forceinline__ float bf1(bf16_t b) { return __uint_as_float(((unsigned)b) << 16); }
__device__ __forceinline__ unsigned pk2(float lo, float hi) { unsigned r; asm("v_cvt_pk_bf16_f32 %0, %1, %2" : "=v"(r) : "v"(lo), "v"(hi)); return r; }
__device__ __forceinline__ void unpack8(u32x4 p, float* f) {
    f[0] = bflo(p.x); f[1] = bfhi(p.x); f[2] = bflo(p.y); f[3] = bfhi(p.y); f[4] = bflo(p.z); f[5] = bfhi(p.z); f[6] = bflo(p.w); f[7] = bfhi(p.w);
}
__device__ __forceinline__ u32x4 pack8(const float* f) { u32x4 o; o.x = pk2(f[0], f[1]); o.y = pk2(f[2], f[3]); o.z = pk2(f[4], f[5]); o.w = pk2(f[6], f[7]); return o; }
template <int CTRL> __device__ __forceinline__ float dppf(float x) { return __int_as_float(__builtin_amdgcn_update_dpp(0, __float_as_int(x), CTRL, 0xf, 0xf, true)); }
__device__ __forceinline__ float ar4(float x) { x += dppf<0xB1>(x); x += dppf<0x4E>(x); return x; }
__device__ __forceinline__ float ar8(float x) { x = ar4(x); x += dppf<0x141>(x); return x; }
__device__ __forceinline__ void ar8x4(float& a, float& b, float& c, float& d) {
    asm volatile(
        "s_nop 1\n\t"
        "v_add_f32_dpp %0, %0, %0 quad_perm:[1,0,3,2] row_mask:0xf bank_mask:0xf bound_ctrl:1\n\t"
        "v_add_f32_dpp %1, %1, %1 quad_perm:[1,0,3,2] row_mask:0xf bank_mask:0xf bound_ctrl:1\n\t"
        "v_add_f32_dpp %2, %2, %2 quad_perm:[1,0,3,2] row_mask:0xf bank_mask:0xf bound_ctrl:1\n\t"
        "v_add_f32_dpp %3, %3, %3 quad_perm:[1,0,3,2] row_mask:0xf bank_mask:0xf bound_ctrl:1\n\t"
        "v_add_f32_dpp %0, %0, %0 quad_perm:[2,3,0,1] row_mask:0xf bank_mask:0xf bound_ctrl:1\n\t"
        "v_add_f32_dpp %1, %1, %1 quad_perm:[2,3,0,1] row_mask:0xf bank_mask:0xf bound_ctrl:1\n\t"
        "v_add_f32_dpp %2, %2, %2 quad_perm:[2,3,0,1] row_mask:0xf bank_mask:0xf bound_ctrl:1\n\t"
        "v_add_f32_dpp %3, %3, %3 quad_perm:[2,3,0,1] row_mask:0xf bank_mask:0xf bound_ctrl:1\n\t"
        "v_add_f32_dpp %0, %0, %0 row_half_mirror row_mask:0xf bank_mask:0xf bound_ctrl:1\n\t"
        "v_add_f32_dpp %1, %1, %1 row_half_mirror row_mask:0xf bank_mask:0xf bound_ctrl:1\n\t"
        "v_add_f32_dpp %2, %2, %2 row_half_mirror row_mask:0xf bank_mask:0xf bound_ctrl:1\n\t"
        "v_add_f32_dpp %3, %3, %3 row_half_mirror row_mask:0xf bank_mask:0xf bound_ctrl:1\n\t"
        : "+v"(a), "+v"(b), "+v"(c), "+v"(d));
}
__device__ __forceinline__ void ar16x4(float& a, float& b, float& c, float& d) {
    asm volatile(
        "s_nop 1\n\t"
        "v_add_f32_dpp %0, %0, %0 quad_perm:[1,0,3,2] row_mask:0xf bank_mask:0xf bound_ctrl:1\n\t"
        "v_add_f32_dpp %1, %1, %1 quad_perm:[1,0,3,2] row_mask:0xf bank_mask:0xf bound_ctrl:1\n\t"
        "v_add_f32_dpp %2, %2, %2 quad_perm:[1,0,3,2] row_mask:0xf bank_mask:0xf bound_ctrl:1\n\t"
        "v_add_f32_dpp %3, %3, %3 quad_perm:[1,0,3,2] row_mask:0xf bank_mask:0xf bound_ctrl:1\n\t"
        "v_add_f32_dpp %0, %0, %0 quad_perm:[2,3,0,1] row_mask:0xf bank_mask:0xf bound_ctrl:1\n\t"
        "v_add_f32_dpp %1, %1, %1 quad_perm:[2,3,0,1] row_mask:0xf bank_mask:0xf bound_ctrl:1\n\t"
        "v_add_f32_dpp %2, %2, %2 quad_perm:[2,3,0,1] row_mask:0xf bank_mask:0xf bound_ctrl:1\n\t"
        "v_add_f32_dpp %3, %3, %3 quad_perm:[2,3,0,1] row_mask:0xf bank_mask:0xf bound_ctrl:1\n\t"
        "v_add_f32_dpp %0, %0, %0 row_half_mirror row_mask:0xf bank_mask:0xf bound_ctrl:1\n\t"
        "v_add_f32_dpp %1, %1, %1 row_half_mirror row_mask:0xf bank_mask:0xf bound_ctrl:1\n\t"
        "v_add_f32_dpp %2, %2, %2 row_half_mirror row_mask:0xf bank_mask:0xf bound_ctrl:1\n\t"
        "v_add_f32_dpp %3, %3, %3 row_half_mirror row_mask:0xf bank_mask:0xf bound_ctrl:1\n\t"
        "v_add_f32_dpp %0, %0, %0 row_mirror row_mask:0xf bank_mask:0xf bound_ctrl:1\n\t"
        "v_add_f32_dpp %1, %1, %1 row_mirror row_mask:0xf bank_mask:0xf bound_ctrl:1\n\t"
        "v_add_f32_dpp %2, %2, %2 row_mirror row_mask:0xf bank_mask:0xf bound_ctrl:1\n\t"
        "v_add_f32_dpp %3, %3, %3 row_mirror row_mask:0xf bank_mask:0xf bound_ctrl:1\n\t"
        : "+v"(a), "+v"(b), "+v"(c), "+v"(d));
}
__device__ __forceinline__ void ar16x2(float& a, float& b) {
    asm volatile(
        "s_nop 1\n\t"
        "v_add_f32_dpp %0, %0, %0 quad_perm:[1,0,3,2] row_mask:0xf bank_mask:0xf bound_ctrl:1\n\t"
        "v_add_f32_dpp %1, %1, %1 quad_perm:[1,0,3,2] row_mask:0xf bank_mask:0xf bound_ctrl:1\n\t"
        "s_nop 0\n\t"
        "v_add_f32_dpp %0, %0, %0 quad_perm:[2,3,0,1] row_mask:0xf bank_mask:0xf bound_ctrl:1\n\t"
        "v_add_f32_dpp %1, %1, %1 quad_perm:[2,3,0,1] row_mask:0xf bank_mask:0xf bound_ctrl:1\n\t"
        "s_nop 0\n\t"
        "v_add_f32_dpp %0, %0, %0 row_half_mirror row_mask:0xf bank_mask:0xf bound_ctrl:1\n\t"
        "v_add_f32_dpp %1, %1, %1 row_half_mirror row_mask:0xf bank_mask:0xf bound_ctrl:1\n\t"
        "s_nop 0\n\t"
        "v_add_f32_dpp %0, %0, %0 row_mirror row_mask:0xf bank_mask:0xf bound_ctrl:1\n\t"
        "v_add_f32_dpp %1, %1, %1 row_mirror row_mask:0xf bank_mask:0xf bound_ctrl:1\n\t"
        : "+v"(a), "+v"(b));
}
__device__ __forceinline__ float ar16(float x) { x = ar8(x); x += dppf<0x140>(x); return x; }
__device__ __forceinline__ float ar32(float x) { x = ar16(x); x += __shfl_xor(x, 16); return x; }
__device__ __forceinline__ float ar64(float x) { x = ar32(x); x += __shfl_xor(x, 32); return x; }
__device__ __forceinline__ float sigmoidf_(float x) { return __builtin_amdgcn_rcpf(1.f + __expf(-x)); }
__device__ __forceinline__ float siluf_(float x) { return x * __builtin_amdgcn_rcpf(1.f + __expf(-x)); }
__device__ __forceinline__ float gla_alpha_(float x) { const float t = __expf(-x); const float sp = x < -15.f ? -x : __logf(1.f + t); return __expf(-sp * 0.0625f); }
__device__ __forceinline__ float softplusf_(float x) { return x > 20.f ? x : log1pf(expf(x)); }
__device__ __forceinline__ float rdl(float v, int l) { return __int_as_float(__builtin_amdgcn_readlane(__float_as_int(v), l)); }
__device__ __forceinline__ unsigned rdlu(unsigned v, int l) { return (unsigned)__builtin_amdgcn_readlane((int)v, l); }

__device__ __forceinline__ int map_even(int c) { if (c < 3072) return c; if (c < 5120) return c + 16; if (c < 8192) return c + 32; if (c < 8208) return c - 8192 + 3072; if (c < 8224) return c - 8208 + 5136; return -1; }
__device__ __forceinline__ int map_odd(int c) { if (c < 2048) return c; if (c < 6144) return c + 16; if (c < 6160) return c - 6144 + 2048; return -1; }

namespace pg8 {
constexpr int BM = 256, BK = 64, HALF = 128, HTB = HALF * BK * 2, STAGE_BYTES = 8 * HTB, NXCD = 8, WGM = 8;
__device__ __forceinline__ int lds_byte(int r, int c) { const int st = (r >> 4) * 2 + (c >> 5), rr = r & 15, cc = c & 31, ob = rr * 64 + cc * 2; return st * 1024 + (ob ^ (((ob >> 9) & 1) << 5)); }
__device__ __forceinline__ void stage_rc(int b, int& R, int& C) { const int st = b / 1024, sb = b % 1024, swz = sb ^ (((sb >> 9) & 1) << 5); R = (st >> 1) * 16 + swz / 64; C = (st & 1) * 32 + (swz % 64) / 2; }
struct Unit { int pm, pn; };
struct Gemm { const bf16_t* A; const bf16_t* Bt; int M, N, K; };
struct StaticOrder {
    int nM, nN, nwg, G, c;
    __device__ void init(int M, int N, int G_, int c_) { nM = M / BM; nN = N / BM; nwg = nM * nN; G = G_; c = c_; }
    __device__ bool next(int i, Unit& u) const {
        const long L = (long)i * G + c; if (L >= nwg) return false;
        int wgid = (int)L; { const int q = nwg / NXCD, r = nwg % NXCD, xcd = wgid % NXCD, off = wgid / NXCD; wgid = (xcd < r ? xcd * (q + 1) : r * (q + 1) + (xcd - r) * q) + off; }
        const int nig = WGM * nN, gid = wgid / nig, fm = gid * WGM, gsz = (nM - fm) < WGM ? (nM - fm) : WGM;
        u.pm = fm + ((wgid % nig) % gsz); u.pn = (wgid % nig) / gsz; return true;
    }
};

struct Epi {
    int kind;
    float* mod; const float* ada_b;
    bf16_t* P; int ldp; int ntile_main; float* G; int ng;
    const float* xp; const float* xs; float* xo; const float* gate; int layer;
    __device__ __forceinline__ void operator()(const f32x4 (&acc)[2][2][4][2], const Unit& u, int wr, int wc, int fr, int fq) const {
        const int row0 = u.pm * BM + wr * 64 + fr;
        const int col0 = u.pn * BM + wc * 32 + 8 * fq;
        if (kind == 0) {
#pragma unroll
            for (int ai = 0; ai < 2; ++ai)
#pragma unroll
                for (int m = 0; m < 4; ++m) { const int row = row0 + ai * HALF + m * 16;
                    if (row < NSEQ) {
#pragma unroll
                        for (int bj = 0; bj < 2; ++bj)
#pragma unroll
                            for (int n = 0; n < 2; ++n) { const int c = col0 + bj * HALF + n * 4; const f32x4 b = *(const f32x4*)(ada_b + c);
                                *(f32x4*)(mod + (size_t)row * 6144 + c) = acc[ai][bj][m][n] + b; } } }
        } else if (kind == 1) {
            if (u.pn < ntile_main) {
#pragma unroll
                for (int ai = 0; ai < 2; ++ai)
#pragma unroll
                    for (int m = 0; m < 4; ++m) { const int row = row0 + ai * HALF + m * 16;
                        if (row < NTOK) { bf16_t* rowp = P + (size_t)row * ldp + col0;
#pragma unroll
                            for (int bj = 0; bj < 2; ++bj) { const f32x4 v0 = acc[ai][bj][m][0], v1 = acc[ai][bj][m][1]; u32x4 o;
                                o.x = pk2(v0[0], v0[1]); o.y = pk2(v0[2], v0[3]); o.z = pk2(v1[0], v1[1]); o.w = pk2(v1[2], v1[3]);
                                *(u32x4*)(rowp + bj * HALF) = o; } } }
            } else {
#pragma unroll
                for (int ai = 0; ai < 2; ++ai)
#pragma unroll
                    for (int m = 0; m < 4; ++m) { const int row = row0 + ai * HALF + m * 16;
#pragma unroll
                        for (int bj = 0; bj < 2; ++bj)
#pragma unroll
                            for (int n = 0; n < 2; ++n) { const int c = bj * HALF + wc * 32 + 8 * fq + 4 * n;
                                if (row < NTOK && c < ng) *(f32x4*)(G + (size_t)row * ng + c) = acc[ai][bj][m][n]; } }
            }
        } else {
#pragma unroll
            for (int ai = 0; ai < 2; ++ai)
#pragma unroll
                for (int m = 0; m < 4; ++m) { const int row = row0 + ai * HALF + m * 16;
                    if (row < NTOK) {
                        const int seq = row < NTP ? (row >> 11) : (8 + row - NTP);
                        const float* xin = layer == 0 ? (row < NTP ? xp + (size_t)row * DM : xs + (size_t)(row - NTP) * DM) : xo + (size_t)row * DM;
                        const float* gp = gate + (size_t)seq * 6144 + layer * 3072 + 2048;
                        float* xw = xo + (size_t)row * DM;
#pragma unroll
                        for (int bj = 0; bj < 2; ++bj)
#pragma unroll
                            for (int n = 0; n < 2; ++n) { const int c = col0 + bj * HALF + n * 4;
                                const f32x4 xv = *(const f32x4*)(xin + c), gv = *(const f32x4*)(gp + c);
                                *(f32x4*)(xw + c) = xv + gv * acc[ai][bj][m][n]; } } }
        }
    }
};

__device__ __forceinline__ void gemm_phase(LAS unsigned char* lds, const Gemm g, const StaticOrder& S, const Epi& E, const int tid) {
    const int wid = __builtin_amdgcn_readfirstlane(tid >> 6), lane = tid & 63, wr = wid >> 2, wc = wid & 3, fr = lane & 15, fq = lane >> 4;
    const int K = g.K, nt = K / BK;
    unsigned voffA[2], voffB[2];
#pragma unroll
    for (int i = 0; i < 2; ++i) { int R, C; stage_rc(tid * 16 + i * 8192, R, C); voffA[i] = (unsigned)(R * K + C) * 2u;
        const int rho = R & 31, Rb = (R & ~31) + 8 * ((rho & 15) >> 2) + 4 * (rho >> 4) + (rho & 3);
        voffB[i] = (unsigned)(Rb * K + C) * 2u; }
    const size_t kstep = (size_t)(BK * 2);
    const size_t hstep = (size_t)HALF * K * 2;
    const size_t tstep = 2 * hstep;
    const unsigned ldsw = (unsigned)wid * 1024u;
    const int aoff = lds_byte(wr * 64 + fr, fq * 8), boff = lds_byte(wc * 32 + fr, fq * 8);
#define PG8_SA(b, h) (((b) * 2 + (h)) * HTB)
#define PG8_SB(b, h) ((4 + (b) * 2 + (h)) * HTB)
#define PG8_STAGE(bufoff, gbase, voff) do { _Pragma("unroll") for (int _i = 0; _i < 2; ++_i) \
        __builtin_amdgcn_global_load_lds((const unsigned*)((const char*)(gbase) + (voff)[_i]), (LAS unsigned*)(lds + (bufoff) + ldsw + _i * 8192), 16, 0, 0); } while (0)
#define PG8_LDA(dst, b, h) do { _Pragma("unroll") for (int m = 0; m < 4; ++m) _Pragma("unroll") for (int k = 0; k < 2; ++k) dst[m][k] = *(const LAS bf16x8*)(lds + PG8_SA(b, h) + aoff + m * 2048 + k * 1024); } while (0)
#define PG8_LDB(dst, b, h) do { _Pragma("unroll") for (int n = 0; n < 2; ++n) _Pragma("unroll") for (int k = 0; k < 2; ++k) dst[n][k] = *(const LAS bf16x8*)(lds + PG8_SB(b, h) + boff + n * 2048 + k * 1024); } while (0)
#define PG8_MMA(ai, bj, At, Bt) do { __builtin_amdgcn_s_setprio(1); _Pragma("unroll") for (int m = 0; m < 4; ++m) _Pragma("unroll") for (int n = 0; n < 2; ++n) _Pragma("unroll") for (int k = 0; k < 2; ++k) \
        acc[ai][bj][m][n] = __builtin_amdgcn_mfma_f32_16x16x32_bf16(Bt[n][k], At[m][k], acc[ai][bj][m][n], 0, 0, 0); __builtin_amdgcn_s_setprio(0); } while (0)
#define PG8_WAIT_V(n) asm volatile("s_waitcnt vmcnt(" #n ")" ::: "memory")
#define PG8_WAIT_L(n) asm volatile("s_waitcnt lgkmcnt(" #n ")" ::: "memory")
#define PG8_BAR __builtin_amdgcn_s_barrier()
#define PG8_SCHED __builtin_amdgcn_sched_barrier(0)
    Unit cur, nxt; int ui = 0;
    if (!S.next(0, cur)) return;
    f32x4 acc[2][2][4][2];
#pragma unroll
    for (int a = 0; a < 2; ++a)
#pragma unroll
        for (int b = 0; b < 2; ++b)
#pragma unroll
            for (int m = 0; m < 4; ++m)
#pragma unroll
                for (int n = 0; n < 2; ++n) acc[a][b][m][n] = (f32x4){0.f, 0.f, 0.f, 0.f};
    bf16x8 At[4][2], B0[2][2], B1[2][2];
    const char* cA = (const char*)g.A + (size_t)cur.pm * tstep; const char* cB = (const char*)g.Bt + (size_t)cur.pn * tstep;
    PG8_STAGE(PG8_SB(0, 0), cB, voffB); PG8_STAGE(PG8_SA(0, 0), cA, voffA); PG8_STAGE(PG8_SB(0, 1), cB + hstep, voffB); PG8_STAGE(PG8_SA(0, 1), cA + hstep, voffA);
    if (wr == 1) PG8_BAR;
    PG8_WAIT_V(4); PG8_BAR;
    PG8_STAGE(PG8_SB(1, 0), cB + kstep, voffB); PG8_STAGE(PG8_SA(1, 0), cA + kstep, voffA); PG8_STAGE(PG8_SB(1, 1), cB + hstep + kstep, voffB);
    PG8_WAIT_V(6); PG8_BAR;
    for (;;) {
        const bool has_next = S.next(ui + 1, nxt);
        const char* nA = has_next ? (const char*)g.A + (size_t)nxt.pm * tstep : cA; const char* nB = has_next ? (const char*)g.Bt + (size_t)nxt.pn * tstep : cB;
        for (int t = 0; t < nt; t += 2) {
            const bool last = (t == nt - 2);
            const char* a1 = cA + (size_t)(t + 1) * kstep;
            const char* a2 = last ? nA : cA + (size_t)(t + 2) * kstep; const char* b2 = last ? nB : cB + (size_t)(t + 2) * kstep;
            const char* a3 = a2 + kstep; const char* b3 = b2 + kstep;
            PG8_LDB(B0, 0, 0); PG8_SCHED; PG8_LDA(At, 0, 0); PG8_STAGE(PG8_SA(1, 1), a1 + hstep, voffA);
            PG8_WAIT_L(8); PG8_BAR; PG8_WAIT_L(0); PG8_MMA(0, 0, At, B0); PG8_BAR; PG8_SCHED;
            PG8_LDB(B1, 0, 1); PG8_STAGE(PG8_SB(0, 0), b2, voffB);
            PG8_BAR; PG8_WAIT_L(0); PG8_MMA(0, 1, At, B1); PG8_BAR;
            PG8_LDA(At, 0, 1); PG8_STAGE(PG8_SA(0, 0), a2, voffA);
            PG8_BAR; PG8_WAIT_L(0); PG8_MMA(1, 0, At, B0); PG8_BAR; PG8_SCHED;
            PG8_STAGE(PG8_SB(0, 1), b2 + hstep, voffB);
            PG8_WAIT_V(6); PG8_BAR; PG8_MMA(1, 1, At, B1); PG8_BAR;
            PG8_LDB(B0, 1, 0); PG8_SCHED; PG8_LDA(At, 1, 0); PG8_STAGE(PG8_SA(0, 1), a2 + hstep, voffA);
            PG8_WAIT_L(8); PG8_BAR; PG8_WAIT_L(0); PG8_MMA(0, 0, At, B0); PG8_BAR; PG8_SCHED;
            PG8_LDB(B1, 1, 1); PG8_STAGE(PG8_SB(1, 0), b3, voffB);
            PG8_BAR; PG8_WAIT_L(0); PG8_MMA(0, 1, At, B1); PG8_BAR;
            PG8_LDA(At, 1, 1); PG8_STAGE(PG8_SA(1, 0), a3, voffA);
            PG8_BAR; PG8_WAIT_L(0); PG8_MMA(1, 0, At, B0); PG8_BAR; PG8_SCHED;
            PG8_STAGE(PG8_SB(1, 1), b3 + hstep, voffB);
            PG8_WAIT_V(6); PG8_BAR; PG8_MMA(1, 1, At, B1); PG8_BAR;
        }
        E(acc, cur, wr, wc, fr, fq);
        if (!has_next) break;
#pragma unroll
        for (int a = 0; a < 2; ++a)
#pragma unroll
            for (int b = 0; b < 2; ++b)
#pragma unroll
                for (int m = 0; m < 4; ++m)
#pragma unroll
                    for (int n = 0; n < 2; ++n) acc[a][b][m][n] = (f32x4){0.f, 0.f, 0.f, 0.f};
        cur = nxt; cA = nA; cB = nB; ++ui;
    }
    PG8_WAIT_V(0);
    if (wr == 0) PG8_BAR;
    PG8_BAR;
#undef PG8_SA
#undef PG8_SB
#undef PG8_STAGE
#undef PG8_LDA
#undef PG8_LDB
#undef PG8_MMA
#undef PG8_WAIT_V
#undef PG8_WAIT_L
#undef PG8_BAR
#undef PG8_SCHED
}
}

typedef const __attribute__((address_space(4))) Params* KP;
struct Ctx {
    int lane, wave, gw, ngw, bid, nblk, tid;
    LAS unsigned char* lds;
};
#define WSP(T, off) ((T*)(P->ws + (off)))
#define DOP(T, off) ((T*)((unsigned char*)P->out + (off)))

__device__ __forceinline__ void transpose_item(const float* W, int ldw, bf16_t* WT, int K, int k0, int n0, int mapkind, LAS float* scr, int lane) {
    const int n = n0 + (lane & 31);
    const int sc = mapkind == 0 ? map_even(n) : (mapkind == 1 ? map_odd(n) : n);
#pragma unroll
    for (int i = 0; i < 32; ++i) { const int kk = 2 * i + (lane >> 5); scr[kk * 33 + (lane & 31)] = sc >= 0 ? W[(size_t)(k0 + kk) * ldw + sc] : 0.f; }
    asm volatile("s_waitcnt lgkmcnt(0)" ::: "memory");
    const int c = lane & 7;
#pragma unroll
    for (int j = 0; j < 4; ++j) { const int nn = (lane >> 3) + 8 * j; const LAS float* s = scr + (8 * c) * 33 + nn;
        u32x4 o; o.x = pk2(s[0 * 33], s[1 * 33]); o.y = pk2(s[2 * 33], s[3 * 33]); o.z = pk2(s[4 * 33], s[5 * 33]); o.w = pk2(s[6 * 33], s[7 * 33]);
        *(u32x4*)(WT + (size_t)(n0 + nn) * K + k0 + 8 * c) = o; }
    asm volatile("s_waitcnt lgkmcnt(0)" ::: "memory");
}

__device__ __forceinline__ void prep_weights(KP P, const Ctx& C, int gw, int ngw) {
    LAS float* scr = (LAS float*)(C.lds + C.wave * 8704);
    constexpr int I_WIN0 = 16 * (PE_PAD / 32), I_WIN1 = 16 * (PO_PAD / 32), I_WOUT = 32 * 32;
    constexpr int NIT = I_WIN0 + I_WIN1 + 2 * I_WOUT;
    for (int it = gw; it < NIT; it += ngw) {
        int r = it;
        if (r < I_WIN0) { const int nb = r % (PE_PAD / 32), kb = r / (PE_PAD / 32); transpose_item(P->in[14], 8224, WSP(bf16_t, WS_WIN0), 1024, kb * 64, nb * 32, 0, scr, C.lane); continue; } r -= I_WIN0;
        if (r < I_WIN1) { const int nb = r % (PO_PAD / 32), kb = r / (PO_PAD / 32); transpose_item(P->in[22], 6160, WSP(bf16_t, WS_WIN1), 1024, kb * 64, nb * 32, 1, scr, C.lane); continue; } r -= I_WIN1;
        if (r < I_WOUT) { const int nb = r % 32, kb = r / 32; transpose_item(P->in[15], 1024, WSP(bf16_t, WS_WOUT0), 2048, kb * 64, nb * 32, 2, scr, C.lane); continue; } r -= I_WOUT;
        { const int nb = r % 32, kb = r / 32; transpose_item(P->in[23], 1024, WSP(bf16_t, WS_WOUT1), 2048, kb * 64, nb * 32, 2, scr, C.lane); }
    }
}
__device__ __forceinline__ void phase_prep0(KP P, const Ctx& C) {
    LAS float* scr = (LAS float*)(C.lds + C.wave * 8704);
    constexpr int I_ADA = 2 * 16 * 96;
    for (int r = C.gw; r < I_ADA; r += C.ngw) {
        const int l = r / (16 * 96), rr = r % (16 * 96), nb = rr % 96, kb = rr / 96;
        transpose_item(P->in[11] + (size_t)l * 1024 * 3072, 3072, WSP(bf16_t, WS_ADAT) + (size_t)l * 3072 * 1024, 1024, kb * 64, nb * 32, 2, scr, C.lane);
    }
    const int gt = C.bid * 512 + C.tid, ngt = C.nblk * 512;
    bf16_t* cbf = WSP(bf16_t, WS_CBF);
    for (int i = gt; i < 256 * 512; i += ngt) { const int row = i >> 9, c2 = (i & 511) * 2; float a = 0.f, b = 0.f;
        if (row < NSEQ) { const float* cp = row < 8 ? P->in[2] + row * 1024 : P->in[3] + (row - 8) * 1024; a = siluf_(cp[c2]); b = siluf_(cp[c2 + 1]); }
        *(unsigned*)(cbf + (size_t)row * 1024 + c2) = pk2(a, b); }
    f32x2* rope = WSP(f32x2, WS_ROPE);
    for (int i = gt; i < 2049 * 64; i += ngt) { const int p = i >> 6, fi = i & 63; const float pos = p < 2048 ? (float)p : 16384.f;
        const float inv = expf(-(float)fi * (1.f / 64.f) * 9.210340371976184f); const float ang = pos * inv;
        const double ad = (double)ang; const double n = rint(ad * 0.15915494309189535); const float rr = (float)(ad - n * 6.283185307179586);
        rope[i] = (f32x2){cosf(rr), sinf(rr)}; }
    unsigned* hz = (unsigned*)(DOP(bf16_t, DO_HBUF) + (size_t)NTOK * 1024);
    for (int i = gt; i < 128 * 512; i += ngt) hz[i] = 0u;
    unsigned* yz = (unsigned*)(WSP(bf16_t, WS_Y) + (size_t)NTOK * 2048);
    for (int i = gt; i < 128 * 1024; i += ngt) yz[i] = 0u;
}

__device__ __forceinline__ void phase_hnorm(KP P, const Ctx& C, int layer) {
    const float* mod = WSP(float, WS_MOD); const float* nw = P->in[13] + layer * 1024; bf16_t* hb = DOP(bf16_t, DO_HBUF);
    for (int tok = C.gw; tok < NTOK; tok += C.ngw) {
        const float* xr = layer == 0 ? (tok < NTP ? P->in[0] + (size_t)tok * DM : P->in[1] + (size_t)(tok - NTP) * DM) : P->out + (size_t)tok * DM;
        const int seq = tok < NTP ? (tok >> 11) : (8 + tok - NTP);
        const float* md = mod + (size_t)seq * 6144 + layer * 3072;
        f32x4 v[4]; float ss = 0.f;
#pragma unroll
        for (int j = 0; j < 4; ++j) { v[j] = ((const f32x4*)xr)[C.lane + 64 * j]; ss += v[j].x * v[j].x + v[j].y * v[j].y + v[j].z * v[j].z + v[j].w * v[j].w; }
        ss = ar64(ss); const float rstd = rsqrtf(ss * (1.f / 1024.f) + EPS);
#pragma unroll
        for (int j = 0; j < 4; ++j) { const int idx = (C.lane + 64 * j) * 4;
            const f32x4 w = *(const f32x4*)(nw + idx), sh = *(const f32x4*)(md + idx), sc = *(const f32x4*)(md + 1024 + idx);
            const f32x4 h = v[j] * rstd * w * (sc + 1.f) + sh; u32x2 o; o.x = pk2(h.x, h.y); o.y = pk2(h.z, h.w);
            *(u32x2*)(hb + (size_t)tok * 1024 + idx) = o; }
    }
}

__device__ __forceinline__ void phase_prep_even(KP P, const Ctx& C) {
    const bf16_t* proj = WSP(bf16_t, WS_PROJ); const float* G = WSP(float, WS_GATES); float* GA = WSP(float, WS_GA); float* GB = WSP(float, WS_GB);
    bf16_t* ab = DOP(bf16_t, DO_ABUF); const float* cw = P->in[16]; const int lane = C.lane;
    for (int tok = C.gw; tok < NTOK; tok += C.ngw) {
        const bool isP = tok < NTP; const int t = isP ? (tok & 2047) : 0; const int si = tok - NTP;
        if (lane < 8) { const int h = lane; const float* g = G + (size_t)tok * 32;
            const float beta = sigmoidf_(g[h]); const float a = expf(-expf(P->in[17][h]) * softplusf_(g[8 + h] + P->in[18][h]));
            GA[(size_t)tok * 32 + h * 4] = a; GA[(size_t)tok * 32 + h * 4 + 1] = beta;
            const float ig = g[16 + h] + P->in[20][h], fg = g[24 + h] + P->in[20][8 + h];
            GB[(size_t)tok * 32 + h * 4] = ig; GB[(size_t)tok * 32 + h * 4 + 1] = -softplusf_(-fg); }
#pragma unroll 1
        for (int i = 0; i < 2; ++i) {
            float val[3][8];
#pragma unroll
            for (int s = 0; s < 3; ++s) { const int c0 = s * 1024 + i * 512 + lane * 8;
                float y[8];
#pragma unroll
                for (int e = 0; e < 8; ++e) y[e] = 0.f;
#pragma unroll
                for (int j = 0; j < 4; ++j) {
                    const int back = 3 - j; float u[8];
                    if (t >= back) unpack8(*(const u32x4*)(proj + (size_t)(tok - back) * PE_MAIN + c0), u);
                    else if (!isP) { const float* bp = P->in[5] + ((size_t)si * 3 + (t + j)) * 3072 + c0; const f32x4 b0 = *(const f32x4*)bp, b1 = *(const f32x4*)(bp + 4);
                        u[0] = b0.x; u[1] = b0.y; u[2] = b0.z; u[3] = b0.w; u[4] = b1.x; u[5] = b1.y; u[6] = b1.z; u[7] = b1.w; }
                    else {
#pragma unroll
                        for (int e = 0; e < 8; ++e) u[e] = 0.f; }
                    const f32x4 w0 = *(const f32x4*)(cw + j * 3072 + c0), w1 = *(const f32x4*)(cw + j * 3072 + c0 + 4);
                    y[0] += w0.x * u[0]; y[1] += w0.y * u[1]; y[2] += w0.z * u[2]; y[3] += w0.w * u[3];
                    y[4] += w1.x * u[4]; y[5] += w1.y * u[5]; y[6] += w1.z * u[6]; y[7] += w1.w * u[7];
                    if (isP) { if (j == 3 && t >= 2045) { float* pc = P->out + OUT_PCONV + ((size_t)(tok >> 11) * 3 + (t - 2045)) * 3072 + c0;
                            *(f32x4*)pc = (f32x4){u[0], u[1], u[2], u[3]}; *(f32x4*)(pc + 4) = (f32x4){u[4], u[5], u[6], u[7]}; } }
                    else if (j >= 1) { float* sc = P->out + OUT_SCONV + ((size_t)si * 3 + (j - 1)) * 3072 + c0;
                        *(f32x4*)sc = (f32x4){u[0], u[1], u[2], u[3]}; *(f32x4*)(sc + 4) = (f32x4){u[4], u[5], u[6], u[7]}; }
                }
#pragma unroll
                for (int e = 0; e < 8; ++e) val[s][e] = siluf_(y[e]);
            }
            float sq = 0.f, sk = 0.f, d = 0.f;
#pragma unroll
            for (int e = 0; e < 8; ++e) { sq += val[0][e] * val[0][e]; sk += val[1][e] * val[1][e]; d += val[0][e] * val[1][e]; }
            sq = ar16(sq); sk = ar16(sk); d = ar16(d);
            const float rq = rsqrtf(sq + EPS) * 0.08838834764831845f, rk = rsqrtf(sk + EPS);
#pragma unroll
            for (int e = 0; e < 8; ++e) { val[0][e] *= rq; val[1][e] *= rk; }
            *(u32x4*)(ab + (size_t)tok * 3072 + i * 512 + lane * 8) = pack8(val[0]);
            *(u32x4*)(ab + (size_t)tok * 3072 + 1024 + i * 512 + lane * 8) = pack8(val[1]);
            *(u32x4*)(ab + (size_t)tok * 3072 + 2048 + i * 512 + lane * 8) = pack8(val[2]);
            if ((lane & 15) == 0) GA[(size_t)tok * 32 + (4 * i + (lane >> 4)) * 4 + 2] = d * rq * rk;
        }
    }
}

template <int NLANES> __device__ __forceinline__ float arN(float x) { return NLANES == 16 ? ar16(x) : (NLANES == 8 ? ar8(x) : ar4(x)); }
template <int MODE, int DKL, int DR> __device__ __forceinline__ void rec_item(KP P, int item, int lane) {
    constexpr int DK = (MODE == 1 || MODE == 4) ? 64 : 128;
    constexpr int NL = DK / DKL;
    constexpr int CW = (64 / NL) * 2;
    constexpr int DV = (MODE == 0 || MODE == 1) ? 128 : (MODE == 4 ? CW : 256);
    constexpr int NCB = DV / CW;
    constexpr int NH = (MODE >= 2 && MODE <= 3) ? 4 : 8;
    constexpr int LD = MODE == 0 ? 3072 : ((MODE == 1 || MODE == 4) ? PE_MAIN : PO_MAIN);
    const int bh = item / NCB, cb = item % NCB, b = bh / NH, h = bh % NH;
    const int r = lane & (NL - 1), dv = cb * CW + (lane / NL) * 2;
    const bf16_t* src = (MODE == 0 ? DOP(bf16_t, DO_ABUF) : WSP(bf16_t, WS_PROJ)) + (size_t)b * TSEQ * LD;
    const int ko = (MODE == 0 ? 1024 + h * 128 : (MODE == 1 || MODE == 4) ? E_KB + h * 64 : MODE == 2 ? O_KC + h * 128 : O_KD + h * 128) + r * DKL;
    const int qo = (MODE == 0 ? h * 128 : (MODE == 1 || MODE == 4) ? E_QB + h * 64 : MODE == 2 ? O_QC + h * 128 : O_QD + h * 128) + r * DKL;
    const int vo = (MODE == 0 ? 2048 + h * 128 : MODE == 1 ? E_VB + h * 128 : MODE == 2 ? O_VC + h * 256 : O_VD + h * 256) + dv;
    float* gsrc = (MODE == 0 ? WSP(float, WS_GA) : WSP(float, WS_GB)) + (size_t)b * TSEQ * 32 + h * 4;
    const float* asrc = WSP(float, WS_ALPHA) + (size_t)b * TSEQ * 512 + h * 128 + r * DKL;
    bf16_t* yb = WSP(bf16_t, WS_Y) + (size_t)b * TSEQ * 2048 + (MODE == 0 ? h * 128 : MODE == 1 ? 1024 + h * 128 : MODE == 2 ? h * 256 : 1024 + h * 256) + dv;
    const float gam = 1.f - exp2f(-5.f - (float)h);
    struct TokIn { u32x4 k0, k1, q0, q1; unsigned v; f32x4 g; f32x4 a0, a1, a2, a3; };
    f32x2 S[DKL];
#pragma unroll
    for (int i = 0; i < DKL; ++i) S[i] = (f32x2){0.f, 0.f};
    float m = 0.f, A = 1.f;
    auto load = [&](TokIn& x, int t) {
        const int tt = t;
        const bf16_t* p = src + (size_t)tt * LD;
        x.k0 = *(const u32x4*)(p + ko); x.q0 = *(const u32x4*)(p + qo);
        if (DKL == 16) { x.k1 = *(const u32x4*)(p + ko + 8); x.q1 = *(const u32x4*)(p + qo + 8); }
        if (MODE != 4) x.v = *(const unsigned*)(p + vo);
        if (MODE == 0) { const f32x3 g3 = *(const f32x3*)(gsrc + (size_t)tt * 32); x.g.x = g3.x; x.g.y = g3.y; x.g.z = g3.z; }
        if (MODE == 1 || MODE == 4) { const f32x2 g2 = *(const f32x2*)(gsrc + (size_t)tt * 32); x.g.x = g2.x; x.g.y = g2.y; }
        if (MODE == 2) { const float* ap = asrc + (size_t)tt * 512; x.a0 = *(const f32x4*)ap; x.a1 = *(const f32x4*)(ap + 4);
            if (DKL == 16) { x.a2 = *(const f32x4*)(ap + 8); x.a3 = *(const f32x4*)(ap + 12); } }
    };
    auto step = [&](const TokIn& x, int t) {
        float k[16], q[16]; unpack8(x.k0, k); unpack8(x.q0, q);
        if (DKL == 16) { unpack8(x.k1, k + 8); unpack8(x.q1, q + 8); }
        f32x2 v = {1.f, 1.f};
        if (MODE != 4) v = (f32x2){bflo(x.v), bfhi(x.v)};
        f32x2 o = {0.f, 0.f};
        if (MODE == 0) {
            const float a = x.g.x, be = x.g.y, qk = x.g.z;
            f32x2 pka[4], pqa[4];
#pragma unroll
            for (int i = 0; i < 4; ++i) { pka[i] = S[i] * k[i]; pqa[i] = S[i] * q[i]; }
#pragma unroll
            for (int i = 4; i < DKL; ++i) { pka[i & 3] += S[i] * k[i]; pqa[i & 3] += S[i] * q[i]; }
            f32x2 pk = (pka[0] + pka[1]) + (pka[2] + pka[3]), pq = (pqa[0] + pqa[1]) + (pqa[2] + pqa[3]);
            { float p0 = pk.x, p1 = pk.y, p2 = pq.x, p3 = pq.y;
              if (NL == 8) ar8x4(p0, p1, p2, p3); else if (NL == 16) ar16x4(p0, p1, p2, p3); else { p0 = arN<NL>(p0); p1 = arN<NL>(p1); p2 = arN<NL>(p2); p3 = arN<NL>(p3); }
              pk = (f32x2){p0, p1}; pq = (f32x2){p2, p3}; }
            float An = a * A;
            const f32x2 u = (v - pk * An) * be;
            o = pq * An + u * qk;
            if (An < 1e-12f) {
#pragma unroll
                for (int i = 0; i < DKL; ++i) S[i] = S[i] * An;
                An = 1.f; }
            const f32x2 uh = u * __builtin_amdgcn_rcpf(An);
#pragma unroll
            for (int i = 0; i < DKL; ++i) S[i] = S[i] + uh * k[i];
            A = An;
        } else if (MODE == 1 || MODE == 4) {
            const float ig = x.g.x, lf = x.g.y;
            const float mn = fmaxf(lf + m, ig); const float dec = __expf(lf + m - mn), isc = __expf(ig - mn) * 0.125f; m = mn;
            const f32x2 u = v * isc;
            f32x2 oa[4] = {o, o, o, o};
#pragma unroll
            for (int i = 0; i < DKL; ++i) { S[i] = S[i] * dec + u * k[i]; oa[i & 3] += S[i] * q[i]; }
            o = (oa[0] + oa[1]) + (oa[2] + oa[3]);
            o.x = arN<NL>(o.x); if (MODE == 1) o.y = arN<NL>(o.y);
        } else if (MODE == 2) {
            const float al[16] = {x.a0.x, x.a0.y, x.a0.z, x.a0.w, x.a1.x, x.a1.y, x.a1.z, x.a1.w, x.a2.x, x.a2.y, x.a2.z, x.a2.w, x.a3.x, x.a3.y, x.a3.z, x.a3.w};
            f32x2 oa[4] = {o, o, o, o};
#pragma unroll
            for (int i = 0; i < DKL; ++i) { S[i] = S[i] * al[i] + v * k[i]; oa[i & 3] += S[i] * q[i]; }
            o = (oa[0] + oa[1]) + (oa[2] + oa[3]);
            if (NL == 16) { float p0 = o.x, p1 = o.y; ar16x2(p0, p1); o = (f32x2){p0, p1}; } else { o.x = arN<NL>(o.x); o.y = arN<NL>(o.y); }
            o *= 0.08838834764831845f;
        } else {
            f32x2 oa[4] = {o, o, o, o};
#pragma unroll
            for (int i = 0; i < DKL; ++i) { S[i] = S[i] * gam + v * k[i]; oa[i & 3] += S[i] * q[i]; }
            o = (oa[0] + oa[1]) + (oa[2] + oa[3]);
            if (NL == 16) { float p0 = o.x, p1 = o.y; ar16x2(p0, p1); o = (f32x2){p0, p1}; } else { o.x = arN<NL>(o.x); o.y = arN<NL>(o.y); }
        }
        if (MODE == 4) { if (lane == 0) gsrc[(size_t)t * 32 + 2] = __builtin_amdgcn_rcpf(fmaxf(fabsf(o.x), __expf(-m))); }
        else if (r == 0) *(unsigned*)(yb + (size_t)t * 2048) = pk2(o.x, o.y);
    };
    TokIn X[DR];
#pragma unroll
    for (int d = 0; d < DR; ++d) load(X[d], d);
    for (int t0 = 0; t0 < TSEQ; t0 += DR) {
#pragma unroll
        for (int d = 0; d < DR; ++d) { const int t = t0 + d;
            if (t < TSEQ) step(X[d], t);
            load(X[d], t + DR); }
    }
    if (MODE == 4) {
        if (lane < NL) {
#pragma unroll
            for (int i = 0; i < DKL; ++i) P->out[OUT_PMN + (size_t)bh * 64 + r * DKL + i] = S[i].x; }
        if (lane == 0) P->out[OUT_PMM + bh] = m;
    } else {
        float* ps = P->out + (MODE == 0 ? OUT_PGDN : MODE == 1 ? OUT_PMC : MODE == 2 ? OUT_PGLA : OUT_PRET) + (size_t)bh * DK * DV;
#pragma unroll
        for (int i = 0; i < DKL; ++i) *(f32x2*)(ps + (size_t)(r * DKL + i) * DV + dv) = (MODE == 0) ? S[i] * A : S[i];
    }
}

__device__ __forceinline__ void gdn_sample_item(KP P, int idx, int lane) {
    const int si = idx >> 3, h = idx & 7, tok = NTP + si;
    const float* Sin = P->in[4] + (size_t)idx * 128 * 128; float* Sout = P->out + OUT_SGDN + (size_t)idx * 128 * 128;
    const bf16_t* ab = DOP(bf16_t, DO_ABUF) + (size_t)tok * 3072 + h * 128;
    const float* ga = WSP(float, WS_GA) + (size_t)tok * 32;
    const unsigned kpk = *(const unsigned*)(ab + 1024 + 2 * lane), qpk = *(const unsigned*)(ab + 2 * lane), vpk = *(const unsigned*)(ab + 2048 + 2 * lane);
    const float a = ga[h * 4], be = ga[h * 4 + 1], qk = ga[h * 4 + 2];
    f32x2 pk = {0.f, 0.f}, pq = {0.f, 0.f};
#pragma unroll 8
    for (int d2 = 0; d2 < 64; ++d2) { const unsigned ku = rdlu(kpk, d2), qu = rdlu(qpk, d2);
        const f32x2 s0 = *(const f32x2*)(Sin + (size_t)(2 * d2) * 128 + 2 * lane), s1 = *(const f32x2*)(Sin + (size_t)(2 * d2 + 1) * 128 + 2 * lane);
        pk += s0 * bflo(ku) + s1 * bfhi(ku); pq += s0 * bflo(qu) + s1 * bfhi(qu); }
    const f32x2 v = {bflo(vpk), bfhi(vpk)};
    const f32x2 u = (v - pk * a) * be; const f32x2 o = pq * a + u * qk;
#pragma unroll 8
    for (int d2 = 0; d2 < 64; ++d2) { const unsigned ku = rdlu(kpk, d2);
        const f32x2 s0 = *(const f32x2*)(Sin + (size_t)(2 * d2) * 128 + 2 * lane), s1 = *(const f32x2*)(Sin + (size_t)(2 * d2 + 1) * 128 + 2 * lane);
        *(f32x2*)(Sout + (size_t)(2 * d2) * 128 + 2 * lane) = s0 * a + u * bflo(ku);
        *(f32x2*)(Sout + (size_t)(2 * d2 + 1) * 128 + 2 * lane) = s1 * a + u * bfhi(ku); }
    *(unsigned*)(WSP(bf16_t, WS_Y) + (size_t)tok * 2048 + h * 128 + 2 * lane) = pk2(o.x, o.y);
}

__device__ __forceinline__ void mlstm_sample_item(KP P, int idx, int lane) {
    const int si = idx >> 3, h = idx & 7, tok = NTP + si;
    const float* Cin = P->in[6] + (size_t)idx * 64 * 128; float* Cout = P->out + OUT_SMC + (size_t)idx * 64 * 128;
    const bf16_t* pr = WSP(bf16_t, WS_PROJ) + (size_t)tok * PE_MAIN;
    float* gb = WSP(float, WS_GB) + (size_t)tok * 32;
    const float m0 = P->in[8][idx], ig = gb[h * 4], lf = gb[h * 4 + 1];
    const float mn = fmaxf(lf + m0, ig); const float dec = expf(lf + m0 - mn), isc = expf(ig - mn) * 0.125f;
    const unsigned kpk = *(const unsigned*)(pr + E_KB + h * 64 + 2 * (lane & 31)), qpk = *(const unsigned*)(pr + E_QB + h * 64 + 2 * (lane & 31));
    const unsigned vpk = *(const unsigned*)(pr + E_VB + h * 128 + 2 * lane);
    const f32x2 uv = (f32x2){bflo(vpk), bfhi(vpk)} * isc;
    f32x2 num = {0.f, 0.f};
#pragma unroll 8
    for (int d2 = 0; d2 < 32; ++d2) { const unsigned ku = rdlu(kpk, d2), qu = rdlu(qpk, d2);
        const f32x2 s0 = *(const f32x2*)(Cin + (size_t)(2 * d2) * 128 + 2 * lane), s1 = *(const f32x2*)(Cin + (size_t)(2 * d2 + 1) * 128 + 2 * lane);
        const f32x2 n0 = s0 * dec + uv * bflo(ku), n1 = s1 * dec + uv * bfhi(ku);
        *(f32x2*)(Cout + (size_t)(2 * d2) * 128 + 2 * lane) = n0; *(f32x2*)(Cout + (size_t)(2 * d2 + 1) * 128 + 2 * lane) = n1;
        num += n0 * bflo(qu) + n1 * bfhi(qu); }
    const float kl = bf1(pr[E_KB + h * 64 + lane]), ql = bf1(pr[E_QB + h * 64 + lane]);
    const float nl = dec * P->in[7][(size_t)idx * 64 + lane] + isc * kl;
    const float den = ar64(nl * ql);
    P->out[OUT_SMN + (size_t)idx * 64 + lane] = nl;
    if (lane == 0) { P->out[OUT_SMM + idx] = mn; gb[h * 4 + 2] = 1.f / fmaxf(fabsf(den), expf(-mn)); }
    *(unsigned*)(WSP(bf16_t, WS_Y) + (size_t)tok * 2048 + 1024 + h * 128 + 2 * lane) = pk2(num.x, num.y);
}

__device__ __forceinline__ void phase_rec_even(KP P, const Ctx& C) {
    const int lane = C.lane;
    { const int slot = C.bid * 4 + (C.wave & 3), nslot = C.nblk * 4;
        if (C.wave < 4) { for (int g = slot; g < 1024; g += nslot) rec_item<0, 8, 8>(P, g, lane); }
        else { for (int q = slot; q < 576; q += nslot) { if (q < 512) rec_item<1, 8, 8>(P, q, lane); else rec_item<4, 8, 8>(P, q - 512, lane); } } }
    unsigned* ctr = WSP(unsigned, WS_CTL);
    for (;;) {
        int idx = 0; if (lane == 0) idx = (int)atomicAdd(ctr, 1u);
        idx = __builtin_amdgcn_readfirstlane(idx);
        if (idx >= 2048) break;
        if (idx < 1024) gdn_sample_item(P, idx, lane); else mlstm_sample_item(P, idx - 1024, lane);
    }
}

__device__ __forceinline__ void phase_post_even(KP P, const Ctx& C) {
    bf16_t* Y = WSP(bf16_t, WS_Y); const bf16_t* proj = WSP(bf16_t, WS_PROJ); const float* GB = WSP(float, WS_GB); const int lane = C.lane;
    for (int tok = C.gw; tok < NTOK; tok += C.ngw) {
#pragma unroll
        for (int i = 0; i < 4; ++i) { const int ch0 = i * 512 + lane * 8; float o[8], z[8], y[8];
            unpack8(*(const u32x4*)(Y + (size_t)tok * 2048 + ch0), o); unpack8(*(const u32x4*)(proj + (size_t)tok * PE_MAIN + E_Z + ch0), z);
            if (i < 2) { float ss = 0.f;
#pragma unroll
                for (int e = 0; e < 8; ++e) ss += o[e] * o[e];
                ss = ar16(ss); const float rs = rsqrtf(ss * (1.f / 128.f) + EPS); const float* w = P->in[19] + (ch0 & 127);
#pragma unroll
                for (int e = 0; e < 8; ++e) y[e] = o[e] * rs * w[e] * siluf_(z[e]);
            } else { const int hh = (ch0 - 1024) >> 7; const float dn = GB[(size_t)tok * 32 + hh * 4 + 2]; float ss = 0.f; float op[8];
                unpack8(*(const u32x4*)(proj + (size_t)tok * PE_MAIN + E_OP + ch0 - 1024), op);
#pragma unroll
                for (int e = 0; e < 8; ++e) { o[e] *= dn; ss += o[e] * o[e]; }
                ss = ar16(ss); const float rs = rsqrtf(ss * (1.f / 128.f) + EPS); const float* w = P->in[21] + (ch0 & 127);
#pragma unroll
                for (int e = 0; e < 8; ++e) y[e] = sigmoidf_(op[e]) * o[e] * rs * w[e] * siluf_(z[e]);
            }
            *(u32x4*)(Y + (size_t)tok * 2048 + ch0) = pack8(y);
        }
    }
}

__device__ __forceinline__ void phase_prep_odd(KP P, const Ctx& C) {
    bf16_t* proj = WSP(bf16_t, WS_PROJ); const float* G = WSP(float, WS_GATES); float* AL = WSP(float, WS_ALPHA); const f32x2* rope = WSP(f32x2, WS_ROPE);
    const float* w2 = P->in[24]; const float* b2 = P->in[25]; const int lane = C.lane;
    for (int tok = C.gw; tok < NTOK; tok += C.ngw) {
        const bool isP = tok < NTP; const int t = isP ? (tok & 2047) : 2048;
        float g[16];
#pragma unroll
        for (int r4 = 0; r4 < 4; ++r4) { const f32x4 gv = *(const f32x4*)(G + (size_t)tok * 16 + r4 * 4); g[r4 * 4] = gv.x; g[r4 * 4 + 1] = gv.y; g[r4 * 4 + 2] = gv.z; g[r4 * 4 + 3] = gv.w; }
        float x[8];
#pragma unroll
        for (int e = 0; e < 8; ++e) x[e] = b2[lane * 8 + e];
#pragma unroll
        for (int r = 0; r < 16; ++r) { const f32x4 wa = *(const f32x4*)(w2 + r * 512 + lane * 8), wb = *(const f32x4*)(w2 + r * 512 + lane * 8 + 4);
            x[0] += g[r] * wa.x; x[1] += g[r] * wa.y; x[2] += g[r] * wa.z; x[3] += g[r] * wa.w; x[4] += g[r] * wb.x; x[5] += g[r] * wb.y; x[6] += g[r] * wb.z; x[7] += g[r] * wb.w; }
        f32x4 a0, a1;
        a0.x = gla_alpha_(x[0]); a0.y = gla_alpha_(x[1]); a0.z = gla_alpha_(x[2]); a0.w = gla_alpha_(x[3]);
        a1.x = gla_alpha_(x[4]); a1.y = gla_alpha_(x[5]); a1.z = gla_alpha_(x[6]); a1.w = gla_alpha_(x[7]);
        *(f32x4*)(AL + (size_t)tok * 512 + lane * 8) = a0; *(f32x4*)(AL + (size_t)tok * 512 + lane * 8 + 4) = a1;
        const f32x2 cs = rope[t * 64 + lane];
        bf16_t* pr = proj + (size_t)tok * PO_MAIN;
#pragma unroll
        for (int h = 0; h < 4; ++h) {
            { bf16_t* q = pr + O_QD + h * 128; const float x1 = bf1(q[lane]), x2 = bf1(q[64 + lane]);
              const unsigned o = pk2(x1 * cs.x - x2 * cs.y, x1 * cs.y + x2 * cs.x); q[lane] = (bf16_t)(o & 0xffffu); q[64 + lane] = (bf16_t)(o >> 16); }
            { bf16_t* k = pr + O_KD + h * 128; const float x1 = bf1(k[lane]) * 0.08838834764831845f, x2 = bf1(k[64 + lane]) * 0.08838834764831845f;
              const unsigned o = pk2(x1 * cs.x - x2 * cs.y, x1 * cs.y + x2 * cs.x); k[lane] = (bf16_t)(o & 0xffffu); k[64 + lane] = (bf16_t)(o >> 16); }
        }
    }
}

template <bool GLA> __device__ __forceinline__ void odd_sample_item(KP P, int idx, int lane) {
    const int si = idx >> 2, h = idx & 3, tok = NTP + si;
    const float* Sin = P->in[GLA ? 9 : 10] + (size_t)idx * 128 * 256; float* Sout = P->out + (GLA ? OUT_SGLA : OUT_SRET) + (size_t)idx * 128 * 256;
    const bf16_t* pr = WSP(bf16_t, WS_PROJ) + (size_t)tok * PO_MAIN;
    const unsigned kpk = *(const unsigned*)(pr + (GLA ? O_KC : O_KD) + h * 128 + 2 * lane), qpk = *(const unsigned*)(pr + (GLA ? O_QC : O_QD) + h * 128 + 2 * lane);
    const u32x2 vpk = *(const u32x2*)(pr + (GLA ? O_VC : O_VD) + h * 256 + 4 * lane);
    const f32x4 v = {bflo(vpk.x), bfhi(vpk.x), bflo(vpk.y), bfhi(vpk.y)};
    const float gam = 1.f - exp2f(-5.f - (float)h);
    f32x2 alp = {gam, gam};
    if (GLA) alp = *(const f32x2*)(WSP(float, WS_ALPHA) + (size_t)tok * 512 + h * 128 + 2 * lane);
    f32x4 o = {0.f, 0.f, 0.f, 0.f};
#pragma unroll 8
    for (int d2 = 0; d2 < 64; ++d2) { const unsigned ku = rdlu(kpk, d2), qu = rdlu(qpk, d2); const float a0 = rdl(alp.x, d2), a1 = rdl(alp.y, d2);
        const f32x4 s0 = *(const f32x4*)(Sin + (size_t)(2 * d2) * 256 + 4 * lane), s1 = *(const f32x4*)(Sin + (size_t)(2 * d2 + 1) * 256 + 4 * lane);
        const f32x4 n0 = s0 * a0 + v * bflo(ku), n1 = s1 * a1 + v * bfhi(ku);
        *(f32x4*)(Sout + (size_t)(2 * d2) * 256 + 4 * lane) = n0; *(f32x4*)(Sout + (size_t)(2 * d2 + 1) * 256 + 4 * lane) = n1;
        o += n0 * bflo(qu) + n1 * bfhi(qu); }
    if (GLA) o *= 0.08838834764831845f;
    u32x2 op; op.x = pk2(o.x, o.y); op.y = pk2(o.z, o.w);
    *(u32x2*)(WSP(bf16_t, WS_Y) + (size_t)tok * 2048 + (GLA ? 0 : 1024) + h * 256 + 4 * lane) = op;
}

__device__ __forceinline__ void phase_rec_odd(KP P, const Ctx& C) {
    const int lane = C.lane;
    { const int slot = C.bid * 4 + (C.wave & 3), nslot = C.nblk * 4;
        if (C.wave < 4) { for (int g = slot; g < 1024; g += nslot) rec_item<2, 8, 8>(P, g, lane); }
        else { for (int g = slot; g < 1024; g += nslot) rec_item<3, 8, 8>(P, g, lane); } }
    unsigned* ctr = WSP(unsigned, WS_CTL) + 64;
    for (;;) {
        int idx = 0; if (lane == 0) idx = (int)atomicAdd(ctr, 1u);
        idx = __builtin_amdgcn_readfirstlane(idx);
        if (idx >= 1024) break;
        if (idx < 512) odd_sample_item<true>(P, idx, lane); else odd_sample_item<false>(P, idx - 512, lane);
    }
}

__device__ __forceinline__ void phase_post_odd(KP P, const Ctx& C) {
    bf16_t* Y = WSP(bf16_t, WS_Y); const bf16_t* proj = WSP(bf16_t, WS_PROJ); const int lane = C.lane;
    for (int tok = C.gw; tok < NTOK; tok += C.ngw) {
#pragma unroll
        for (int i = 0; i < 4; ++i) { const int ch0 = i * 512 + lane * 8; float o[8], z[8], y[8];
            unpack8(*(const u32x4*)(Y + (size_t)tok * 2048 + ch0), o); unpack8(*(const u32x4*)(proj + (size_t)tok * PO_MAIN + O_Z + ch0), z);
            float ss = 0.f;
#pragma unroll
            for (int e = 0; e < 8; ++e) ss += o[e] * o[e];
            ss = ar32(ss); const float rs = rsqrtf(ss * (1.f / 256.f) + EPS); const float* w = P->in[i < 2 ? 26 : 27] + (ch0 & 255);
#pragma unroll
            for (int e = 0; e < 8; ++e) y[e] = o[e] * rs * w[e] * siluf_(z[e]);
            *(u32x4*)(Y + (size_t)tok * 2048 + ch0) = pack8(y);
        }
    }
}

__device__ __forceinline__ void phase_final(KP P, const Ctx& C) {
    const float* fw = P->in[28];
    for (int tok = C.gw; tok < NTOK; tok += C.ngw) {
        float* xr = P->out + (size_t)tok * DM; f32x4 v[4]; float ss = 0.f;
#pragma unroll
        for (int j = 0; j < 4; ++j) { v[j] = ((const f32x4*)xr)[C.lane + 64 * j]; ss += v[j].x * v[j].x + v[j].y * v[j].y + v[j].z * v[j].z + v[j].w * v[j].w; }
        ss = ar64(ss); const float rstd = rsqrtf(ss * (1.f / 1024.f) + EPS);
#pragma unroll
        for (int j = 0; j < 4; ++j) { const int idx = (C.lane + 64 * j) * 4; ((f32x4*)xr)[C.lane + 64 * j] = v[j] * rstd * *(const f32x4*)(fw + idx); }
    }
}

__device__ __forceinline__ void sample_outproj(KP P, const Ctx& C, int layer) {
    const bf16_t* Y = WSP(bf16_t, WS_Y) + (size_t)NTP * 2048; const bf16_t* W = WSP(bf16_t, layer == 0 ? WS_WOUT0 : WS_WOUT1);
    const float* mod = WSP(float, WS_MOD); LAS float* red = (LAS float*)C.lds;
    const int lane = C.lane, w = C.wave;
    for (int task = C.bid; task < 256; task += C.nblk) {
        const int r0 = (task >> 5) * 16, c0 = (task & 31) * 32;
        f32x4 acc0 = {0.f, 0.f, 0.f, 0.f}, acc1 = acc0;
        const bf16_t* ap = Y + (size_t)(r0 + (lane & 15)) * 2048 + w * 256 + (lane >> 4) * 8;
        const bf16_t* bp0 = W + (size_t)(c0 + (lane & 15)) * 2048 + w * 256 + (lane >> 4) * 8; const bf16_t* bp1 = bp0 + (size_t)16 * 2048;
#pragma unroll
        for (int ks = 0; ks < 8; ++ks) { const bf16x8 a = *(const bf16x8*)(ap + ks * 32), b0 = *(const bf16x8*)(bp0 + ks * 32), b1 = *(const bf16x8*)(bp1 + ks * 32);
            acc0 = __builtin_amdgcn_mfma_f32_16x16x32_bf16(a, b0, acc0, 0, 0, 0); acc1 = __builtin_amdgcn_mfma_f32_16x16x32_bf16(a, b1, acc1, 0, 0, 0); }
        __syncthreads();
        *(LAS f32x4*)(red + ((w * 2 + 0) * 64 + lane) * 4) = acc0; *(LAS f32x4*)(red + ((w * 2 + 1) * 64 + lane) * 4) = acc1;
        __syncthreads();
        { const int e = C.tid, tile = e >> 8, idx = e & 255, ln = idx >> 2, j = idx & 3; float sum = 0.f;
#pragma unroll
          for (int ww = 0; ww < 8; ++ww) sum += red[((ww * 2 + tile) * 64 + ln) * 4 + j];
          const int row = r0 + (ln >> 4) * 4 + j, col = c0 + tile * 16 + (ln & 15);
          const float xin = layer == 0 ? P->in[1][(size_t)row * DM + col] : P->out[(size_t)(NTP + row) * DM + col];
          const float gt = mod[(size_t)(8 + row) * 6144 + layer * 3072 + 2048 + col];
          P->out[(size_t)(NTP + row) * DM + col] = xin + gt * sum; }
    }
    __syncthreads();
}

#define XB_XCNT(j)  (256  + 64 * (j))
#define XB_XSUB(j)  (1280 + 64 * (j))
#define XB_XGEN(j)  (2304 + 64 * (j))
#define XB_TOP      3328
#define XB_TOPGEN   3392
__device__ __forceinline__ unsigned xb_ld(unsigned* p) { return __hip_atomic_load(p, __ATOMIC_RELAXED, __HIP_MEMORY_SCOPE_AGENT); }
__device__ __forceinline__ unsigned xb_add(unsigned* p, unsigned v) { return __hip_atomic_fetch_add(p, v, __ATOMIC_RELAXED, __HIP_MEMORY_SCOPE_AGENT); }
__device__ __forceinline__ unsigned xb_xcc_id() { return (unsigned)__builtin_amdgcn_s_getreg((3 << 11) | 20) & 0xFu; }
__device__ __forceinline__ void xcd_bar(unsigned* bar, volatile unsigned* st) {
    asm volatile("s_waitcnt vmcnt(0)" ::: "memory");
    __syncthreads();
    if (threadIdx.x == 0) {
        __builtin_amdgcn_s_waitcnt(0);
        const unsigned x = xb_xcc_id();
        unsigned nloc = st[0], nx = st[1];
        if (nloc == 0u) {
            unsigned cnt, mine, sum;
            for (;;) { cnt = 0u; mine = 0u; sum = 0u;
#pragma unroll
                for (unsigned j = 0; j < 16; ++j) { const unsigned c = xb_ld(&bar[XB_XCNT(j)]); sum += c; cnt += (c > 0u) ? 1u : 0u; mine = (j == x) ? c : mine; }
                if (sum == gridDim.x) break;
                __builtin_amdgcn_s_sleep(1); }
            nloc = mine > 0u ? mine : 1u; nx = cnt > 0u ? cnt : 1u; st[0] = nloc; st[1] = nx;
        }
        const unsigned old = xb_add(&bar[XB_XSUB(x)], 1u);
        const unsigned gen = old / nloc;
        if (old + 1u == (gen + 1u) * nloc) {
            __builtin_amdgcn_fence(__ATOMIC_RELEASE, "agent");
            asm volatile("s_waitcnt vmcnt(0)" ::: "memory");
            const unsigned og = xb_add(&bar[XB_TOP], 1u);
            const unsigned tg = og / nx;
            if (og + 1u == (tg + 1u) * nx) xb_add(&bar[XB_TOPGEN], 1u);
            else { while (xb_ld(&bar[XB_TOPGEN]) == tg) __builtin_amdgcn_s_sleep(1); }
            __builtin_amdgcn_fence(__ATOMIC_ACQUIRE, "agent");
            xb_add(&bar[XB_XGEN(x)], 1u);
            asm volatile("s_waitcnt vmcnt(0)" ::: "memory");
        } else {
            while (xb_ld(&bar[XB_XGEN(x)]) == gen) __builtin_amdgcn_s_sleep(1);
            __builtin_amdgcn_fence(__ATOMIC_ACQUIRE, "agent");
            asm volatile("s_waitcnt vmcnt(0)" ::: "memory");
        }
    }
    __syncthreads();
}

#ifndef PH_MASK
#define PH_MASK 0x7fff
#endif
#define PH_ON(n) (((PH_MASK) >> (n)) & 1)
#ifndef PH_REP
#define PH_REP 0
#endif
#define PH_RP(n) (((PH_REP) >> (n)) & 1)
constexpr int NPHASE = 15;
__global__ void __launch_bounds__(512, 2) fwd_megakernel(Params PV) {
    extern __shared__ __attribute__((aligned(16))) unsigned char shm[];
    __shared__ __attribute__((aligned(16))) unsigned xb_st[4];
    Ctx C; C.lds = (LAS unsigned char*)shm;
    if (threadIdx.x == 0) { xb_st[0] = 0u; xb_st[1] = 0u; if (PV.ph_hi - PV.ph_lo > 1) (void)xb_add(((unsigned*)PV.ws) + XB_XCNT(xb_xcc_id()), 1u); }
    __syncthreads();
    for (int ph = PV.ph_lo; ph < PV.ph_hi; ++ph) {
        KP P = (KP)__builtin_amdgcn_kernarg_segment_ptr(); asm volatile("" : "+s"(P));
        { int tid = threadIdx.x; asm volatile("" : "+v"(tid)); int bid = blockIdx.x; asm volatile("" : "+s"(bid)); int nblk = gridDim.x; asm volatile("" : "+s"(nblk));
          C.tid = tid; C.bid = bid; C.nblk = nblk; C.lane = tid & 63; C.wave = __builtin_amdgcn_readfirstlane(tid >> 6); C.gw = bid * 8 + C.wave; C.ngw = nblk * 8; }
        const bool is_gemm = (ph == 1 || ph == 3 || ph == 7 || ph == 9 || ph == 13);
        if (is_gemm && PH_ON(1)) {
            pg8::Gemm g; pg8::Epi E; E.kind = 0; E.mod = WSP(float, WS_MOD); E.ada_b = P->in[12]; E.P = WSP(bf16_t, WS_PROJ); E.ldp = PE_MAIN; E.ntile_main = 32; E.G = WSP(float, WS_GATES); E.ng = 32;
            E.xp = P->in[0]; E.xs = P->in[1]; E.xo = P->out; E.gate = WSP(float, WS_MOD); E.layer = 0;
            if (ph == 1) { g.A = WSP(bf16_t, WS_CBF); g.Bt = WSP(bf16_t, WS_ADAT); g.M = 256; g.N = 6144; g.K = 1024; E.kind = 0; }
            else if (ph == 3) { g.A = DOP(bf16_t, DO_HBUF); g.Bt = WSP(bf16_t, WS_WIN0); g.M = MPAD; g.N = PE_PAD; g.K = 1024; E.kind = 1; }
            else if (ph == 7) { g.A = WSP(bf16_t, WS_Y); g.Bt = WSP(bf16_t, WS_WOUT0); g.M = NTP; g.N = 1024; g.K = 2048; E.kind = 2; E.layer = 0; }
            else if (ph == 9) { g.A = DOP(bf16_t, DO_HBUF); g.Bt = WSP(bf16_t, WS_WIN1); g.M = MPAD; g.N = PO_PAD; g.K = 1024; E.kind = 1; E.ldp = PO_MAIN; E.ntile_main = 24; E.ng = 16; }
            else { g.A = WSP(bf16_t, WS_Y); g.Bt = WSP(bf16_t, WS_WOUT1); g.M = NTP; g.N = 1024; g.K = 2048; E.kind = 2; E.layer = 1; }
            pg8::StaticOrder S; S.init(g.M, g.N, C.nblk, C.bid);
            for (int rep = 0; rep < 1 + PH_RP(ph); ++rep) { asm volatile("" : "+s"(rep)); pg8::gemm_phase(C.lds, g, S, E, C.tid); }
            if (E.kind == 2) sample_outproj(P, C, E.layer);
            if (ph == 1) { if (C.nblk > 24) { if (C.bid >= 24) prep_weights(P, C, (C.bid - 24) * 8 + C.wave, (C.nblk - 24) * 8); } else prep_weights(P, C, C.gw, C.ngw); }
        } else {
            switch (ph) {
                case 0: if (PH_ON(0)) phase_prep0(P, C); if (PH_RP(0)) { asm volatile("" : "+s"(P)); phase_prep0(P, C); } break;
                case 2: if (PH_ON(2)) phase_hnorm(P, C, 0); if (PH_RP(2)) { asm volatile("" : "+s"(P)); phase_hnorm(P, C, 0); } break;
                case 4: if (PH_ON(4)) phase_prep_even(P, C); if (PH_RP(4)) { asm volatile("" : "+s"(P)); phase_prep_even(P, C); } break;
                case 5: if (PH_ON(5)) phase_rec_even(P, C); if (PH_RP(5)) { asm volatile("" : "+s"(P)); phase_rec_even(P, C); } break;
                case 6: if (PH_ON(6)) phase_post_even(P, C); break;
                case 8: if (PH_ON(8)) phase_hnorm(P, C, 1); if (PH_RP(8)) { asm volatile("" : "+s"(P)); phase_hnorm(P, C, 1); } break;
                case 10: if (PH_ON(10)) phase_prep_odd(P, C); break;
                case 11: if (PH_ON(11)) phase_rec_odd(P, C); if (PH_RP(11)) { asm volatile("" : "+s"(P)); phase_rec_odd(P, C); } break;
                case 12: if (PH_ON(12)) phase_post_odd(P, C); break;
                case 14: if (PH_ON(14)) phase_final(P, C); break;
                default: break;
            }
        }
        if (ph + 1 < PV.ph_hi) {
            if (PV.ph_lo > 0 && ph == PV.ph_lo) cg::this_grid().sync();
            else xcd_bar(WSP(unsigned, WS_CTL), xb_st);
        }
    }
}

extern "C" void kernel_launch(void* const* d_in, const int* in_sizes, int n_in, void* d_out, int out_size, void* d_ws, size_t ws_size, hipStream_t stream) {
    constexpr size_t kDynLds = 131072;
    static int grid_blocks = 0;
    if (!grid_blocks) {
        if (n_in != 29 || ws_size < WS_END) { fprintf(stderr, "kernel_launch: unexpected n_in %d or ws_size %zu (need %zu)\n", n_in, ws_size, (size_t)WS_END); }
        int dev = 0, cus = 0, per_cu = 0;
        hipGetDevice(&dev);
        hipDeviceGetAttribute(&cus, hipDeviceAttributeMultiprocessorCount, dev);
        hipFuncSetAttribute((const void*)fwd_megakernel, hipFuncAttributeMaxDynamicSharedMemorySize, (int)kDynLds);
        hipOccupancyMaxActiveBlocksPerMultiprocessor(&per_cu, (const void*)fwd_megakernel, 512, kDynLds);
        if (per_cu < 1) { fprintf(stderr, "kernel_launch: occupancy query says %d blocks/CU\n", per_cu); per_cu = 1; }
        if (per_cu > 1) per_cu = 1;
        grid_blocks = cus * per_cu;
        (void)hipGetLastError();
    }
    hipMemsetAsync((char*)d_ws + WS_CTL, 0, 16384, stream);
    Params p{};
    for (int i = 0; i < 29; ++i) p.in[i] = (const float*)d_in[i];
    p.out = (float*)d_out; p.ws = (unsigned char*)d_ws;
#if MK_SPLIT
    for (int ph = 0; ph < NPHASE; ++ph) { p.ph_lo = ph; p.ph_hi = ph + 1;
        hipLaunchKernelGGL(fwd_megakernel, dim3(grid_blocks), dim3(512), kDynLds, stream, p); }
#else
    p.ph_lo = 0; p.ph_hi = NPHASE;
    void* args[] = {&p};
    hipError_t e = hipLaunchCooperativeKernel((const void*)fwd_megakernel, dim3(grid_blocks), dim3(512), args, kDynLds, stream);
    if (e != hipSuccess) fprintf(stderr, "cooperative launch failed: %s (grid %d)\n", hipGetErrorString(e), grid_blocks);
#endif
}
```

```cpp
#include <hip/hip_runtime.h>
#include <hip/hip_cooperative_groups.h>
#include <cstdio>
#include <cstdint>
namespace cg = cooperative_groups;

#ifndef MK_SPLIT
#define MK_SPLIT 0
#endif

#define LAS __attribute__((address_space(3)))
typedef unsigned short bf16_t;
typedef short bf16x8 __attribute__((ext_vector_type(8)));
typedef float f32x4 __attribute__((ext_vector_type(4)));
typedef float f32x2 __attribute__((ext_vector_type(2)));
typedef float f32x3 __attribute__((ext_vector_type(3)));
typedef unsigned u32x4 __attribute__((ext_vector_type(4)));
typedef unsigned u32x2 __attribute__((ext_vector_type(2)));

constexpr int DM = 1024, NTP = 16384, NTS = 128, NTOK = NTP + NTS, MPAD = 16640, TSEQ = 2048;
constexpr int NSEQ = 136;
constexpr float EPS = 1e-6f;
constexpr int PE_MAIN = 8192, PE_PAD = 8448, PO_MAIN = 6144, PO_PAD = 6400;
constexpr int E_QA = 0, E_KA = 1024, E_VA = 2048, E_QB = 3072, E_KB = 3584, E_VB = 4096, E_OP = 5120, E_Z = 6144;
constexpr int O_QC = 0, O_KC = 512, O_VC = 1024, O_QD = 2048, O_KD = 2560, O_VD = 3072, O_Z = 4096;
constexpr size_t OUT_Y = 0, OUT_PGDN = 16908288, OUT_PCONV = 17956864, OUT_PMC = 18030592, OUT_PMN = 18554880, OUT_PMM = 18558976,
                 OUT_PGLA = 18559040, OUT_PRET = 19607616, OUT_SGDN = 20656192, OUT_SCONV = 37433408, OUT_SMC = 38613056,
                 OUT_SMN = 47001664, OUT_SMM = 47067200, OUT_SGLA = 47068224, OUT_SRET = 63845440;
constexpr size_t WS_CTL = 0, WS_WIN0 = 16384, WS_WOUT0 = WS_WIN0 + (size_t)PE_PAD * 1024 * 2, WS_WIN1 = WS_WOUT0 + (size_t)1024 * 2048 * 2,
                 WS_WOUT1 = WS_WIN1 + (size_t)PO_PAD * 1024 * 2, WS_ADAT = WS_WOUT1 + (size_t)1024 * 2048 * 2, WS_CBF = WS_ADAT + (size_t)6144 * 1024 * 2,
                 WS_MOD = WS_CBF + (size_t)256 * 1024 * 2, WS_ROPE = WS_MOD + (size_t)NSEQ * 6144 * 4, WS_GATES = WS_ROPE + 1049600,
                 WS_GA = WS_GATES + (size_t)NTOK * 32 * 4, WS_GB = WS_GA + (size_t)NTOK * 32 * 4, WS_PROJ = WS_GB + (size_t)NTOK * 32 * 4,
                 WS_Y = WS_PROJ + (size_t)NTOK * PE_MAIN * 2, WS_END = WS_Y + (size_t)MPAD * 2048 * 2;
constexpr size_t WS_ALPHA = WS_PROJ + (size_t)NTOK * PO_MAIN * 2;
constexpr size_t DO_ABUF = OUT_SGLA * 4;
constexpr size_t DO_HBUF = OUT_SRET * 4 + (size_t)67108864 - (size_t)MPAD * 1024 * 2;

struct Params {
    const float* in[29];
    float* out;
    unsigned char* ws;
    int ph_lo, ph_hi;
};

__device__ __forceinline__ float bflo(unsigned u) { return __uint_as_float(u << 16); }
__device__ __forceinline__ float bfhi(unsigned u) { return __uint_as_float(u & 0xffff0000u); }
__device__ __forceinline__ float bf1(bf16_t b) { return __uint_as_float(((unsigned)b) << 16); }
__device__ __forceinline__ unsigned pk2(float lo, float hi) { unsigned r; asm("v_cvt_pk_bf16_f32 %0, %1, %2" : "=v"(r) : "v"(lo), "v"(hi)); return r; }
__device__ __forceinline__ void unpack8(u32x4 p, float* f) {
    f[0] = bflo(p.x); f[1] = bfhi(p.x); f[2] = bflo(p.y); f[3] = bfhi(p.y); f[4] = bflo(p.z); f[5] = bfhi(p.z); f[6] = bflo(p.w); f[7] = bfhi(p.w);
}
__device__ __forceinline__ u32x4 pack8(const float* f) { u32x4 o; o.x = pk2(f[0], f[1]); o.y = pk2(f[2], f[3]); o.z = pk2(f[4], f[5]); o.w = pk2(f[6], f[7]); return o; }
template <int CTRL> __device__ __forceinline__ float dppf(float x) { return __int_as_float(__builtin_amdgcn_update_dpp(0, __float_as_int(x), CTRL, 0xf, 0xf, true)); }
__device__ __forceinline__ float ar4(float x) { x += dppf<0xB1>(x); x += dppf<0x4E>(x); return x; }
__device__ __forceinline__ float ar8(float x) { x = ar4(x); x += dppf<0x141>(x); return x; }
__device__ __forceinline__ void ar8x4(float& a, float& b, float& c, float& d) {
    asm volatile(
        "s_nop 1\n\t"
        "v_add_f32_dpp %0, %0, %0 quad_perm:[1,0,3,2] row_mask:0xf bank_mask:0xf bound_ctrl:1\n\t"
        "v_add_f32_dpp %1, %1, %1 quad_perm:[1,0,3,2] row_mask:0xf bank_mask:0xf bound_ctrl:1\n\t"
        "v_add_f32_dpp %2, %2, %2 quad_perm:[1,0,3,2] row_mask:0xf bank_mask:0xf bound_ctrl:1\n\t"
        "v_add_f32_dpp %3, %3, %3 quad_perm:[1,0,3,2] row_mask:0xf bank_mask:0xf bound_ctrl:1\n\t"
        "v_add_f32_dpp %0, %0, %0 quad_perm:[2,3,0,1] row_mask:0xf bank_mask:0xf bound_ctrl:1\n\t"
        "v_add_f32_dpp %1, %1, %1 quad_perm:[2,3,0,1] row_mask:0xf bank_mask:0xf bound_ctrl:1\n\t"
        "v_add_f32_dpp %2, %2, %2 quad_perm:[2,3,0,1] row_mask:0xf bank_mask:0xf bound_ctrl:1\n\t"
        "v_add_f32_dpp %3, %3, %3 quad_perm:[2,3,0,1] row_mask:0xf bank_mask:0xf bound_ctrl:1\n\t"
        "v_add_f32_dpp %0, %0, %0 row_half_mirror row_mask:0xf bank_mask:0xf bound_ctrl:1\n\t"
        "v_add_f32_dpp %1, %1, %1 row_half_mirror row_mask:0xf bank_mask:0xf bound_ctrl:1\n\t"
        "v_add_f32_dpp %2, %2, %2 row_half_mirror row_mask:0xf bank_mask:0xf bound_ctrl:1\n\t"
        "v_add_f32_dpp %3, %3, %3 row_half_mirror row_mask:0xf bank_mask:0xf bound_ctrl:1\n\t"
        : "+v"(a), "+v"(b), "+v"(c), "+v"(d));
}
__device__ __forceinline__ void ar16x4(float& a, float& b, float& c, float& d) {
    asm volatile(
        "s_nop 1\n\t"
        "v_add_f32_dpp %0, %0, %0 quad_perm:[1,0,3,2] row_mask:0xf bank_mask:0xf bound_ctrl:1\n\t"
        "v_add_f32_dpp %1, %1, %1 quad_perm:[1,0,3,2] row_mask:0xf bank_mask:0xf bound_ctrl:1\n\t"
        "v_add_f32_dpp %2, %2, %2 quad_perm:[1,0,3,2] row_mask:0xf bank_mask:0xf bound_ctrl:1\n\t"
        "v_add_f32_dpp %3, %3, %3 quad_perm:[1,0,3,2] row_mask:0xf bank_mask:0xf bound_ctrl:1\n\t"
        "v_add_f32_dpp %0, %0, %0 quad_perm:[2,3,0,1] row_mask:0xf bank_mask:0xf bound_ctrl:1\n\t"
        "v_add_f32_dpp %1, %1, %1 quad_perm:[2,3,0,1] row_mask:0xf bank_mask:0xf bound_ctrl:1\n\t"
        "v_add_f32_dpp %2, %2, %2 quad_perm:[2,3,0,1] row_mask:0xf bank_mask:0xf bound_ctrl:1\n\t"
        "v_add_f32_dpp %3, %3, %3 quad_perm:[2,3,0,1] row_mask:0xf bank_mask:0xf bound_ctrl:1\n\t"
        "v_add_f32_dpp %0, %0, %0 row_half_mirror row_mask:0xf bank_mask:0xf bound_ctrl:1\n\t"
        "v_add_f32_dpp %1, %1, %1 row_half_mirror row_mask:0xf bank_mask:0xf bound_ctrl:1\n\t"
        "v_add_f32_dpp %2, %2, %2 row_half_mirror row_mask:0xf bank_mask:0xf bound_ctrl:1\n\t"
        "v_add_f32_dpp %3, %3, %3 row_half_mirror row_mask:0xf bank_mask:0xf bound_ctrl:1\n\t"
        "v_add_f32_dpp %0, %0, %0 row_mirror row_mask:0xf bank_mask:0xf bound_ctrl:1\n\t"
        "v_add_f32_dpp %1, %1, %1 row_mirror row_mask:0xf bank_mask:0xf bound_ctrl:1\n\t"
        "v_add_f32_dpp %2, %2, %2 row_mirror row_mask:0xf bank_mask:0xf bound_ctrl:1\n\t"
        "v_add_f32_dpp %3, %3, %3 row_mirror row_mask:0xf bank_mask:0xf bound_ctrl:1\n\t"
        : "+v"(a), "+v"(b), "+v"(c), "+v"(d));
}
__device__ __forceinline__ void ar16x2(float& a, float& b) {
    asm volatile(
        "s_nop 1\n\t"
        "v_add_f32_dpp %0, %0, %0 quad_perm:[1,0,3,2] row_mask:0xf bank_mask:0xf bound_ctrl:1\n\t"
        "v_add_f32_dpp %1, %1, %1 quad_perm:[1,0,3,2] row_mask:0xf bank_mask:0xf bound_ctrl:1\n\t"
        "s_nop 0\n\t"
        "v_add_f32_dpp %0, %0, %0 quad_perm:[2,3,0,1] row_mask:0xf bank_mask:0xf bound_ctrl:1\n\t"
        "v_add_f32_dpp %1, %1, %1 quad_perm:[2,3,0,1] row_mask:0xf bank_mask:0xf bound_ctrl:1\n\t"
        "s_nop 0\n\t"
        "v_add_f32_dpp %0, %0, %0 row_half_mirror row_mask:0xf bank_mask:0xf bound_ctrl:1\n\t"
        "v_add_f32_dpp %1, %1, %1 row_half_mirror row_mask:0xf bank_mask:0xf bound_ctrl:1\n\t"
        "s_nop 0\n\t"
        "v_add_f32_dpp %0, %0, %0 row_mirror row_mask:0xf bank_mask:0xf bound_ctrl:1\n\t"
        "v_add_f32_dpp %1, %1, %1 row_mirror row_mask:0xf bank_mask:0xf bound_ctrl:1\n\t"
        : "+v"(a), "+v"(b));
}
__device__ __forceinline__ float ar16(float x) { x = ar8(x); x += dppf<0x140>(x); return x; }
__device__ __forceinline__ float ar32(float x) { x = ar16(x); x += __shfl_xor(x, 16); return x; }
__device__ __forceinline__ float ar64(float x) { x = ar32(x); x += __shfl_xor(x, 32); return x; }
__device__ __forceinline__ float sigmoidf_(float x) { return __builtin_amdgcn_rcpf(1.f + __expf(-x)); }
__device__ __forceinline__ float siluf_(float x) { return x * __builtin_amdgcn_rcpf(1.f + __expf(-x)); }
__device__ __forceinline__ float gla_alpha_(float x) { const float t = __expf(-x); const float sp = x < -15.f ? -x : __logf(1.f + t); return __expf(-sp * 0.0625f); }
__device__ __forceinline__ float softplusf_(float x) { return x > 20.f ? x : log1pf(expf(x)); }
__device__ __forceinline__ float rdl(float v, int l) { return __int_as_float(__builtin_amdgcn_readlane(__float_as_int(v), l)); }
__device__ __forceinline__ unsigned rdlu(unsigned v, int l) { return (unsigned)__builtin_amdgcn_readlane((int)v, l); }

__device__ __forceinline__ int map_even(int c) { if (c < 3072) return c; if (c < 5120) return c + 16; if (c < 8192) return c + 32; if (c < 8208) return c - 8192 + 3072; if (c < 8224) return c - 8208 + 5136; return -1; }
__device__ __forceinline__ int map_odd(int c) { if (c < 2048) return c; if (c < 6144) return c + 16; if (c < 6160) return c - 6144 + 2048; return -1; }

namespace pg8 {
constexpr int BM = 256, BK = 64, HALF = 128, HTB = HALF * BK * 2, STAGE_BYTES = 8 * HTB, NXCD = 8, WGM = 8;
__device__ __forceinline__ int lds_byte(int r, int c) { const int st = (r >> 4) * 2 + (c >> 5), rr = r & 15, cc = c & 31, ob = rr * 64 + cc * 2; return st * 1024 + (ob ^ (((ob >> 9) & 1) << 5)); }
__device__ __forceinline__ void stage_rc(int b, int& R, int& C) { const int st = b / 1024, sb = b % 1024, swz = sb ^ (((sb >> 9) & 1) << 5); R = (st >> 1) * 16 + swz / 64; C = (st & 1) * 32 + (swz % 64) / 2; }
struct Unit { int pm, pn; };
struct Gemm { const bf16_t* A; const bf16_t* Bt; int M, N, K; };
struct StaticOrder {
    int nM, nN, nwg, G, c;
    __device__ void init(int M, int N, int G_, int c_) { nM = M / BM; nN = N / BM; nwg = nM * nN; G = G_; c = c_; }
    __device__ bool next(int i, Unit& u) const {
        const long L = (long)i * G + c; if (L >= nwg) return false;
        int wgid = (int)L; { const int q = nwg / NXCD, r = nwg % NXCD, xcd = wgid % NXCD, off = wgid / NXCD; wgid = (xcd < r ? xcd * (q + 1) : r * (q + 1) + (xcd - r) * q) + off; }
        const int nig = WGM * nN, gid = wgid / nig, fm = gid * WGM, gsz = (nM - fm) < WGM ? (nM - fm) : WGM;
        u.pm = fm + ((wgid % nig) % gsz); u.pn = (wgid % nig) / gsz; return true;
    }
};

struct Epi {
    int kind;
    float* mod; const float* ada_b;
    bf16_t* P; int ldp; int ntile_main; float* G; int ng;
    const float* xp; const float* xs; float* xo; const float* gate; int layer;
    __device__ __forceinline__ void operator()(const f32x4 (&acc)[2][2][4][2], const Unit& u, int wr, int wc, int fr, int fq) const {
        const int row0 = u.pm * BM + wr * 64 + fr;
        const int col0 = u.pn * BM + wc * 32 + 8 * fq;
        if (kind == 0) {
#pragma unroll
            for (int ai = 0; ai < 2; ++ai)
#pragma unroll
                for (int m = 0; m < 4; ++m) { const int row = row0 + ai * HALF + m * 16;
                    if (row < NSEQ) {
#pragma unroll
                        for (int bj = 0; bj < 2; ++bj)
#pragma unroll
                            for (int n = 0; n < 2; ++n) { const int c = col0 + bj * HALF + n * 4; const f32x4 b = *(const f32x4*)(ada_b + c);
                                *(f32x4*)(mod + (size_t)row * 6144 + c) = acc[ai][bj][m][n] + b; } } }
        } else if (kind == 1) {
            if (u.pn < ntile_main) {
#pragma unroll
                for (int ai = 0; ai < 2; ++ai)
#pragma unroll
                    for (int m = 0; m < 4; ++m) { const int row = row0 + ai * HALF + m * 16;
                        if (row < NTOK) { bf16_t* rowp = P + (size_t)row * ldp + col0;
#pragma unroll
                            for (int bj = 0; bj < 2; ++bj) { const f32x4 v0 = acc[ai][bj][m][0], v1 = acc[ai][bj][m][1]; u32x4 o;
                                o.x = pk2(v0[0], v0[1]); o.y = pk2(v0[2], v0[3]); o.z = pk2(v1[0], v1[1]); o.w = pk2(v1[2], v1[3]);
                                *(u32x4*)(rowp + bj * HALF) = o; } } }
            } else {
#pragma unroll
                for (int ai = 0; ai < 2; ++ai)
#pragma unroll
                    for (int m = 0; m < 4; ++m) { const int row = row0 + ai * HALF + m * 16;
#pragma unroll
                        for (int bj = 0; bj < 2; ++bj)
#pragma unroll
                            for (int n = 0; n < 2; ++n) { const int c = bj * HALF + wc * 32 + 8 * fq + 4 * n;
                                if (row < NTOK && c < ng) *(f32x4*)(G + (size_t)row * ng + c) = acc[ai][bj][m][n]; } }
            }
        } else {
#pragma unroll
            for (int ai = 0; ai < 2; ++ai)
#pragma unroll
                for (int m = 0; m < 4; ++m) { const int row = row0 + ai * HALF + m * 16;
                    if (row < NTOK) {
                        const int seq = row < NTP ? (row >> 11) : (8 + row - NTP);
                        const float* xin = layer == 0 ? (row < NTP ? xp + (size_t)row * DM : xs + (size_t)(row - NTP) * DM) : xo + (size_t)row * DM;
                        const float* gp = gate + (size_t)seq * 6144 + layer * 3072 + 2048;
                        float* xw = xo + (size_t)row * DM;
#pragma unroll
                        for (int bj = 0; bj < 2; ++bj)
#pragma unroll
                            for (int n = 0; n < 2; ++n) { const int c = col0 + bj * HALF + n * 4;
                                const f32x4 xv = *(const f32x4*)(xin + c), gv = *(const f32x4*)(gp + c);
                                *(f32x4*)(xw + c) = xv + gv * acc[ai][bj][m][n]; } } }
        }
    }
};

__device__ __forceinline__ void gemm_phase(LAS unsigned char* lds, const Gemm g, const StaticOrder& S, const Epi& E, const int tid) {
    const int wid = __builtin_amdgcn_readfirstlane(tid >> 6), lane = tid & 63, wr = wid >> 2, wc = wid & 3, fr = lane & 15, fq = lane >> 4;
    const int K = g.K, nt = K / BK;
    unsigned voffA[2], voffB[2];
#pragma unroll
    for (int i = 0; i < 2; ++i) { int R, C; stage_rc(tid * 16 + i * 8192, R, C); voffA[i] = (unsigned)(R * K + C) * 2u;
        const int rho = R & 31, Rb = (R & ~31) + 8 * ((rho & 15) >> 2) + 4 * (rho >> 4) + (rho & 3);
        voffB[i] = (unsigned)(Rb * K + C) * 2u; }
    const size_t kstep = (size_t)(BK * 2);
    const size_t hstep = (size_t)HALF * K * 2;
    const size_t tstep = 2 * hstep;
    const unsigned ldsw = (unsigned)wid * 1024u;
    const int aoff = lds_byte(wr * 64 + fr, fq * 8), boff = lds_byte(wc * 32 + fr, fq * 8);
#define PG8_SA(b, h) (((b) * 2 + (h)) * HTB)
#define PG8_SB(b, h) ((4 + (b) * 2 + (h)) * HTB)
#define PG8_STAGE(bufoff, gbase, voff) do { _Pragma("unroll") for (int _i = 0; _i < 2; ++_i) \
        __builtin_amdgcn_global_load_lds((const unsigned*)((const char*)(gbase) + (voff)[_i]), (LAS unsigned*)(lds + (bufoff) + ldsw + _i * 8192), 16, 0, 0); } while (0)
#define PG8_LDA(dst, b, h) do { _Pragma("unroll") for (int m = 0; m < 4; ++m) _Pragma("unroll") for (int k = 0; k < 2; ++k) dst[m][k] = *(const LAS bf16x8*)(lds + PG8_SA(b, h) + aoff + m * 2048 + k * 1024); } while (0)
#define PG8_LDB(dst, b, h) do { _Pragma("unroll") for (int n = 0; n < 2; ++n) _Pragma("unroll") for (int k = 0; k < 2; ++k) dst[n][k] = *(const LAS bf16x8*)(lds + PG8_SB(b, h) + boff + n * 2048 + k * 1024); } while (0)
#define PG8_MMA(ai, bj, At, Bt) do { __builtin_amdgcn_s_setprio(1); _Pragma("unroll") for (int m = 0; m < 4; ++m) _Pragma("unroll") for (int n = 0; n < 2; ++n) _Pragma("unroll") for (int k = 0; k < 2; ++k) \
        acc[ai][bj][m][n] = __builtin_amdgcn_mfma_f32_16x16x32_bf16(Bt[n][k], At[m][k], acc[ai][bj][m][n], 0, 0, 0); __builtin_amdgcn_s_setprio(0); } while (0)
#define PG8_WAIT_V(n) asm volatile("s_waitcnt vmcnt(" #n ")" ::: "memory")
#define PG8_WAIT_L(n) asm volatile("s_waitcnt lgkmcnt(" #n ")" ::: "memory")
#define PG8_BAR __builtin_amdgcn_s_barrier()
#define PG8_SCHED __builtin_amdgcn_sched_barrier(0)
    Unit cur, nxt; int ui = 0;
    if (!S.next(0, cur)) return;
    f32x4 acc[2][2][4][2];
#pragma unroll
    for (int a = 0; a < 2; ++a)
#pragma unroll
        for (int b = 0; b < 2; ++b)
#pragma unroll
            for (int m = 0; m < 4; ++m)
#pragma unroll
                for (int n = 0; n < 2; ++n) acc[a][b][m][n] = (f32x4){0.f, 0.f, 0.f, 0.f};
    bf16x8 At[4][2], B0[2][2], B1[2][2];
    const char* cA = (const char*)g.A + (size_t)cur.pm * tstep; const char* cB = (const char*)g.Bt + (size_t)cur.pn * tstep;
    PG8_STAGE(PG8_SB(0, 0), cB, voffB); PG8_STAGE(PG8_SA(0, 0), cA, voffA); PG8_STAGE(PG8_SB(0, 1), cB + hstep, voffB); PG8_STAGE(PG8_SA(0, 1), cA + hstep, voffA);
    if (wr == 1) PG8_BAR;
    PG8_WAIT_V(4); PG8_BAR;
    PG8_STAGE(PG8_SB(1, 0), cB + kstep, voffB); PG8_STAGE(PG8_SA(1, 0), cA + kstep, voffA); PG8_STAGE(PG8_SB(1, 1), cB + hstep + kstep, voffB);
    PG8_WAIT_V(6); PG8_BAR;
    for (;;) {
        const bool has_next = S.next(ui + 1, nxt);
        const char* nA = has_next ? (const char*)g.A + (size_t)nxt.pm * tstep : cA; const char* nB = has_next ? (const char*)g.Bt + (size_t)nxt.pn * tstep : cB;
        for (int t = 0; t < nt; t += 2) {
            const bool last = (t == nt - 2);
            const char* a1 = cA + (size_t)(t + 1) * kstep;
            const char* a2 = last ? nA : cA + (size_t)(t + 2) * kstep; const char* b2 = last ? nB : cB + (size_t)(t + 2) * kstep;
            const char* a3 = a2 + kstep; const char* b3 = b2 + kstep;
            PG8_LDB(B0, 0, 0); PG8_SCHED; PG8_LDA(At, 0, 0); PG8_STAGE(PG8_SA(1, 1), a1 + hstep, voffA);
            PG8_WAIT_L(8); PG8_BAR; PG8_WAIT_L(0); PG8_MMA(0, 0, At, B0); PG8_BAR; PG8_SCHED;
            PG8_LDB(B1, 0, 1); PG8_STAGE(PG8_SB(0, 0), b2, voffB);
            PG8_BAR; PG8_WAIT_L(0); PG8_MMA(0, 1, At, B1); PG8_BAR;
            PG8_LDA(At, 0, 1); PG8_STAGE(PG8_SA(0, 0), a2, voffA);
            PG8_BAR; PG8_WAIT_L(0); PG8_MMA(1, 0, At, B0); PG8_BAR; PG8_SCHED;
            PG8_STAGE(PG8_SB(0, 1), b2 + hstep, voffB);
            PG8_WAIT_V(6); PG8_BAR; PG8_MMA(1, 1, At, B1); PG8_BAR;
            PG8_LDB(B0, 1, 0); PG8_SCHED; PG8_LDA(At, 1, 0); PG8_STAGE(PG8_SA(0, 1), a2 + hstep, voffA);
            PG8_WAIT_L(8); PG8_BAR; PG8_WAIT_L(0); PG8_MMA(0, 0, At, B0); PG8_BAR; PG8_SCHED;
            PG8_LDB(B1, 1, 1); PG8_STAGE(PG8_SB(1, 0), b3, voffB);
            PG8_BAR; PG8_WAIT_L(0); PG8_MMA(0, 1, At, B1); PG8_BAR;
            PG8_LDA(At, 1, 1); PG8_STAGE(PG8_SA(1, 0), a3, voffA);
            PG8_BAR; PG8_WAIT_L(0); PG8_MMA(1, 0, At, B0); PG8_BAR; PG8_SCHED;
            PG8_STAGE(PG8_SB(1, 1), b3 + hstep, voffB);
            PG8_WAIT_V(6); PG8_BAR; PG8_MMA(1, 1, At, B1); PG8_BAR;
        }
        E(acc, cur, wr, wc, fr, fq);
        if (!has_next) break;
#pragma unroll
        for (int a = 0; a < 2; ++a)
#pragma unroll
            for (int b = 0; b < 2; ++b)
#pragma unroll
                for (int m = 0; m < 4; ++m)
#pragma unroll
                    for (int n = 0; n < 2; ++n) acc[a][b][m][n] = (f32x4){0.f, 0.f, 0.f, 0.f};
        cur = nxt; cA = nA; cB = nB; ++ui;
    }
    PG8_WAIT_V(0);
    if (wr == 0) PG8_BAR;
    PG8_BAR;
#undef PG8_SA
#undef PG8_SB
#undef PG8_STAGE
#undef PG8_LDA
#undef PG8_LDB
#undef PG8_MMA
#undef PG8_WAIT_V
#undef PG8_WAIT_L
#undef PG8_BAR
#undef PG8_SCHED
}
}

typedef const __attribute__((address_space(4))) Params* KP;
struct Ctx {
    int lane, wave, gw, ngw, bid, nblk, tid;
    LAS unsigned char* lds;
};
#define WSP(T, off) ((T*)(P->ws + (off)))
#define DOP(T, off) ((T*)((unsigned char*)P->out + (off)))

__device__ __forceinline__ void transpose_item(const float* W, int ldw, bf16_t* WT, int K, int k0, int n0, int mapkind, LAS float* scr, int lane) {
    const int n = n0 + (lane & 31);
    const int sc = mapkind == 0 ? map_even(n) : (mapkind == 1 ? map_odd(n) : n);
#pragma unroll
    for (int i = 0; i < 32; ++i) { const int kk = 2 * i + (lane >> 5); scr[kk * 33 + (lane & 31)] = sc >= 0 ? W[(size_t)(k0 + kk) * ldw + sc] : 0.f; }
    asm volatile("s_waitcnt lgkmcnt(0)" ::: "memory");
    const int c = lane & 7;
#pragma unroll
    for (int j = 0; j < 4; ++j) { const int nn = (lane >> 3) + 8 * j; const LAS float* s = scr + (8 * c) * 33 + nn;
        u32x4 o; o.x = pk2(s[0 * 33], s[1 * 33]); o.y = pk2(s[2 * 33], s[3 * 33]); o.z = pk2(s[4 * 33], s[5 * 33]); o.w = pk2(s[6 * 33], s[7 * 33]);
        *(u32x4*)(WT + (size_t)(n0 + nn) * K + k0 + 8 * c) = o; }
    asm volatile("s_waitcnt lgkmcnt(0)" ::: "memory");
}

__device__ __forceinline__ void prep_weights(KP P, const Ctx& C, int gw, int ngw) {
    LAS float* scr = (LAS float*)(C.lds + C.wave * 8704);
    constexpr int I_WIN0 = 16 * (PE_PAD / 32), I_WIN1 = 16 * (PO_PAD / 32), I_WOUT = 32 * 32;
    constexpr int NIT = I_WIN0 + I_WIN1 + 2 * I_WOUT;
    for (int it = gw; it < NIT; it += ngw) {
        int r = it;
        if (r < I_WIN0) { const int nb = r % (PE_PAD / 32), kb = r / (PE_PAD / 32); transpose_item(P->in[14], 8224, WSP(bf16_t, WS_WIN0), 1024, kb * 64, nb * 32, 0, scr, C.lane); continue; } r -= I_WIN0;
        if (r < I_WIN1) { const int nb = r % (PO_PAD / 32), kb = r / (PO_PAD / 32); transpose_item(P->in[22], 6160, WSP(bf16_t, WS_WIN1), 1024, kb * 64, nb * 32, 1, scr, C.lane); continue; } r -= I_WIN1;
        if (r < I_WOUT) { const int nb = r % 32, kb = r / 32; transpose_item(P->in[15], 1024, WSP(bf16_t, WS_WOUT0), 2048, kb * 64, nb * 32, 2, scr, C.lane); continue; } r -= I_WOUT;
        { const int nb = r % 32, kb = r / 32; transpose_item(P->in[23], 1024, WSP(bf16_t, WS_WOUT1), 2048, kb * 64, nb * 32, 2, scr, C.lane); }
    }
}
__device__ __forceinline__ void phase_prep0(KP P, const Ctx& C) {
    LAS float* scr = (LAS float*)(C.lds + C.wave * 8704);
    constexpr int I_ADA = 2 * 16 * 96;
    for (int r = C.gw; r < I_ADA; r += C.ngw) {
        const int l = r / (16 * 96), rr = r % (16 * 96), nb = rr % 96, kb = rr / 96;
        transpose_item(P->in[11] + (size_t)l * 1024 * 3072, 3072, WSP(bf16_t, WS_ADAT) + (size_t)l * 3072 * 1024, 1024, kb * 64, nb * 32, 2, scr, C.lane);
    }
    const int gt = C.bid * 512 + C.tid, ngt = C.nblk * 512;
    bf16_t* cbf = WSP(bf16_t, WS_CBF);
    for (int i = gt; i < 256 * 512; i += ngt) { const int row = i >> 9, c2 = (i & 511) * 2; float a = 0.f, b = 0.f;
        if (row < NSEQ) { const float* cp = row < 8 ? P->in[2] + row * 1024 : P->in[3] + (row - 8) * 1024; a = siluf_(cp[c2]); b = siluf_(cp[c2 + 1]); }
        *(unsigned*)(cbf + (size_t)row * 1024 + c2) = pk2(a, b); }
    f32x2* rope = WSP(f32x2, WS_ROPE);
    for (int i = gt; i < 2049 * 64; i += ngt) { const int p = i >> 6, fi = i & 63; const float pos = p < 2048 ? (float)p : 16384.f;
        const float inv = expf(-(float)fi * (1.f / 64.f) * 9.210340371976184f); const float ang = pos * inv;
        const double ad = (double)ang; const double n = rint(ad * 0.15915494309189535); const float rr = (float)(ad - n * 6.283185307179586);
        rope[i] = (f32x2){cosf(rr), sinf(rr)}; }
    unsigned* hz = (unsigned*)(DOP(bf16_t, DO_HBUF) + (size_t)NTOK * 1024);
    for (int i = gt; i < 128 * 512; i += ngt) hz[i] = 0u;
    unsigned* yz = (unsigned*)(WSP(bf16_t, WS_Y) + (size_t)NTOK * 2048);
    for (int i = gt; i < 128 * 1024; i += ngt) yz[i] = 0u;
}

__device__ __forceinline__ void phase_hnorm(KP P, const Ctx& C, int layer) {
    const float* mod = WSP(float, WS_MOD); const float* nw = P->in[13] + layer * 1024; bf16_t* hb = DOP(bf16_t, DO_HBUF);
    for (int tok = C.gw; tok < NTOK; tok += C.ngw) {
        const float* xr = layer == 0 ? (tok < NTP ? P->in[0] + (size_t)tok * DM : P->in[1] + (size_t)(tok - NTP) * DM) : P->out + (size_t)tok * DM;
        const int seq = tok < NTP ? (tok >> 11) : (8 + tok - NTP);
        const float* md = mod + (size_t)seq * 6144 + layer * 3072;
        f32x4 v[4]; float ss = 0.f;
#pragma unroll
        for (int j = 0; j < 4; ++j) { v[j] = ((const f32x4*)xr)[C.lane + 64 * j]; ss += v[j].x * v[j].x + v[j].y * v[j].y + v[j].z * v[j].z + v[j].w * v[j].w; }
        ss = ar64(ss); const float rstd = rsqrtf(ss * (1.f / 1024.f) + EPS);
#pragma unroll
        for (int j = 0; j < 4; ++j) { const int idx = (C.lane + 64 * j) * 4;
            const f32x4 w = *(const f32x4*)(nw + idx), sh = *(const f32x4*)(md + idx), sc = *(const f32x4*)(md + 1024 + idx);
            const f32x4 h = v[j] * rstd * w * (sc + 1.f) + sh; u32x2 o; o.x = pk2(h.x, h.y); o.y = pk2(h.z, h.w);
            *(u32x2*)(hb + (size_t)tok * 1024 + idx) = o; }
    }
}

__device__ __forceinline__ void phase_prep_even(KP P, const Ctx& C) {
    const bf16_t* proj = WSP(bf16_t, WS_PROJ); const float* G = WSP(float, WS_GATES); float* GA = WSP(float, WS_GA); float* GB = WSP(float, WS_GB);
    bf16_t* ab = DOP(bf16_t, DO_ABUF); const float* cw = P->in[16]; const int lane = C.lane;
    for (int tok = C.gw; tok < NTOK; tok += C.ngw) {
        const bool isP = tok < NTP; const int t = isP ? (tok & 2047) : 0; const int si = tok - NTP;
        if (lane < 8) { const int h = lane; const float* g = G + (size_t)tok * 32;
            const float beta = sigmoidf_(g[h]); const float a = expf(-expf(P->in[17][h]) * softplusf_(g[8 + h] + P->in[18][h]));
            GA[(size_t)tok * 32 + h * 4] = a; GA[(size_t)tok * 32 + h * 4 + 1] = beta;
            const float ig = g[16 + h] + P->in[20][h], fg = g[24 + h] + P->in[20][8 + h];
            GB[(size_t)tok * 32 + h * 4] = ig; GB[(size_t)tok * 32 + h * 4 + 1] = -softplusf_(-fg); }
#pragma unroll 1
        for (int i = 0; i < 2; ++i) {
            float val[3][8];
            u32x4 raw[3][4];
#pragma unroll
            for (int s = 0; s < 3; ++s)
#pragma unroll
                for (int j = 0; j < 4; ++j) { const int back = 3 - j; const int rowi = (isP && t >= back) ? tok - back : tok;
                    u32x4 rr = *(const u32x4*)(proj + (size_t)rowi * PE_MAIN + s * 1024 + i * 512 + lane * 8);
                    if (t < back) rr = (u32x4){0u, 0u, 0u, 0u};
                    raw[s][j] = rr; }
#pragma unroll
            for (int s = 0; s < 3; ++s) { const int c0 = s * 1024 + i * 512 + lane * 8;
                float y[8];
#pragma unroll
                for (int e = 0; e < 8; ++e) y[e] = 0.f;
#pragma unroll
                for (int j = 0; j < 4; ++j) {
                    const int back = 3 - j; float u[8];
                    if (isP || t >= back) unpack8(raw[s][j], u);
                    else if (!isP) { const float* bp = P->in[5] + ((size_t)si * 3 + (t + j)) * 3072 + c0; const f32x4 b0 = *(const f32x4*)bp, b1 = *(const f32x4*)(bp + 4);
                        u[0] = b0.x; u[1] = b0.y; u[2] = b0.z; u[3] = b0.w; u[4] = b1.x; u[5] = b1.y; u[6] = b1.z; u[7] = b1.w; }
                    else {
#pragma unroll
                        for (int e = 0; e < 8; ++e) u[e] = 0.f; }
                    const f32x4 w0 = *(const f32x4*)(cw + j * 3072 + c0), w1 = *(const f32x4*)(cw + j * 3072 + c0 + 4);
                    y[0] += w0.x * u[0]; y[1] += w0.y * u[1]; y[2] += w0.z * u[2]; y[3] += w0.w * u[3];
                    y[4] += w1.x * u[4]; y[5] += w1.y * u[5]; y[6] += w1.z * u[6]; y[7] += w1.w * u[7];
                    if (isP) { if (j == 3 && t >= 2045) { float* pc = P->out + OUT_PCONV + ((size_t)(tok >> 11) * 3 + (t - 2045)) * 3072 + c0;
                            *(f32x4*)pc = (f32x4){u[0], u[1], u[2], u[3]}; *(f32x4*)(pc + 4) = (f32x4){u[4], u[5], u[6], u[7]}; } }
                    else if (j >= 1) { float* sc = P->out + OUT_SCONV + ((size_t)si * 3 + (j - 1)) * 3072 + c0;
                        *(f32x4*)sc = (f32x4){u[0], u[1], u[2], u[3]}; *(f32x4*)(sc + 4) = (f32x4){u[4], u[5], u[6], u[7]}; }
                }
#pragma unroll
                for (int e = 0; e < 8; ++e) val[s][e] = siluf_(y[e]);
            }
            float sq = 0.f, sk = 0.f, d = 0.f;
#pragma unroll
            for (int e = 0; e < 8; ++e) { sq += val[0][e] * val[0][e]; sk += val[1][e] * val[1][e]; d += val[0][e] * val[1][e]; }
            sq = ar16(sq); sk = ar16(sk); d = ar16(d);
            const float rq = rsqrtf(sq + EPS) * 0.08838834764831845f, rk = rsqrtf(sk + EPS);
#pragma unroll
            for (int e = 0; e < 8; ++e) { val[0][e] *= rq; val[1][e] *= rk; }
            *(u32x4*)(ab + (size_t)tok * 3072 + i * 512 + lane * 8) = pack8(val[0]);
            *(u32x4*)(ab + (size_t)tok * 3072 + 1024 + i * 512 + lane * 8) = pack8(val[1]);
            *(u32x4*)(ab + (size_t)tok * 3072 + 2048 + i * 512 + lane * 8) = pack8(val[2]);
            if ((lane & 15) == 0) GA[(size_t)tok * 32 + (4 * i + (lane >> 4)) * 4 + 2] = d * rq * rk;
        }
    }
}

template <int NLANES> __device__ __forceinline__ float arN(float x) { return NLANES == 16 ? ar16(x) : (NLANES == 8 ? ar8(x) : ar4(x)); }
template <int MODE, int DKL, int DR> __device__ __forceinline__ void rec_item(KP P, int item, int lane) {
    constexpr int DK = (MODE == 1 || MODE == 4) ? 64 : 128;
    constexpr int NL = DK / DKL;
    constexpr int CW = (64 / NL) * 2;
    constexpr int DV = (MODE == 0 || MODE == 1) ? 128 : (MODE == 4 ? CW : 256);
    constexpr int NCB = DV / CW;
    constexpr int NH = (MODE >= 2 && MODE <= 3) ? 4 : 8;
    constexpr int LD = MODE == 0 ? 3072 : ((MODE == 1 || MODE == 4) ? PE_MAIN : PO_MAIN);
    const int bh = item / NCB, cb = item % NCB, b = bh / NH, h = bh % NH;
    const int r = lane & (NL - 1), dv = cb * CW + (lane / NL) * 2;
    const bf16_t* src = (MODE == 0 ? DOP(bf16_t, DO_ABUF) : WSP(bf16_t, WS_PROJ)) + (size_t)b * TSEQ * LD;
    const int ko = (MODE == 0 ? 1024 + h * 128 : (MODE == 1 || MODE == 4) ? E_KB + h * 64 : MODE == 2 ? O_KC + h * 128 : O_KD + h * 128) + r * DKL;
    const int qo = (MODE == 0 ? h * 128 : (MODE == 1 || MODE == 4) ? E_QB + h * 64 : MODE == 2 ? O_QC + h * 128 : O_QD + h * 128) + r * DKL;
    const int vo = (MODE == 0 ? 2048 + h * 128 : MODE == 1 ? E_VB + h * 128 : MODE == 2 ? O_VC + h * 256 : O_VD + h * 256) + dv;
    float* gsrc = (MODE == 0 ? WSP(float, WS_GA) : WSP(float, WS_GB)) + (size_t)b * TSEQ * 32 + h * 4;
    const float* asrc = WSP(float, WS_ALPHA) + (size_t)b * TSEQ * 512 + h * 128 + r * DKL;
    bf16_t* yb = WSP(bf16_t, WS_Y) + (size_t)b * TSEQ * 2048 + (MODE == 0 ? h * 128 : MODE == 1 ? 1024 + h * 128 : MODE == 2 ? h * 256 : 1024 + h * 256) + dv;
    const float gam = 1.f - exp2f(-5.f - (float)h);
    struct TokIn { u32x4 k0, k1, q0, q1; unsigned v; f32x4 g; f32x4 a0, a1, a2, a3; };
    f32x2 S[DKL];
#pragma unroll
    for (int i = 0; i < DKL; ++i) S[i] = (f32x2){0.f, 0.f};
    float m = 0.f, A = 1.f;
    auto load = [&](TokIn& x, int t) {
        const int tt = t;
        const bf16_t* p = src + (size_t)tt * LD;
        x.k0 = *(const u32x4*)(p + ko); x.q0 = *(const u32x4*)(p + qo);
        if (DKL == 16) { x.k1 = *(const u32x4*)(p + ko + 8); x.q1 = *(const u32x4*)(p + qo + 8); }
        if (MODE != 4) x.v = *(const unsigned*)(p + vo);
        if (MODE == 0) { const f32x3 g3 = *(const f32x3*)(gsrc + (size_t)tt * 32); x.g.x = g3.x; x.g.y = g3.y; x.g.z = g3.z; }
        if (MODE == 1 || MODE == 4) { const f32x2 g2 = *(const f32x2*)(gsrc + (size_t)tt * 32); x.g.x = g2.x; x.g.y = g2.y; }
        if (MODE == 2) { const float* ap = asrc + (size_t)tt * 512; x.a0 = *(const f32x4*)ap; x.a1 = *(const f32x4*)(ap + 4);
            if (DKL == 16) { x.a2 = *(const f32x4*)(ap + 8); x.a3 = *(const f32x4*)(ap + 12); } }
    };
    auto step = [&](const TokIn& x, int t) {
        float k[16], q[16]; unpack8(x.k0, k); unpack8(x.q0, q);
        if (DKL == 16) { unpack8(x.k1, k + 8); unpack8(x.q1, q + 8); }
        f32x2 v = {1.f, 1.f};
        if (MODE != 4) v = (f32x2){bflo(x.v), bfhi(x.v)};
        f32x2 o = {0.f, 0.f};
        if (MODE == 0) {
            const float a = x.g.x, be = x.g.y, qk = x.g.z;
            f32x2 pka[4], pqa[4];
#pragma unroll
            for (int i = 0; i < 4; ++i) { pka[i] = S[i] * k[i]; pqa[i] = S[i] * q[i]; }
#pragma unroll
            for (int i = 4; i < DKL; ++i) { pka[i & 3] += S[i] * k[i]; pqa[i & 3] += S[i] * q[i]; }
            f32x2 pk = (pka[0] + pka[1]) + (pka[2] + pka[3]), pq = (pqa[0] + pqa[1]) + (pqa[2] + pqa[3]);
            { float p0 = pk.x, p1 = pk.y, p2 = pq.x, p3 = pq.y;
              if (NL == 8) ar8x4(p0, p1, p2, p3); else if (NL == 16) ar16x4(p0, p1, p2, p3); else { p0 = arN<NL>(p0); p1 = arN<NL>(p1); p2 = arN<NL>(p2); p3 = arN<NL>(p3); }
              pk = (f32x2){p0, p1}; pq = (f32x2){p2, p3}; }
            float An = a * A;
            const f32x2 u = (v - pk * An) * be;
            o = pq * An + u * qk;
            if (An < 1e-12f) {
#pragma unroll
                for (int i = 0; i < DKL; ++i) S[i] = S[i] * An;
                An = 1.f; }
            const f32x2 uh = u * __builtin_amdgcn_rcpf(An);
#pragma unroll
            for (int i = 0; i < DKL; ++i) S[i] = S[i] + uh * k[i];
            A = An;
        } else if (MODE == 1 || MODE == 4) {
            const float ig = x.g.x, lf = x.g.y;
            const float mn = fmaxf(lf + m, ig); const float dec = __expf(lf + m - mn), isc = __expf(ig - mn) * 0.125f; m = mn;
            const f32x2 u = v * isc;
            f32x2 oa[4] = {o, o, o, o};
#pragma unroll
            for (int i = 0; i < DKL; ++i) { S[i] = S[i] * dec + u * k[i]; oa[i & 3] += S[i] * q[i]; }
            o = (oa[0] + oa[1]) + (oa[2] + oa[3]);
            o.x = arN<NL>(o.x); if (MODE == 1) o.y = arN<NL>(o.y);
        } else if (MODE == 2) {
            const float al[16] = {x.a0.x, x.a0.y, x.a0.z, x.a0.w, x.a1.x, x.a1.y, x.a1.z, x.a1.w, x.a2.x, x.a2.y, x.a2.z, x.a2.w, x.a3.x, x.a3.y, x.a3.z, x.a3.w};
            f32x2 oa[4] = {o, o, o, o};
#pragma unroll
            for (int i = 0; i < DKL; ++i) { S[i] = S[i] * al[i] + v * k[i]; oa[i & 3] += S[i] * q[i]; }
            o = (oa[0] + oa[1]) + (oa[2] + oa[3]);
            if (NL == 16) { float p0 = o.x, p1 = o.y; ar16x2(p0, p1); o = (f32x2){p0, p1}; } else { o.x = arN<NL>(o.x); o.y = arN<NL>(o.y); }
            o *= 0.08838834764831845f;
        } else {
            f32x2 oa[4] = {o, o, o, o};
#pragma unroll
            for (int i = 0; i < DKL; ++i) { S[i] = S[i] * gam + v * k[i]; oa[i & 3] += S[i] * q[i]; }
            o = (oa[0] + oa[1]) + (oa[2] + oa[3]);
            if (NL == 16) { float p0 = o.x, p1 = o.y; ar16x2(p0, p1); o = (f32x2){p0, p1}; } else { o.x = arN<NL>(o.x); o.y = arN<NL>(o.y); }
        }
        if (MODE == 4) { if (lane == 0) gsrc[(size_t)t * 32 + 2] = __builtin_amdgcn_rcpf(fmaxf(fabsf(o.x), __expf(-m))); }
        else if (r == 0) *(unsigned*)(yb + (size_t)t * 2048) = pk2(o.x, o.y);
    };
    TokIn X[DR];
#pragma unroll
    for (int d = 0; d < DR; ++d) load(X[d], d);
    for (int t0 = 0; t0 < TSEQ; t0 += DR) {
#pragma unroll
        for (int d = 0; d < DR; ++d) { const int t = t0 + d;
            if (t < TSEQ) step(X[d], t);
            load(X[d], t + DR); }
    }
    if (MODE == 4) {
        if (lane < NL) {
#pragma unroll
            for (int i = 0; i < DKL; ++i) P->out[OUT_PMN + (size_t)bh * 64 + r * DKL + i] = S[i].x; }
        if (lane == 0) P->out[OUT_PMM + bh] = m;
    } else {
        float* ps = P->out + (MODE == 0 ? OUT_PGDN : MODE == 1 ? OUT_PMC : MODE == 2 ? OUT_PGLA : OUT_PRET) + (size_t)bh * DK * DV;
#pragma unroll
        for (int i = 0; i < DKL; ++i) *(f32x2*)(ps + (size_t)(r * DKL + i) * DV + dv) = (MODE == 0) ? S[i] * A : S[i];
    }
}

__device__ __forceinline__ void gdn_sample_item(KP P, int idx, int lane) {
    const int si = idx >> 3, h = idx & 7, tok = NTP + si;
    const float* Sin = P->in[4] + (size_t)idx * 128 * 128; float* Sout = P->out + OUT_SGDN + (size_t)idx * 128 * 128;
    const bf16_t* ab = DOP(bf16_t, DO_ABUF) + (size_t)tok * 3072 + h * 128;
    const float* ga = WSP(float, WS_GA) + (size_t)tok * 32;
    const unsigned kpk = *(const unsigned*)(ab + 1024 + 2 * lane), qpk = *(const unsigned*)(ab + 2 * lane), vpk = *(const unsigned*)(ab + 2048 + 2 * lane);
    const float a = ga[h * 4], be = ga[h * 4 + 1], qk = ga[h * 4 + 2];
    f32x2 pk = {0.f, 0.f}, pq = {0.f, 0.f};
#pragma unroll 8
    for (int d2 = 0; d2 < 64; ++d2) { const unsigned ku = rdlu(kpk, d2), qu = rdlu(qpk, d2);
        const f32x2 s0 = *(const f32x2*)(Sin + (size_t)(2 * d2) * 128 + 2 * lane), s1 = *(const f32x2*)(Sin + (size_t)(2 * d2 + 1) * 128 + 2 * lane);
        pk += s0 * bflo(ku) + s1 * bfhi(ku); pq += s0 * bflo(qu) + s1 * bfhi(qu); }
    const f32x2 v = {bflo(vpk), bfhi(vpk)};
    const f32x2 u = (v - pk * a) * be; const f32x2 o = pq * a + u * qk;
#pragma unroll 8
    for (int d2 = 0; d2 < 64; ++d2) { const unsigned ku = rdlu(kpk, d2);
        const f32x2 s0 = *(const f32x2*)(Sin + (size_t)(2 * d2) * 128 + 2 * lane), s1 = *(const f32x2*)(Sin + (size_t)(2 * d2 + 1) * 128 + 2 * lane);
        *(f32x2*)(Sout + (size_t)(2 * d2) * 128 + 2 * lane) = s0 * a + u * bflo(ku);
        *(f32x2*)(Sout + (size_t)(2 * d2 + 1) * 128 + 2 * lane) = s1 * a + u * bfhi(ku); }
    *(unsigned*)(WSP(bf16_t, WS_Y) + (size_t)tok * 2048 + h * 128 + 2 * lane) = pk2(o.x, o.y);
}

__device__ __forceinline__ void mlstm_sample_item(KP P, int idx, int lane) {
    const int si = idx >> 3, h = idx & 7, tok = NTP + si;
    const float* Cin = P->in[6] + (size_t)idx * 64 * 128; float* Cout = P->out + OUT_SMC + (size_t)idx * 64 * 128;
    const bf16_t* pr = WSP(bf16_t, WS_PROJ) + (size_t)tok * PE_MAIN;
    float* gb = WSP(float, WS_GB) + (size_t)tok * 32;
    const float m0 = P->in[8][idx], ig = gb[h * 4], lf = gb[h * 4 + 1];
    const float mn = fmaxf(lf + m0, ig); const float dec = expf(lf + m0 - mn), isc = expf(ig - mn) * 0.125f;
    const unsigned kpk = *(const unsigned*)(pr + E_KB + h * 64 + 2 * (lane & 31)), qpk = *(const unsigned*)(pr + E_QB + h * 64 + 2 * (lane & 31));
    const unsigned vpk = *(const unsigned*)(pr + E_VB + h * 128 + 2 * lane);
    const f32x2 uv = (f32x2){bflo(vpk), bfhi(vpk)} * isc;
    f32x2 num = {0.f, 0.f};
#pragma unroll 8
    for (int d2 = 0; d2 < 32; ++d2) { const unsigned ku = rdlu(kpk, d2), qu = rdlu(qpk, d2);
        const f32x2 s0 = *(const f32x2*)(Cin + (size_t)(2 * d2) * 128 + 2 * lane), s1 = *(const f32x2*)(Cin + (size_t)(2 * d2 + 1) * 128 + 2 * lane);
        const f32x2 n0 = s0 * dec + uv * bflo(ku), n1 = s1 * dec + uv * bfhi(ku);
        *(f32x2*)(Cout + (size_t)(2 * d2) * 128 + 2 * lane) = n0; *(f32x2*)(Cout + (size_t)(2 * d2 + 1) * 128 + 2 * lane) = n1;
        num += n0 * bflo(qu) + n1 * bfhi(qu); }
    const float kl = bf1(pr[E_KB + h * 64 + lane]), ql = bf1(pr[E_QB + h * 64 + lane]);
    const float nl = dec * P->in[7][(size_t)idx * 64 + lane] + isc * kl;
    const float den = ar64(nl * ql);
    P->out[OUT_SMN + (size_t)idx * 64 + lane] = nl;
    if (lane == 0) { P->out[OUT_SMM + idx] = mn; gb[h * 4 + 2] = 1.f / fmaxf(fabsf(den), expf(-mn)); }
    *(unsigned*)(WSP(bf16_t, WS_Y) + (size_t)tok * 2048 + 1024 + h * 128 + 2 * lane) = pk2(num.x, num.y);
}

__device__ __forceinline__ void phase_rec_even(KP P, const Ctx& C) {
    const int lane = C.lane;
    { const int slot = C.bid * 4 + (C.wave & 3), nslot = C.nblk * 4;
        if (C.wave < 4) { for (int g = slot; g < 1024; g += nslot) rec_item<0, 8, 8>(P, g, lane); }
        else { for (int q = slot; q < 576; q += nslot) { if (q < 512) rec_item<1, 8, 8>(P, q, lane); else rec_item<4, 8, 8>(P, q - 512, lane); } } }
    unsigned* ctr = WSP(unsigned, WS_CTL);
    for (;;) {
        int idx = 0; if (lane == 0) idx = (int)atomicAdd(ctr, 1u);
        idx = __builtin_amdgcn_readfirstlane(idx);
        if (idx >= 2048) break;
        if (idx < 1024) gdn_sample_item(P, idx, lane); else mlstm_sample_item(P, idx - 1024, lane);
    }
}

__device__ __forceinline__ void phase_post_even(KP P, const Ctx& C) {
    bf16_t* Y = WSP(bf16_t, WS_Y); const bf16_t* proj = WSP(bf16_t, WS_PROJ); const float* GB = WSP(float, WS_GB); const int lane = C.lane;
    for (int tok = C.gw; tok < NTOK; tok += C.ngw) {
#pragma unroll
        for (int i = 0; i < 4; ++i) { const int ch0 = i * 512 + lane * 8; float o[8], z[8], y[8];
            unpack8(*(const u32x4*)(Y + (size_t)tok * 2048 + ch0), o); unpack8(*(const u32x4*)(proj + (size_t)tok * PE_MAIN + E_Z + ch0), z);
            if (i < 2) { float ss = 0.f;
#pragma unroll
                for (int e = 0; e < 8; ++e) ss += o[e] * o[e];
                ss = ar16(ss); const float rs = rsqrtf(ss * (1.f / 128.f) + EPS); const float* w = P->in[19] + (ch0 & 127);
#pragma unroll
                for (int e = 0; e < 8; ++e) y[e] = o[e] * rs * w[e] * siluf_(z[e]);
            } else { const int hh = (ch0 - 1024) >> 7; const float dn = GB[(size_t)tok * 32 + hh * 4 + 2]; float ss = 0.f; float op[8];
                unpack8(*(const u32x4*)(proj + (size_t)tok * PE_MAIN + E_OP + ch0 - 1024), op);
#pragma unroll
                for (int e = 0; e < 8; ++e) { o[e] *= dn; ss += o[e] * o[e]; }
                ss = ar16(ss); const float rs = rsqrtf(ss * (1.f / 128.f) + EPS); const float* w = P->in[21] + (ch0 & 127);
#pragma unroll
                for (int e = 0; e < 8; ++e) y[e] = sigmoidf_(op[e]) * o[e] * rs * w[e] * siluf_(z[e]);
            }
            *(u32x4*)(Y + (size_t)tok * 2048 + ch0) = pack8(y);
        }
    }
}

__device__ __forceinline__ void phase_prep_odd(KP P, const Ctx& C) {
    bf16_t* proj = WSP(bf16_t, WS_PROJ); const float* G = WSP(float, WS_GATES); float* AL = WSP(float, WS_ALPHA); const f32x2* rope = WSP(f32x2, WS_ROPE);
    const float* w2 = P->in[24]; const float* b2 = P->in[25]; const int lane = C.lane;
    for (int tok = C.gw; tok < NTOK; tok += C.ngw) {
        const bool isP = tok < NTP; const int t = isP ? (tok & 2047) : 2048;
        float g[16];
#pragma unroll
        for (int r4 = 0; r4 < 4; ++r4) { const f32x4 gv = *(const f32x4*)(G + (size_t)tok * 16 + r4 * 4); g[r4 * 4] = gv.x; g[r4 * 4 + 1] = gv.y; g[r4 * 4 + 2] = gv.z; g[r4 * 4 + 3] = gv.w; }
        float x[8];
#pragma unroll
        for (int e = 0; e < 8; ++e) x[e] = b2[lane * 8 + e];
#pragma unroll
        for (int r = 0; r < 16; ++r) { const f32x4 wa = *(const f32x4*)(w2 + r * 512 + lane * 8), wb = *(const f32x4*)(w2 + r * 512 + lane * 8 + 4);
            x[0] += g[r] * wa.x; x[1] += g[r] * wa.y; x[2] += g[r] * wa.z; x[3] += g[r] * wa.w; x[4] += g[r] * wb.x; x[5] += g[r] * wb.y; x[6] += g[r] * wb.z; x[7] += g[r] * wb.w; }
        f32x4 a0, a1;
        a0.x = gla_alpha_(x[0]); a0.y = gla_alpha_(x[1]); a0.z = gla_alpha_(x[2]); a0.w = gla_alpha_(x[3]);
        a1.x = gla_alpha_(x[4]); a1.y = gla_alpha_(x[5]); a1.z = gla_alpha_(x[6]); a1.w = gla_alpha_(x[7]);
        *(f32x4*)(AL + (size_t)tok * 512 + lane * 8) = a0; *(f32x4*)(AL + (size_t)tok * 512 + lane * 8 + 4) = a1;
        const f32x2 cs = rope[t * 64 + lane];
        bf16_t* pr = proj + (size_t)tok * PO_MAIN;
#pragma unroll
        for (int h = 0; h < 4; ++h) {
            { bf16_t* q = pr + O_QD + h * 128; const float x1 = bf1(q[lane]), x2 = bf1(q[64 + lane]);
              const unsigned o = pk2(x1 * cs.x - x2 * cs.y, x1 * cs.y + x2 * cs.x); q[lane] = (bf16_t)(o & 0xffffu); q[64 + lane] = (bf16_t)(o >> 16); }
            { bf16_t* k = pr + O_KD + h * 128; const float x1 = bf1(k[lane]) * 0.08838834764831845f, x2 = bf1(k[64 + lane]) * 0.08838834764831845f;
              const unsigned o = pk2(x1 * cs.x - x2 * cs.y, x1 * cs.y + x2 * cs.x); k[lane] = (bf16_t)(o & 0xffffu); k[64 + lane] = (bf16_t)(o >> 16); }
        }
    }
}

template <bool GLA> __device__ __forceinline__ void odd_sample_item(KP P, int idx, int lane) {
    const int si = idx >> 2, h = idx & 3, tok = NTP + si;
    const float* Sin = P->in[GLA ? 9 : 10] + (size_t)idx * 128 * 256; float* Sout = P->out + (GLA ? OUT_SGLA : OUT_SRET) + (size_t)idx * 128 * 256;
    const bf16_t* pr = WSP(bf16_t, WS_PROJ) + (size_t)tok * PO_MAIN;
    const unsigned kpk = *(const unsigned*)(pr + (GLA ? O_KC : O_KD) + h * 128 + 2 * lane), qpk = *(const unsigned*)(pr + (GLA ? O_QC : O_QD) + h * 128 + 2 * lane);
    const u32x2 vpk = *(const u32x2*)(pr + (GLA ? O_VC : O_VD) + h * 256 + 4 * lane);
    const f32x4 v = {bflo(vpk.x), bfhi(vpk.x), bflo(vpk.y), bfhi(vpk.y)};
    const float gam = 1.f - exp2f(-5.f - (float)h);
    f32x2 alp = {gam, gam};
    if (GLA) alp = *(const f32x2*)(WSP(float, WS_ALPHA) + (size_t)tok * 512 + h * 128 + 2 * lane);
    f32x4 o = {0.f, 0.f, 0.f, 0.f};
#pragma unroll 8
    for (int d2 = 0; d2 < 64; ++d2) { const unsigned ku = rdlu(kpk, d2), qu = rdlu(qpk, d2); const float a0 = rdl(alp.x, d2), a1 = rdl(alp.y, d2);
        const f32x4 s0 = *(const f32x4*)(Sin + (size_t)(2 * d2) * 256 + 4 * lane), s1 = *(const f32x4*)(Sin + (size_t)(2 * d2 + 1) * 256 + 4 * lane);
        const f32x4 n0 = s0 * a0 + v * bflo(ku), n1 = s1 * a1 + v * bfhi(ku);
        *(f32x4*)(Sout + (size_t)(2 * d2) * 256 + 4 * lane) = n0; *(f32x4*)(Sout + (size_t)(2 * d2 + 1) * 256 + 4 * lane) = n1;
        o += n0 * bflo(qu) + n1 * bfhi(qu); }
    if (GLA) o *= 0.08838834764831845f;
    u32x2 op; op.x = pk2(o.x, o.y); op.y = pk2(o.z, o.w);
    *(u32x2*)(WSP(bf16_t, WS_Y) + (size_t)tok * 2048 + (GLA ? 0 : 1024) + h * 256 + 4 * lane) = op;
}

__device__ __forceinline__ void phase_rec_odd(KP P, const Ctx& C) {
    const int lane = C.lane;
    { const int slot = C.bid * 4 + (C.wave & 3), nslot = C.nblk * 4;
        if (C.wave < 4) { for (int g = slot; g < 1024; g += nslot) rec_item<2, 8, 8>(P, g, lane); }
        else { for (int g = slot; g < 1024; g += nslot) rec_item<3, 8, 8>(P, g, lane); } }
    unsigned* ctr = WSP(unsigned, WS_CTL) + 64;
    for (;;) {
        int idx = 0; if (lane == 0) idx = (int)atomicAdd(ctr, 1u);
        idx = __builtin_amdgcn_readfirstlane(idx);
        if (idx >= 1024) break;
        if (idx < 512) odd_sample_item<true>(P, idx, lane); else odd_sample_item<false>(P, idx - 512, lane);
    }
}

__device__ __forceinline__ void phase_post_odd(KP P, const Ctx& C) {
    bf16_t* Y = WSP(bf16_t, WS_Y); const bf16_t* proj = WSP(bf16_t, WS_PROJ); const int lane = C.lane;
    for (int tok = C.gw; tok < NTOK; tok += C.ngw) {
#pragma unroll
        for (int i = 0; i < 4; ++i) { const int ch0 = i * 512 + lane * 8; float o[8], z[8], y[8];
            unpack8(*(const u32x4*)(Y + (size_t)tok * 2048 + ch0), o); unpack8(*(const u32x4*)(proj + (size_t)tok * PO_MAIN + O_Z + ch0), z);
            float ss = 0.f;
#pragma unroll
            for (int e = 0; e < 8; ++e) ss += o[e] * o[e];
            ss = ar32(ss); const float rs = rsqrtf(ss * (1.f / 256.f) + EPS); const float* w = P->in[i < 2 ? 26 : 27] + (ch0 & 255);
#pragma unroll
            for (int e = 0; e < 8; ++e) y[e] = o[e] * rs * w[e] * siluf_(z[e]);
            *(u32x4*)(Y + (size_t)tok * 2048 + ch0) = pack8(y);
        }
    }
}

__device__ __forceinline__ void phase_final(KP P, const Ctx& C) {
    const float* fw = P->in[28];
    for (int tok = C.gw; tok < NTOK; tok += C.ngw) {
        float* xr = P->out + (size_t)tok * DM; f32x4 v[4]; float ss = 0.f;
#pragma unroll
        for (int j = 0; j < 4; ++j) { v[j] = ((const f32x4*)xr)[C.lane + 64 * j]; ss += v[j].x * v[j].x + v[j].y * v[j].y + v[j].z * v[j].z + v[j].w * v[j].w; }
        ss = ar64(ss); const float rstd = rsqrtf(ss * (1.f / 1024.f) + EPS);
#pragma unroll
        for (int j = 0; j < 4; ++j) { const int idx = (C.lane + 64 * j) * 4; ((f32x4*)xr)[C.lane + 64 * j] = v[j] * rstd * *(const f32x4*)(fw + idx); }
    }
}

__device__ __forceinline__ void sample_outproj(KP P, const Ctx& C, int layer) {
    const bf16_t* Y = WSP(bf16_t, WS_Y) + (size_t)NTP * 2048; const bf16_t* W = WSP(bf16_t, layer == 0 ? WS_WOUT0 : WS_WOUT1);
    const float* mod = WSP(float, WS_MOD); LAS float* red = (LAS float*)C.lds;
    const int lane = C.lane, w = C.wave;
    for (int task = C.bid; task < 256; task += C.nblk) {
        const int r0 = (task >> 5) * 16, c0 = (task & 31) * 32;
        f32x4 acc0 = {0.f, 0.f, 0.f, 0.f}, acc1 = acc0;
        const bf16_t* ap = Y + (size_t)(r0 + (lane & 15)) * 2048 + w * 256 + (lane >> 4) * 8;
        const bf16_t* bp0 = W + (size_t)(c0 + (lane & 15)) * 2048 + w * 256 + (lane >> 4) * 8; const bf16_t* bp1 = bp0 + (size_t)16 * 2048;
#pragma unroll
        for (int ks = 0; ks < 8; ++ks) { const bf16x8 a = *(const bf16x8*)(ap + ks * 32), b0 = *(const bf16x8*)(bp0 + ks * 32), b1 = *(const bf16x8*)(bp1 + ks * 32);
            acc0 = __builtin_amdgcn_mfma_f32_16x16x32_bf16(a, b0, acc0, 0, 0, 0); acc1 = __builtin_amdgcn_mfma_f32_16x16x32_bf16(a, b1, acc1, 0, 0, 0); }
        __syncthreads();
        *(LAS f32x4*)(red + ((w * 2 + 0) * 64 + lane) * 4) = acc0; *(LAS f32x4*)(red + ((w * 2 + 1) * 64 + lane) * 4) = acc1;
        __syncthreads();
        { const int e = C.tid, tile = e >> 8, idx = e & 255, ln = idx >> 2, j = idx & 3; float sum = 0.f;
#pragma unroll
          for (int ww = 0; ww < 8; ++ww) sum += red[((ww * 2 + tile) * 64 + ln) * 4 + j];
          const int row = r0 + (ln >> 4) * 4 + j, col = c0 + tile * 16 + (ln & 15);
          const float xin = layer == 0 ? P->in[1][(size_t)row * DM + col] : P->out[(size_t)(NTP + row) * DM + col];
          const float gt = mod[(size_t)(8 + row) * 6144 + layer * 3072 + 2048 + col];
          P->out[(size_t)(NTP + row) * DM + col] = xin + gt * sum; }
    }
    __syncthreads();
}

#define XB_XCNT(j)  (256  + 64 * (j))
#define XB_XSUB(j)  (1280 + 64 * (j))
#define XB_XGEN(j)  (2304 + 64 * (j))
#define XB_TOP      3328
#define XB_TOPGEN   3392
__device__ __forceinline__ unsigned xb_ld(unsigned* p) { return __hip_atomic_load(p, __ATOMIC_RELAXED, __HIP_MEMORY_SCOPE_AGENT); }
__device__ __forceinline__ unsigned xb_add(unsigned* p, unsigned v) { return __hip_atomic_fetch_add(p, v, __ATOMIC_RELAXED, __HIP_MEMORY_SCOPE_AGENT); }
__device__ __forceinline__ unsigned xb_xcc_id() { return (unsigned)__builtin_amdgcn_s_getreg((3 << 11) | 20) & 0xFu; }
__device__ __forceinline__ void xcd_bar(unsigned* bar, volatile unsigned* st) {
    asm volatile("s_waitcnt vmcnt(0)" ::: "memory");
    __syncthreads();
    if (threadIdx.x == 0) {
        __builtin_amdgcn_s_waitcnt(0);
        const unsigned x = xb_xcc_id();
        unsigned nloc = st[0], nx = st[1];
        if (nloc == 0u) {
            unsigned cnt, mine, sum;
            for (;;) { cnt = 0u; mine = 0u; sum = 0u;
#pragma unroll
                for (unsigned j = 0; j < 16; ++j) { const unsigned c = xb_ld(&bar[XB_XCNT(j)]); sum += c; cnt += (c > 0u) ? 1u : 0u; mine = (j == x) ? c : mine; }
                if (sum == gridDim.x) break;
                __builtin_amdgcn_s_sleep(1); }
            nloc = mine > 0u ? mine : 1u; nx = cnt > 0u ? cnt : 1u; st[0] = nloc; st[1] = nx;
        }
        const unsigned old = xb_add(&bar[XB_XSUB(x)], 1u);
        const unsigned gen = old / nloc;
        if (old + 1u == (gen + 1u) * nloc) {
            __builtin_amdgcn_fence(__ATOMIC_RELEASE, "agent");
            asm volatile("s_waitcnt vmcnt(0)" ::: "memory");
            const unsigned og = xb_add(&bar[XB_TOP], 1u);
            const unsigned tg = og / nx;
            if (og + 1u == (tg + 1u) * nx) xb_add(&bar[XB_TOPGEN], 1u);
            else { while (xb_ld(&bar[XB_TOPGEN]) == tg) __builtin_amdgcn_s_sleep(1); }
            __builtin_amdgcn_fence(__ATOMIC_ACQUIRE, "agent");
            xb_add(&bar[XB_XGEN(x)], 1u);
            asm volatile("s_waitcnt vmcnt(0)" ::: "memory");
        } else {
            while (xb_ld(&bar[XB_XGEN(x)]) == gen) __builtin_amdgcn_s_sleep(1);
            __builtin_amdgcn_fence(__ATOMIC_ACQUIRE, "agent");
            asm volatile("s_waitcnt vmcnt(0)" ::: "memory");
        }
    }
    __syncthreads();
}

#ifndef PH_MASK
#define PH_MASK 0x7fff
#endif
#define PH_ON(n) (((PH_MASK) >> (n)) & 1)
#ifndef PH_REP
#define PH_REP 0
#endif
#define PH_RP(n) (((PH_REP) >> (n)) & 1)
constexpr int NPHASE = 15;
__global__ void __launch_bounds__(512, 2) fwd_megakernel(Params PV) {
    extern __shared__ __attribute__((aligned(16))) unsigned char shm[];
    __shared__ __attribute__((aligned(16))) unsigned xb_st[4];
    Ctx C; C.lds = (LAS unsigned char*)shm;
    if (threadIdx.x == 0) { xb_st[0] = 0u; xb_st[1] = 0u; if (PV.ph_hi - PV.ph_lo > 1) (void)xb_add(((unsigned*)PV.ws) + XB_XCNT(xb_xcc_id()), 1u); }
    __syncthreads();
    for (int ph = PV.ph_lo; ph < PV.ph_hi; ++ph) {
        KP P = (KP)__builtin_amdgcn_kernarg_segment_ptr(); asm volatile("" : "+s"(P));
        { int tid = threadIdx.x; asm volatile("" : "+v"(tid)); int bid = blockIdx.x; asm volatile("" : "+s"(bid)); int nblk = gridDim.x; asm volatile("" : "+s"(nblk));
          C.tid = tid; C.bid = bid; C.nblk = nblk; C.lane = tid & 63; C.wave = __builtin_amdgcn_readfirstlane(tid >> 6); C.gw = bid * 8 + C.wave; C.ngw = nblk * 8; }
        const bool is_gemm = (ph == 1 || ph == 3 || ph == 7 || ph == 9 || ph == 13);
        if (is_gemm && PH_ON(1)) {
            pg8::Gemm g; pg8::Epi E; E.kind = 0; E.mod = WSP(float, WS_MOD); E.ada_b = P->in[12]; E.P = WSP(bf16_t, WS_PROJ); E.ldp = PE_MAIN; E.ntile_main = 32; E.G = WSP(float, WS_GATES); E.ng = 32;
            E.xp = P->in[0]; E.xs = P->in[1]; E.xo = P->out; E.gate = WSP(float, WS_MOD); E.layer = 0;
            if (ph == 1) { g.A = WSP(bf16_t, WS_CBF); g.Bt = WSP(bf16_t, WS_ADAT); g.M = 256; g.N = 6144; g.K = 1024; E.kind = 0; }
            else if (ph == 3) { g.A = DOP(bf16_t, DO_HBUF); g.Bt = WSP(bf16_t, WS_WIN0); g.M = MPAD; g.N = PE_PAD; g.K = 1024; E.kind = 1; }
            else if (ph == 7) { g.A = WSP(bf16_t, WS_Y); g.Bt = WSP(bf16_t, WS_WOUT0); g.M = NTP; g.N = 1024; g.K = 2048; E.kind = 2; E.layer = 0; }
            else if (ph == 9) { g.A = DOP(bf16_t, DO_HBUF); g.Bt = WSP(bf16_t, WS_WIN1); g.M = MPAD; g.N = PO_PAD; g.K = 1024; E.kind = 1; E.ldp = PO_MAIN; E.ntile_main = 24; E.ng = 16; }
            else { g.A = WSP(bf16_t, WS_Y); g.Bt = WSP(bf16_t, WS_WOUT1); g.M = NTP; g.N = 1024; g.K = 2048; E.kind = 2; E.layer = 1; }
            pg8::StaticOrder S; S.init(g.M, g.N, C.nblk, C.bid);
            for (int rep = 0; rep < 1 + PH_RP(ph); ++rep) { asm volatile("" : "+s"(rep)); pg8::gemm_phase(C.lds, g, S, E, C.tid); }
            if (E.kind == 2) sample_outproj(P, C, E.layer);
            if (ph == 1) { if (C.nblk > 24) { if (C.bid >= 24) prep_weights(P, C, (C.bid - 24) * 8 + C.wave, (C.nblk - 24) * 8); } else prep_weights(P, C, C.gw, C.ngw); }
        } else {
            switch (ph) {
                case 0: if (PH_ON(0)) phase_prep0(P, C); if (PH_RP(0)) { asm volatile("" : "+s"(P)); phase_prep0(P, C); } break;
                case 2: if (PH_ON(2)) phase_hnorm(P, C, 0); if (PH_RP(2)) { asm volatile("" : "+s"(P)); phase_hnorm(P, C, 0); } break;
                case 4: if (PH_ON(4)) phase_prep_even(P, C); if (PH_RP(4)) { asm volatile("" : "+s"(P)); phase_prep_even(P, C); } break;
                case 5: if (PH_ON(5)) phase_rec_even(P, C); if (PH_RP(5)) { asm volatile("" : "+s"(P)); phase_rec_even(P, C); } break;
                case 6: if (PH_ON(6)) phase_post_even(P, C); break;
                case 8: if (PH_ON(8)) phase_hnorm(P, C, 1); if (PH_RP(8)) { asm volatile("" : "+s"(P)); phase_hnorm(P, C, 1); } break;
                case 10: if (PH_ON(10)) phase_prep_odd(P, C); break;
                case 11: if (PH_ON(11)) phase_rec_odd(P, C); if (PH_RP(11)) { asm volatile("" : "+s"(P)); phase_rec_odd(P, C); } break;
                case 12: if (PH_ON(12)) phase_post_odd(P, C); break;
                case 14: if (PH_ON(14)) phase_final(P, C); break;
                default: break;
            }
        }
        if (ph + 1 < PV.ph_hi) {
            if (PV.ph_lo > 0 && ph == PV.ph_lo) cg::this_grid().sync();
            else xcd_bar(WSP(unsigned, WS_CTL), xb_st);
        }
    }
}

extern "C" void kernel_launch(void* const* d_in, const int* in_sizes, int n_in, void* d_out, int out_size, void* d_ws, size_t ws_size, hipStream_t stream) {
    constexpr size_t kDynLds = 131072;
    static int grid_blocks = 0;
    if (!grid_blocks) {
        if (n_in != 29 || ws_size < WS_END) { fprintf(stderr, "kernel_launch: unexpected n_in %d or ws_size %zu (need %zu)\n", n_in, ws_size, (size_t)WS_END); }
        int dev = 0, cus = 0, per_cu = 0;
        hipGetDevice(&dev);
        hipDeviceGetAttribute(&cus, hipDeviceAttributeMultiprocessorCount, dev);
        hipFuncSetAttribute((const void*)fwd_megakernel, hipFuncAttributeMaxDynamicSharedMemorySize, (int)kDynLds);
        hipOccupancyMaxActiveBlocksPerMultiprocessor(&per_cu, (const void*)fwd_megakernel, 512, kDynLds);
        if (per_cu < 1) { fprintf(stderr, "kernel_launch: occupancy query says %d blocks/CU\n", per_cu); per_cu = 1; }
        if (per_cu > 1) per_cu = 1;
        grid_blocks = cus * per_cu;
        (void)hipGetLastError();
    }
    hipMemsetAsync((char*)d_ws + WS_CTL, 0, 16384, stream);
    Params p{};
    for (int i = 0; i < 29; ++i) p.in[i] = (const float*)d_in[i];
    p.out = (float*)d_out; p.ws = (unsigned char*)d_ws;
#if MK_SPLIT
    for (int ph = 0; ph < NPHASE; ++ph) { p.ph_lo = ph; p.ph_hi = ph + 1;
        hipLaunchKernelGGL(fwd_megakernel, dim3(grid_blocks), dim3(512), kDynLds, stream, p); }
#else
    p.ph_lo = 0; p.ph_hi = NPHASE;
    void* args[] = {&p};
    hipError_t e = hipLaunchCooperativeKernel((const void*)fwd_megakernel, dim3(grid_blocks), dim3(512), args, kDynLds, stream);
    if (e != hipSuccess) fprintf(stderr, "cooperative launch failed: %s (grid %d)\n", hipGetErrorString(e), grid_blocks);
#endif
}
```

```cpp
#include <hip/hip_runtime.h>
#include <hip/hip_cooperative_groups.h>
#include <cstdio>
#include <cstdint>
namespace cg = cooperative_groups;

#ifndef MK_SPLIT
#define MK_SPLIT 0
#endif

#define LAS __attribute__((address_space(3)))
typedef unsigned short bf16_t;
typedef short bf16x8 __attribute__((ext_vector_type(8)));
typedef float f32x4 __attribute__((ext_vector_type(4)));
typedef float f32x2 __attribute__((ext_vector_type(2)));
typedef float f32x3 __attribute__((ext_vector_type(3)));
typedef unsigned u32x4 __attribute__((ext_vector_type(4)));
typedef unsigned u32x2 __attribute__((ext_vector_type(2)));

constexpr int DM = 1024, NTP = 16384, NTS = 128, NTOK = NTP + NTS, MPAD = 16640, TSEQ = 2048;
constexpr int NSEQ = 136;
constexpr float EPS = 1e-6f;
constexpr int PE_MAIN = 8192, PE_PAD = 8448, PO_MAIN = 6144, PO_PAD = 6400;
constexpr int E_QA = 0, E_KA = 1024, E_VA = 2048, E_QB = 3072, E_KB = 3584, E_VB = 4096, E_OP = 5120, E_Z = 6144;
constexpr int O_QC = 0, O_KC = 512, O_VC = 1024, O_QD = 2048, O_KD = 2560, O_VD = 3072, O_Z = 4096;
constexpr size_t OUT_Y = 0, OUT_PGDN = 16908288, OUT_PCONV = 17956864, OUT_PMC = 18030592, OUT_PMN = 18554880, OUT_PMM = 18558976,
                 OUT_PGLA = 18559040, OUT_PRET = 19607616, OUT_SGDN = 20656192, OUT_SCONV = 37433408, OUT_SMC = 38613056,
                 OUT_SMN = 47001664, OUT_SMM = 47067200, OUT_SGLA = 47068224, OUT_SRET = 63845440;
constexpr size_t WS_CTL = 0, WS_WIN0 = 16384, WS_WOUT0 = WS_WIN0 + (size_t)PE_PAD * 1024 * 2, WS_WIN1 = WS_WOUT0 + (size_t)1024 * 2048 * 2,
                 WS_WOUT1 = WS_WIN1 + (size_t)PO_PAD * 1024 * 2, WS_ADAT = WS_WOUT1 + (size_t)1024 * 2048 * 2, WS_CBF = WS_ADAT + (size_t)6144 * 1024 * 2,
                 WS_MOD = WS_CBF + (size_t)256 * 1024 * 2, WS_ROPE = WS_MOD + (size_t)NSEQ * 6144 * 4, WS_GATES = WS_ROPE + 1049600,
                 WS_GA = WS_GATES + (size_t)NTOK * 32 * 4, WS_GB = WS_GA + (size_t)NTOK * 32 * 4, WS_PROJ = WS_GB + (size_t)NTOK * 32 * 4,
                 WS_Y = WS_PROJ + (size_t)NTOK * PE_MAIN * 2, WS_END = WS_Y + (size_t)MPAD * 2048 * 2;
constexpr size_t WS_ALPHA = WS_PROJ + (size_t)NTOK * PO_MAIN * 2;
constexpr size_t DO_ABUF = OUT_SGLA * 4;
constexpr size_t DO_HBUF = OUT_SRET * 4 + (size_t)67108864 - (size_t)MPAD * 1024 * 2;

struct Params {
    const float* in[29];
    float* out;
    unsigned char* ws;
    int ph_lo, ph_hi;
};

__device__ __forceinline__ float bflo(unsigned u) { return __uint_as_float(u << 16); }
__device__ __forceinline__ float bfhi(unsigned u) { return __uint_as_float(u & 0xffff0000u); }
__device__ __forceinline__ float bf1(bf16_t b) { return __uint_as_float(((unsigned)b) << 16); }
__device__ __forceinline__ unsigned pk2(float lo, float hi) { unsigned r; asm("v_cvt_pk_bf16_f32 %0, %1, %2" : "=v"(r) : "v"(lo), "v"(hi)); return r; }
__device__ __forceinline__ void unpack8(u32x4 p, float* f) {
    f[0] = bflo(p.x); f[1] = bfhi(p.x); f[2] = bflo(p.y); f[3] = bfhi(p.y); f[4] = bflo(p.z); f[5] = bfhi(p.z); f[6] = bflo(p.w); f[7] = bfhi(p.w);
}
__device__ __forceinline__ u32x4 pack8(const float* f) { u32x4 o; o.x = pk2(f[0], f[1]); o.y = pk2(f[2], f[3]); o.z = pk2(f[4], f[5]); o.w = pk2(f[6], f[7]); return o; }
template <int CTRL> __device__ __forceinline__ float dppf(float x) { return __int_as_float(__builtin_amdgcn_update_dpp(0, __float_as_int(x), CTRL, 0xf, 0xf, true)); }
__device__ __forceinline__ float ar4(float x) { x += dppf<0xB1>(x); x += dppf<0x4E>(x); return x; }
__device__ __forceinline__ float ar8(float x) { x = ar4(x); x += dppf<0x141>(x); return x; }
__device__ __forceinline__ void ar8x4(float& a, float& b, float& c, float& d) {
    asm volatile(
        "s_nop 1\n\t"
        "v_add_f32_dpp %0, %0, %0 quad_perm:[1,0,3,2] row_mask:0xf bank_mask:0xf bound_ctrl:1\n\t"
        "v_add_f32_dpp %1, %1, %1 quad_perm:[1,0,3,2] row_mask:0xf bank_mask:0xf bound_ctrl:1\n\t"
        "v_add_f32_dpp %2, %2, %2 quad_perm:[1,0,3,2] row_mask:0xf bank_mask:0xf bound_ctrl:1\n\t"
        "v_add_f32_dpp %3, %3, %3 quad_perm:[1,0,3,2] row_mask:0xf bank_mask:0xf bound_ctrl:1\n\t"
        "v_add_f32_dpp %0, %0, %0 quad_perm:[2,3,0,1] row_mask:0xf bank_mask:0xf bound_ctrl:1\n\t"
        "v_add_f32_dpp %1, %1, %1 quad_perm:[2,3,0,1] row_mask:0xf bank_mask:0xf bound_ctrl:1\n\t"
        "v_add_f32_dpp %2, %2, %2 quad_perm:[2,3,0,1] row_mask:0xf bank_mask:0xf bound_ctrl:1\n\t"
        "v_add_f32_dpp %3, %3, %3 quad_perm:[2,3,0,1] row_mask:0xf bank_mask:0xf bound_ctrl:1\n\t"
        "v_add_f32_dpp %0, %0, %0 row_half_mirror row_mask:0xf bank_mask:0xf bound_ctrl:1\n\t"
        "v_add_f32_dpp %1, %1, %1 row_half_mirror row_mask:0xf bank_mask:0xf bound_ctrl:1\n\t"
        "v_add_f32_dpp %2, %2, %2 row_half_mirror row_mask:0xf bank_mask:0xf bound_ctrl:1\n\t"
        "v_add_f32_dpp %3, %3, %3 row_half_mirror row_mask:0xf bank_mask:0xf bound_ctrl:1\n\t"
        : "+v"(a), "+v"(b), "+v"(c), "+v"(d));
}
__device__ __forceinline__ void ar16x4(float& a, float& b, float& c, float& d) {
    asm volatile(
        "s_nop 1\n\t"
        "v_add_f32_dpp %0, %0, %0 quad_perm:[1,0,3,2] row_mask:0xf bank_mask:0xf bound_ctrl:1\n\t"
        "v_add_f32_dpp %1, %1, %1 quad_perm:[1,0,3,2] row_mask:0xf bank_mask:0xf bound_ctrl:1\n\t"
        "v_add_f32_dpp %2, %2, %2 quad_perm:[1,0,3,2] row_mask:0xf bank_mask:0xf bound_ctrl:1\n\t"
        "v_add_f32_dpp %3, %3, %3 quad_perm:[1,0,3,2] row_mask:0xf bank_mask:0xf bound_ctrl:1\n\t"
        "v_add_f32_dpp %0, %0, %0 quad_perm:[2,3,0,1] row_mask:0xf bank_mask:0xf bound_ctrl:1\n\t"
        "v_add_f32_dpp %1, %1, %1 quad_perm:[2,3,0,1] row_mask:0xf bank_mask:0xf bound_ctrl:1\n\t"
        "v_add_f32_dpp %2, %2, %2 quad_perm:[2,3,0,1] row_mask:0xf bank_mask:0xf bound_ctrl:1\n\t"
        "v_add_f32_dpp %3, %3, %3 quad_perm:[2,3,0,1] row_mask:0xf bank_mask:0xf bound_ctrl:1\n\t"
        "v_add_f32_dpp %0, %0, %0 row_half_mirror row_mask:0xf bank_mask:0xf bound_ctrl:1\n\t"
        "v_add_f32_dpp %1, %1, %1 row_half_mirror row_mask:0xf bank_mask:0xf bound_ctrl:1\n\t"
        "v_add_f32_dpp %2, %2, %2 row_half_mirror row_mask:0xf bank_mask:0xf bound_ctrl:1\n\t"
        "v_add_f32_dpp %3, %3, %3 row_half_mirror row_mask:0xf bank_mask:0xf bound_ctrl:1\n\t"
        "v_add_f32_dpp %0, %0, %0 row_mirror row_mask:0xf bank_mask:0xf bound_ctrl:1\n\t"
        "v_add_f32_dpp %1, %1, %1 row_mirror row_mask:0xf bank_mask:0xf bound_ctrl:1\n\t"
        "v_add_f32_dpp %2, %2, %2 row_mirror row_mask:0xf bank_mask:0xf bound_ctrl:1\n\t"
        "v_add_f32_dpp %3, %3, %3 row_mirror row_mask:0xf bank_mask:0xf bound_ctrl:1\n\t"
        : "+v"(a), "+v"(b), "+v"(c), "+v"(d));
}
__device__ __forceinline__ void ar16x2(float& a, float& b) {
    asm volatile(
        "s_nop 1\n\t"
        "v_add_f32_dpp %0, %0, %0 quad_perm:[1,0,3,2] row_mask:0xf bank_mask:0xf bound_ctrl:1\n\t"
        "v_add_f32_dpp %1, %1, %1 quad_perm:[1,0,3,2] row_mask:0xf bank_mask:0xf bound_ctrl:1\n\t"
        "s_nop 0\n\t"
        "v_add_f32_dpp %0, %0, %0 quad_perm:[2,3,0,1] row_mask:0xf bank_mask:0xf bound_ctrl:1\n\t"
        "v_add_f32_dpp %1, %1, %1 quad_perm:[2,3,0,1] row_mask:0xf bank_mask:0xf bound_ctrl:1\n\t"
        "s_nop 0\n\t"
        "v_add_f32_dpp %0, %0, %0 row_half_mirror row_mask:0xf bank_mask:0xf bound_ctrl:1\n\t"
        "v_add_f32_dpp %1, %1, %1 row_half_mirror row_mask:0xf bank_mask:0xf bound_ctrl:1\n\t"
        "s_nop 0\n\t"
        "v_add_f32_dpp %0, %0, %0 row_mirror row_mask:0xf bank_mask:0xf bound_ctrl:1\n\t"
        "v_add_f32_dpp %1, %1, %1 row_mirror row_mask:0xf bank_mask:0xf bound_ctrl:1\n\t"
        : "+v"(a), "+v"(b));
}
__device__ __forceinline__ float ar16(float x) { x = ar8(x); x += dppf<0x140>(x); return x; }
__device__ __forceinline__ float ar32(float x) { x = ar16(x); x += __shfl_xor(x, 16); return x; }
__device__ __forceinline__ float ar64(float x) { x = ar32(x); x += __shfl_xor(x, 32); return x; }
__device__ __forceinline__ float sigmoidf_(float x) { return __builtin_amdgcn_rcpf(1.f + __expf(-x)); }
__device__ __forceinline__ float siluf_(float x) { return x * __builtin_amdgcn_rcpf(1.f + __expf(-x)); }
__device__ __forceinline__ float gla_alpha_(float x) { const float t = __expf(-x); const float sp = x < -15.f ? -x : __logf(1.f + t); return __expf(-sp * 0.0625f); }
__device__ __forceinline__ float softplusf_(float x) { return x > 20.f ? x : log1pf(expf(x)); }
__device__ __forceinline__ float rdl(float v, int l) { return __int_as_float(__builtin_amdgcn_readlane(__float_as_int(v), l)); }
__device__ __forceinline__ unsigned rdlu(unsigned v, int l) { return (unsigned)__builtin_amdgcn_readlane((int)v, l); }

__device__ __forceinline__ int map_even(int c) { if (c < 3072) return c; if (c < 5120) return c + 16; if (c < 8192) return c + 32; if (c < 8208) return c - 8192 + 3072; if (c < 8224) return c - 8208 + 5136; return -1; }
__device__ __forceinline__ int map_odd(int c) { if (c < 2048) return c; if (c < 6144) return c + 16; if (c < 6160) return c - 6144 + 2048; return -1; }

namespace pg8 {
constexpr int BM = 256, BK = 64, HALF = 128, HTB = HALF * BK * 2, STAGE_BYTES = 8 * HTB, NXCD = 8, WGM = 8;
__device__ __forceinline__ int lds_byte(int r, int c) { const int st = (r >> 4) * 2 + (c >> 5), rr = r & 15, cc = c & 31, ob = rr * 64 + cc * 2; return st * 1024 + (ob ^ (((ob >> 9) & 1) << 5)); }
__device__ __forceinline__ void stage_rc(int b, int& R, int& C) { const int st = b / 1024, sb = b % 1024, swz = sb ^ (((sb >> 9) & 1) << 5); R = (st >> 1) * 16 + swz / 64; C = (st & 1) * 32 + (swz % 64) / 2; }
struct Unit { int pm, pn; };
struct Gemm { const bf16_t* A; const bf16_t* Bt; int M, N, K; };
struct StaticOrder {
    int nM, nN, nwg, G, c;
    __device__ void init(int M, int N, int G_, int c_) { nM = M / BM; nN = N / BM; nwg = nM * nN; G = G_; c = c_; }
    __device__ bool next(int i, Unit& u) const {
        const long L = (long)i * G + c; if (L >= nwg) return false;
        int wgid = (int)L; { const int q = nwg / NXCD, r = nwg % NXCD, xcd = wgid % NXCD, off = wgid / NXCD; wgid = (xcd < r ? xcd * (q + 1) : r * (q + 1) + (xcd - r) * q) + off; }
        const int nig = WGM * nN, gid = wgid / nig, fm = gid * WGM, gsz = (nM - fm) < WGM ? (nM - fm) : WGM;
        u.pm = fm + ((wgid % nig) % gsz); u.pn = (wgid % nig) / gsz; return true;
    }
};

struct Epi {
    int kind;
    float* mod; const float* ada_b;
    bf16_t* P; int ldp; int ntile_main; float* G; int ng;
    const float* xp; const float* xs; float* xo; const float* gate; int layer;
    __device__ __forceinline__ void operator()(const f32x4 (&acc)[2][2][4][2], const Unit& u, int wr, int wc, int fr, int fq) const {
        const int row0 = u.pm * BM + wr * 64 + fr;
        const int col0 = u.pn * BM + wc * 32 + 8 * fq;
        if (kind == 0) {
#pragma unroll
            for (int ai = 0; ai < 2; ++ai)
#pragma unroll
                for (int m = 0; m < 4; ++m) { const int row = row0 + ai * HALF + m * 16;
                    if (row < NSEQ) {
#pragma unroll
                        for (int bj = 0; bj < 2; ++bj)
#pragma unroll
                            for (int n = 0; n < 2; ++n) { const int c = col0 + bj * HALF + n * 4; const f32x4 b = *(const f32x4*)(ada_b + c);
                                *(f32x4*)(mod + (size_t)row * 6144 + c) = acc[ai][bj][m][n] + b; } } }
        } else if (kind == 1) {
            if (u.pn < ntile_main) {
#pragma unroll
                for (int ai = 0; ai < 2; ++ai)
#pragma unroll
                    for (int m = 0; m < 4; ++m) { const int row = row0 + ai * HALF + m * 16;
                        if (row < NTOK) { bf16_t* rowp = P + (size_t)row * ldp + col0;
#pragma unroll
                            for (int bj = 0; bj < 2; ++bj) { const f32x4 v0 = acc[ai][bj][m][0], v1 = acc[ai][bj][m][1]; u32x4 o;
                                o.x = pk2(v0[0], v0[1]); o.y = pk2(v0[2], v0[3]); o.z = pk2(v1[0], v1[1]); o.w = pk2(v1[2], v1[3]);
                                *(u32x4*)(rowp + bj * HALF) = o; } } }
            } else {
#pragma unroll
                for (int ai = 0; ai < 2; ++ai)
#pragma unroll
                    for (int m = 0; m < 4; ++m) { const int row = row0 + ai * HALF + m * 16;
#pragma unroll
                        for (int bj = 0; bj < 2; ++bj)
#pragma unroll
                            for (int n = 0; n < 2; ++n) { const int c = bj * HALF + wc * 32 + 8 * fq + 4 * n;
                                if (row < NTOK && c < ng) *(f32x4*)(G + (size_t)row * ng + c) = acc[ai][bj][m][n]; } }
            }
        } else {
#pragma unroll
            for (int ai = 0; ai < 2; ++ai)
#pragma unroll
                for (int m = 0; m < 4; ++m) { const int row = row0 + ai * HALF + m * 16;
                    if (row < NTOK) {
                        const int seq = row < NTP ? (row >> 11) : (8 + row - NTP);
                        const float* xin = layer == 0 ? (row < NTP ? xp + (size_t)row * DM : xs + (size_t)(row - NTP) * DM) : xo + (size_t)row * DM;
                        const float* gp = gate + (size_t)seq * 6144 + layer * 3072 + 2048;
                        float* xw = xo + (size_t)row * DM;
#pragma unroll
                        for (int bj = 0; bj < 2; ++bj)
#pragma unroll
                            for (int n = 0; n < 2; ++n) { const int c = col0 + bj * HALF + n * 4;
                                const f32x4 xv = *(const f32x4*)(xin + c), gv = *(const f32x4*)(gp + c);
                                *(f32x4*)(xw + c) = xv + gv * acc[ai][bj][m][n]; } } }
        }
    }
};

__device__ __forceinline__ void gemm_phase(LAS unsigned char* lds, const Gemm g, const StaticOrder& S, const Epi& E, const int tid) {
    const int wid = __builtin_amdgcn_readfirstlane(tid >> 6), lane = tid & 63, wr = wid >> 2, wc = wid & 3, fr = lane & 15, fq = lane >> 4;
    const int K = g.K, nt = K / BK;
    unsigned voffA[2], voffB[2];
#pragma unroll
    for (int i = 0; i < 2; ++i) { int R, C; stage_rc(tid * 16 + i * 8192, R, C); voffA[i] = (unsigned)(R * K + C) * 2u;
        const int rho = R & 31, Rb = (R & ~31) + 8 * ((rho & 15) >> 2) + 4 * (rho >> 4) + (rho & 3);
        voffB[i] = (unsigned)(Rb * K + C) * 2u; }
    const size_t kstep = (size_t)(BK * 2);
    const size_t hstep = (size_t)HALF * K * 2;
    const size_t tstep = 2 * hstep;
    const unsigned ldsw = (unsigned)wid * 1024u;
    const int aoff = lds_byte(wr * 64 + fr, fq * 8), boff = lds_byte(wc * 32 + fr, fq * 8);
#define PG8_SA(b, h) (((b) * 2 + (h)) * HTB)
#define PG8_SB(b, h) ((4 + (b) * 2 + (h)) * HTB)
#define PG8_STAGE(bufoff, gbase, voff) do { _Pragma("unroll") for (int _i = 0; _i < 2; ++_i) \
        __builtin_amdgcn_global_load_lds((const unsigned*)((const char*)(gbase) + (voff)[_i]), (LAS unsigned*)(lds + (bufoff) + ldsw + _i * 8192), 16, 0, 0); } while (0)
#define PG8_LDA(dst, b, h) do { _Pragma("unroll") for (int m = 0; m < 4; ++m) _Pragma("unroll") for (int k = 0; k < 2; ++k) dst[m][k] = *(const LAS bf16x8*)(lds + PG8_SA(b, h) + aoff + m * 2048 + k * 1024); } while (0)
#define PG8_LDB(dst, b, h) do { _Pragma("unroll") for (int n = 0; n < 2; ++n) _Pragma("unroll") for (int k = 0; k < 2; ++k) dst[n][k] = *(const LAS bf16x8*)(lds + PG8_SB(b, h) + boff + n * 2048 + k * 1024); } while (0)
#define PG8_MMA(ai, bj, At, Bt) do { __builtin_amdgcn_s_setprio(1); _Pragma("unroll") for (int m = 0; m < 4; ++m) _Pragma("unroll") for (int n = 0; n < 2; ++n) _Pragma("unroll") for (int k = 0; k < 2; ++k) \
        acc[ai][bj][m][n] = __builtin_amdgcn_mfma_f32_16x16x32_bf16(Bt[n][k], At[m][k], acc[ai][bj][m][n], 0, 0, 0); __builtin_amdgcn_s_setprio(0); } while (0)
#define PG8_WAIT_V(n) asm volatile("s_waitcnt vmcnt(" #n ")" ::: "memory")
#define PG8_WAIT_L(n) asm volatile("s_waitcnt lgkmcnt(" #n ")" ::: "memory")
#define PG8_BAR __builtin_amdgcn_s_barrier()
#define PG8_SCHED __builtin_amdgcn_sched_barrier(0)
    Unit cur, nxt; int ui = 0;
    if (!S.next(0, cur)) return;
    f32x4 acc[2][2][4][2];
#pragma unroll
    for (int a = 0; a < 2; ++a)
#pragma unroll
        for (int b = 0; b < 2; ++b)
#pragma unroll
            for (int m = 0; m < 4; ++m)
#pragma unroll
                for (int n = 0; n < 2; ++n) acc[a][b][m][n] = (f32x4){0.f, 0.f, 0.f, 0.f};
    bf16x8 At[4][2], B0[2][2], B1[2][2];
    const char* cA = (const char*)g.A + (size_t)cur.pm * tstep; const char* cB = (const char*)g.Bt + (size_t)cur.pn * tstep;
    PG8_STAGE(PG8_SB(0, 0), cB, voffB); PG8_STAGE(PG8_SA(0, 0), cA, voffA); PG8_STAGE(PG8_SB(0, 1), cB + hstep, voffB); PG8_STAGE(PG8_SA(0, 1), cA + hstep, voffA);
    if (wr == 1) PG8_BAR;
    PG8_WAIT_V(4); PG8_BAR;
    PG8_STAGE(PG8_SB(1, 0), cB + kstep, voffB); PG8_STAGE(PG8_SA(1, 0), cA + kstep, voffA); PG8_STAGE(PG8_SB(1, 1), cB + hstep + kstep, voffB);
    PG8_WAIT_V(6); PG8_BAR;
    for (;;) {
        const bool has_next = S.next(ui + 1, nxt);
        const char* nA = has_next ? (const char*)g.A + (size_t)nxt.pm * tstep : cA; const char* nB = has_next ? (const char*)g.Bt + (size_t)nxt.pn * tstep : cB;
        for (int t = 0; t < nt; t += 2) {
            const bool last = (t == nt - 2);
            const char* a1 = cA + (size_t)(t + 1) * kstep;
            const char* a2 = last ? nA : cA + (size_t)(t + 2) * kstep; const char* b2 = last ? nB : cB + (size_t)(t + 2) * kstep;
            const char* a3 = a2 + kstep; const char* b3 = b2 + kstep;
            PG8_LDB(B0, 0, 0); PG8_SCHED; PG8_LDA(At, 0, 0); PG8_STAGE(PG8_SA(1, 1), a1 + hstep, voffA);
            PG8_WAIT_L(8); PG8_BAR; PG8_WAIT_L(0); PG8_MMA(0, 0, At, B0); PG8_BAR; PG8_SCHED;
            PG8_LDB(B1, 0, 1); PG8_STAGE(PG8_SB(0, 0), b2, voffB);
            PG8_BAR; PG8_WAIT_L(0); PG8_MMA(0, 1, At, B1); PG8_BAR;
            PG8_LDA(At, 0, 1); PG8_STAGE(PG8_SA(0, 0), a2, voffA);
            PG8_BAR; PG8_WAIT_L(0); PG8_MMA(1, 0, At, B0); PG8_BAR; PG8_SCHED;
            PG8_STAGE(PG8_SB(0, 1), b2 + hstep, voffB);
            PG8_WAIT_V(6); PG8_BAR; PG8_MMA(1, 1, At, B1); PG8_BAR;
            PG8_LDB(B0, 1, 0); PG8_SCHED; PG8_LDA(At, 1, 0); PG8_STAGE(PG8_SA(0, 1), a2 + hstep, voffA);
            PG8_WAIT_L(8); PG8_BAR; PG8_WAIT_L(0); PG8_MMA(0, 0, At, B0); PG8_BAR; PG8_SCHED;
            PG8_LDB(B1, 1, 1); PG8_STAGE(PG8_SB(1, 0), b3, voffB);
            PG8_BAR; PG8_WAIT_L(0); PG8_MMA(0, 1, At, B1); PG8_BAR;
            PG8_LDA(At, 1, 1); PG8_STAGE(PG8_SA(1, 0), a3, voffA);
            PG8_BAR; PG8_WAIT_L(0); PG8_MMA(1, 0, At, B0); PG8_BAR; PG8_SCHED;
            PG8_STAGE(PG8_SB(1, 1), b3 + hstep, voffB);
            PG8_WAIT_V(6); PG8_BAR; PG8_MMA(1, 1, At, B1); PG8_BAR;
        }
        E(acc, cur, wr, wc, fr, fq);
        if (!has_next) break;
#pragma unroll
        for (int a = 0; a < 2; ++a)
#pragma unroll
            for (int b = 0; b < 2; ++b)
#pragma unroll
                for (int m = 0; m < 4; ++m)
#pragma unroll
                    for (int n = 0; n < 2; ++n) acc[a][b][m][n] = (f32x4){0.f, 0.f, 0.f, 0.f};
        cur = nxt; cA = nA; cB = nB; ++ui;
    }
    PG8_WAIT_V(0);
    if (wr == 0) PG8_BAR;
    PG8_BAR;
#undef PG8_SA
#undef PG8_SB
#undef PG8_STAGE
#undef PG8_LDA
#undef PG8_LDB
#undef PG8_MMA
#undef PG8_WAIT_V
#undef PG8_WAIT_L
#undef PG8_BAR
#undef PG8_SCHED
}
}

typedef const __attribute__((address_space(4))) Params* KP;
struct Ctx {
    int lane, wave, gw, ngw, bid, nblk, tid;
    LAS unsigned char* lds;
};
#define WSP(T, off) ((T*)(P->ws + (off)))
#define DOP(T, off) ((T*)((unsigned char*)P->out + (off)))

__device__ __forceinline__ void transpose_item(const float* W, int ldw, bf16_t* WT, int K, int k0, int n0, int mapkind, LAS float* scr, int lane) {
    const int n = n0 + (lane & 31);
    const int sc = mapkind == 0 ? map_even(n) : (mapkind == 1 ? map_odd(n) : n);
#pragma unroll
    for (int i = 0; i < 32; ++i) { const int kk = 2 * i + (lane >> 5); scr[kk * 33 + (lane & 31)] = sc >= 0 ? W[(size_t)(k0 + kk) * ldw + sc] : 0.f; }
    asm volatile("s_waitcnt lgkmcnt(0)" ::: "memory");
    const int c = lane & 7;
#pragma unroll
    for (int j = 0; j < 4; ++j) { const int nn = (lane >> 3) + 8 * j; const LAS float* s = scr + (8 * c) * 33 + nn;
        u32x4 o; o.x = pk2(s[0 * 33], s[1 * 33]); o.y = pk2(s[2 * 33], s[3 * 33]); o.z = pk2(s[4 * 33], s[5 * 33]); o.w = pk2(s[6 * 33], s[7 * 33]);
        *(u32x4*)(WT + (size_t)(n0 + nn) * K + k0 + 8 * c) = o; }
    asm volatile("s_waitcnt lgkmcnt(0)" ::: "memory");
}

__device__ __forceinline__ void prep_weights(KP P, const Ctx& C, int gw, int ngw) {
    LAS float* scr = (LAS float*)(C.lds + C.wave * 8704);
    constexpr int I_WIN0 = 16 * (PE_PAD / 32), I_WIN1 = 16 * (PO_PAD / 32), I_WOUT = 32 * 32;
    constexpr int NIT = I_WIN0 + I_WIN1 + 2 * I_WOUT;
    for (int it = gw; it < NIT; it += ngw) {
        int r = it;
        if (r < I_WIN0) { const int nb = r % (PE_PAD / 32), kb = r / (PE_PAD / 32); transpose_item(P->in[14], 8224, WSP(bf16_t, WS_WIN0), 1024, kb * 64, nb * 32, 0, scr, C.lane); continue; } r -= I_WIN0;
        if (r < I_WIN1) { const int nb = r % (PO_PAD / 32), kb = r / (PO_PAD / 32); transpose_item(P->in[22], 6160, WSP(bf16_t, WS_WIN1), 1024, kb * 64, nb * 32, 1, scr, C.lane); continue; } r -= I_WIN1;
        if (r < I_WOUT) { const int nb = r % 32, kb = r / 32; transpose_item(P->in[15], 1024, WSP(bf16_t, WS_WOUT0), 2048, kb * 64, nb * 32, 2, scr, C.lane); continue; } r -= I_WOUT;
        { const int nb = r % 32, kb = r / 32; transpose_item(P->in[23], 1024, WSP(bf16_t, WS_WOUT1), 2048, kb * 64, nb * 32, 2, scr, C.lane); }
    }
}
__device__ __forceinline__ void phase_prep0(KP P, const Ctx& C) {
    LAS float* scr = (LAS float*)(C.lds + C.wave * 8704);
    constexpr int I_ADA = 2 * 16 * 96;
    for (int r = C.gw; r < I_ADA; r += C.ngw) {
        const int l = r / (16 * 96), rr = r % (16 * 96), nb = rr % 96, kb = rr / 96;
        transpose_item(P->in[11] + (size_t)l * 1024 * 3072, 3072, WSP(bf16_t, WS_ADAT) + (size_t)l * 3072 * 1024, 1024, kb * 64, nb * 32, 2, scr, C.lane);
    }
    const int gt = C.bid * 512 + C.tid, ngt = C.nblk * 512;
    bf16_t* cbf = WSP(bf16_t, WS_CBF);
    for (int i = gt; i < 256 * 512; i += ngt) { const int row = i >> 9, c2 = (i & 511) * 2; float a = 0.f, b = 0.f;
        if (row < NSEQ) { const float* cp = row < 8 ? P->in[2] + row * 1024 : P->in[3] + (row - 8) * 1024; a = siluf_(cp[c2]); b = siluf_(cp[c2 + 1]); }
        *(unsigned*)(cbf + (size_t)row * 1024 + c2) = pk2(a, b); }
    f32x2* rope = WSP(f32x2, WS_ROPE);
    for (int i = gt; i < 2049 * 64; i += ngt) { const int p = i >> 6, fi = i & 63; const float pos = p < 2048 ? (float)p : 16384.f;
        const float inv = expf(-(float)fi * (1.f / 64.f) * 9.210340371976184f); const float ang = pos * inv;
        const double ad = (double)ang; const double n = rint(ad * 0.15915494309189535); const float rr = (float)(ad - n * 6.283185307179586);
        rope[i] = (f32x2){cosf(rr), sinf(rr)}; }
    unsigned* hz = (unsigned*)(DOP(bf16_t, DO_HBUF) + (size_t)NTOK * 1024);
    for (int i = gt; i < 128 * 512; i += ngt) hz[i] = 0u;
    unsigned* yz = (unsigned*)(WSP(bf16_t, WS_Y) + (size_t)NTOK * 2048);
    for (int i = gt; i < 128 * 1024; i += ngt) yz[i] = 0u;
}

__device__ __forceinline__ void phase_hnorm(KP P, const Ctx& C, int layer) {
    const float* mod = WSP(float, WS_MOD); const float* nw = P->in[13] + layer * 1024; bf16_t* hb = DOP(bf16_t, DO_HBUF);
    for (int tok = C.gw; tok < NTOK; tok += C.ngw) {
        const float* xr = layer == 0 ? (tok < NTP ? P->in[0] + (size_t)tok * DM : P->in[1] + (size_t)(tok - NTP) * DM) : P->out + (size_t)tok * DM;
        const int seq = tok < NTP ? (tok >> 11) : (8 + tok - NTP);
        const float* md = mod + (size_t)seq * 6144 + layer * 3072;
        f32x4 v[4]; float ss = 0.f;
#pragma unroll
        for (int j = 0; j < 4; ++j) { v[j] = ((const f32x4*)xr)[C.lane + 64 * j]; ss += v[j].x * v[j].x + v[j].y * v[j].y + v[j].z * v[j].z + v[j].w * v[j].w; }
        ss = ar64(ss); const float rstd = rsqrtf(ss * (1.f / 1024.f) + EPS);
#pragma unroll
        for (int j = 0; j < 4; ++j) { const int idx = (C.lane + 64 * j) * 4;
            const f32x4 w = *(const f32x4*)(nw + idx), sh = *(const f32x4*)(md + idx), sc = *(const f32x4*)(md + 1024 + idx);
            const f32x4 h = v[j] * rstd * w * (sc + 1.f) + sh; u32x2 o; o.x = pk2(h.x, h.y); o.y = pk2(h.z, h.w);
            *(u32x2*)(hb + (size_t)tok * 1024 + idx) = o; }
    }
}

template <int S0, int NS> __device__ __forceinline__ void prep_even_rows(KP P, const Ctx& C, int i, int tok0, int t0) {
    const bf16_t* proj = WSP(bf16_t, WS_PROJ); const float* G = WSP(float, WS_GATES); float* GA = WSP(float, WS_GA); float* GB = WSP(float, WS_GB);
    bf16_t* ab = DOP(bf16_t, DO_ABUF); const float* cw = P->in[16]; const int lane = C.lane;
    f32x4 w[NS][4][2];
#pragma unroll
    for (int s = 0; s < NS; ++s)
#pragma unroll
        for (int j = 0; j < 4; ++j) { const float* wp = cw + j * 3072 + (S0 + s) * 1024 + i * 512 + lane * 8; w[s][j][0] = *(const f32x4*)wp; w[s][j][1] = *(const f32x4*)(wp + 4); }
    u32x4 win[NS][4];
#pragma unroll
    for (int s = 0; s < NS; ++s)
#pragma unroll
        for (int j = 0; j < 3; ++j) { u32x4 rr = {0u, 0u, 0u, 0u};
            if (t0 != 0) rr = *(const u32x4*)(proj + (size_t)(tok0 + j - 3) * PE_MAIN + (S0 + s) * 1024 + i * 512 + lane * 8);
            win[s][j] = rr; }
    u32x4 nxt[NS], nx2[NS];
#pragma unroll
    for (int s = 0; s < NS; ++s) { nxt[s] = *(const u32x4*)(proj + (size_t)tok0 * PE_MAIN + (S0 + s) * 1024 + i * 512 + lane * 8);
        nx2[s] = *(const u32x4*)(proj + (size_t)(tok0 + 1) * PE_MAIN + (S0 + s) * 1024 + i * 512 + lane * 8); }
#pragma unroll 1
    for (int tt = 0; tt < 16; ++tt) { const int tu = 0, tok = tok0 + tt, t = t0 + tt;
#pragma unroll
        for (int s = 0; s < NS; ++s) { if (tt > 0) { win[s][0] = win[s][1]; win[s][1] = win[s][2]; win[s][2] = win[s][3]; }
            win[s][3] = nxt[s]; nxt[s] = nx2[s];
            nx2[s] = *(const u32x4*)(proj + (size_t)(tok + 2) * PE_MAIN + (S0 + s) * 1024 + i * 512 + lane * 8); }
        if (S0 == 0 && i == 0 && lane < 8) { const int h = lane; const float* g = G + (size_t)tok * 32;
            const float beta = sigmoidf_(g[h]); const float a = expf(-expf(P->in[17][h]) * softplusf_(g[8 + h] + P->in[18][h]));
            GA[(size_t)tok * 32 + h * 4] = a; GA[(size_t)tok * 32 + h * 4 + 1] = beta;
            const float ig = g[16 + h] + P->in[20][h], fg = g[24 + h] + P->in[20][8 + h];
            GB[(size_t)tok * 32 + h * 4] = ig; GB[(size_t)tok * 32 + h * 4 + 1] = -softplusf_(-fg); }
        float val[NS][8];
#pragma unroll
        for (int s = 0; s < NS; ++s) { float y[8];
#pragma unroll
            for (int e = 0; e < 8; ++e) y[e] = 0.f;
#pragma unroll
            for (int j = 0; j < 4; ++j) { float u[8]; unpack8(win[s][(tu + j) & 3], u);
                const f32x4 w0 = w[s][j][0], w1 = w[s][j][1];
                y[0] += w0.x * u[0]; y[1] += w0.y * u[1]; y[2] += w0.z * u[2]; y[3] += w0.w * u[3];
                y[4] += w1.x * u[4]; y[5] += w1.y * u[5]; y[6] += w1.z * u[6]; y[7] += w1.w * u[7];
                if (j == 3 && t >= 2045) { float* pc = P->out + OUT_PCONV + ((size_t)(tok >> 11) * 3 + (t - 2045)) * 3072 + (S0 + s) * 1024 + i * 512 + lane * 8;
                    *(f32x4*)pc = (f32x4){u[0], u[1], u[2], u[3]}; *(f32x4*)(pc + 4) = (f32x4){u[4], u[5], u[6], u[7]}; } }
#pragma unroll
            for (int e = 0; e < 8; ++e) val[s][e] = siluf_(y[e]); }
        if (S0 == 0) {
            float sq = 0.f, sk = 0.f, d = 0.f;
#pragma unroll
            for (int e = 0; e < 8; ++e) { sq += val[0][e] * val[0][e]; sk += val[NS - 1][e] * val[NS - 1][e]; d += val[0][e] * val[NS - 1][e]; }
            sq = ar16(sq); sk = ar16(sk); d = ar16(d);
            const float rq = rsqrtf(sq + EPS) * 0.08838834764831845f, rk = rsqrtf(sk + EPS);
#pragma unroll
            for (int e = 0; e < 8; ++e) { val[0][e] *= rq; val[NS - 1][e] *= rk; }
            *(u32x4*)(ab + (size_t)tok * 3072 + i * 512 + lane * 8) = pack8(val[0]);
            *(u32x4*)(ab + (size_t)tok * 3072 + 1024 + i * 512 + lane * 8) = pack8(val[NS - 1]);
            if ((lane & 15) == 0) GA[(size_t)tok * 32 + (4 * i + (lane >> 4)) * 4 + 2] = d * rq * rk;
        } else {
            *(u32x4*)(ab + (size_t)tok * 3072 + 2048 + i * 512 + lane * 8) = pack8(val[0]);
        }
    }
}
__device__ __forceinline__ void phase_prep_even_prompt(KP P, const Ctx& C) {
    for (int wi = C.gw; wi < 2048; wi += C.ngw) {
        const int i = wi & 1, tok0 = (wi >> 1) * 16, t0 = tok0 & 2047;
        prep_even_rows<0, 2>(P, C, i, tok0, t0);
        prep_even_rows<2, 1>(P, C, i, tok0, t0);
    }
}
__device__ __forceinline__ void phase_prep_even(KP P, const Ctx& C) {
    const bf16_t* proj = WSP(bf16_t, WS_PROJ); const float* G = WSP(float, WS_GATES); float* GA = WSP(float, WS_GA); float* GB = WSP(float, WS_GB);
    bf16_t* ab = DOP(bf16_t, DO_ABUF); const float* cw = P->in[16]; const int lane = C.lane;
    phase_prep_even_prompt(P, C);
    for (int tok = NTP + C.gw; tok < NTOK; tok += C.ngw) {
        const bool isP = tok < NTP; const int t = isP ? (tok & 2047) : 0; const int si = tok - NTP;
        if (lane < 8) { const int h = lane; const float* g = G + (size_t)tok * 32;
            const float beta = sigmoidf_(g[h]); const float a = expf(-expf(P->in[17][h]) * softplusf_(g[8 + h] + P->in[18][h]));
            GA[(size_t)tok * 32 + h * 4] = a; GA[(size_t)tok * 32 + h * 4 + 1] = beta;
            const float ig = g[16 + h] + P->in[20][h], fg = g[24 + h] + P->in[20][8 + h];
            GB[(size_t)tok * 32 + h * 4] = ig; GB[(size_t)tok * 32 + h * 4 + 1] = -softplusf_(-fg); }
#pragma unroll 1
        for (int i = 0; i < 2; ++i) {
            float val[3][8];
            u32x4 raw[3][4];
#pragma unroll
            for (int s = 0; s < 3; ++s)
#pragma unroll
                for (int j = 0; j < 4; ++j) { const int back = 3 - j; const int rowi = (isP && t >= back) ? tok - back : tok;
                    u32x4 rr = *(const u32x4*)(proj + (size_t)rowi * PE_MAIN + s * 1024 + i * 512 + lane * 8);
                    if (t < back) rr = (u32x4){0u, 0u, 0u, 0u};
                    raw[s][j] = rr; }
#pragma unroll
            for (int s = 0; s < 3; ++s) { const int c0 = s * 1024 + i * 512 + lane * 8;
                float y[8];
#pragma unroll
                for (int e = 0; e < 8; ++e) y[e] = 0.f;
#pragma unroll
                for (int j = 0; j < 4; ++j) {
                    const int back = 3 - j; float u[8];
                    if (isP || t >= back) unpack8(raw[s][j], u);
                    else if (!isP) { const float* bp = P->in[5] + ((size_t)si * 3 + (t + j)) * 3072 + c0; const f32x4 b0 = *(const f32x4*)bp, b1 = *(const f32x4*)(bp + 4);
                        u[0] = b0.x; u[1] = b0.y; u[2] = b0.z; u[3] = b0.w; u[4] = b1.x; u[5] = b1.y; u[6] = b1.z; u[7] = b1.w; }
                    else {
#pragma unroll
                        for (int e = 0; e < 8; ++e) u[e] = 0.f; }
                    const f32x4 w0 = *(const f32x4*)(cw + j * 3072 + c0), w1 = *(const f32x4*)(cw + j * 3072 + c0 + 4);
                    y[0] += w0.x * u[0]; y[1] += w0.y * u[1]; y[2] += w0.z * u[2]; y[3] += w0.w * u[3];
                    y[4] += w1.x * u[4]; y[5] += w1.y * u[5]; y[6] += w1.z * u[6]; y[7] += w1.w * u[7];
                    if (isP) { if (j == 3 && t >= 2045) { float* pc = P->out + OUT_PCONV + ((size_t)(tok >> 11) * 3 + (t - 2045)) * 3072 + c0;
                            *(f32x4*)pc = (f32x4){u[0], u[1], u[2], u[3]}; *(f32x4*)(pc + 4) = (f32x4){u[4], u[5], u[6], u[7]}; } }
                    else if (j >= 1) { float* sc = P->out + OUT_SCONV + ((size_t)si * 3 + (j - 1)) * 3072 + c0;
                        *(f32x4*)sc = (f32x4){u[0], u[1], u[2], u[3]}; *(f32x4*)(sc + 4) = (f32x4){u[4], u[5], u[6], u[7]}; }
                }
#pragma unroll
                for (int e = 0; e < 8; ++e) val[s][e] = siluf_(y[e]);
            }
            float sq = 0.f, sk = 0.f, d = 0.f;
#pragma unroll
            for (int e = 0; e < 8; ++e) { sq += val[0][e] * val[0][e]; sk += val[1][e] * val[1][e]; d += val[0][e] * val[1][e]; }
            sq = ar16(sq); sk = ar16(sk); d = ar16(d);
            const float rq = rsqrtf(sq + EPS) * 0.08838834764831845f, rk = rsqrtf(sk + EPS);
#pragma unroll
            for (int e = 0; e < 8; ++e) { val[0][e] *= rq; val[1][e] *= rk; }
            *(u32x4*)(ab + (size_t)tok * 3072 + i * 512 + lane * 8) = pack8(val[0]);
            *(u32x4*)(ab + (size_t)tok * 3072 + 1024 + i * 512 + lane * 8) = pack8(val[1]);
            *(u32x4*)(ab + (size_t)tok * 3072 + 2048 + i * 512 + lane * 8) = pack8(val[2]);
            if ((lane & 15) == 0) GA[(size_t)tok * 32 + (4 * i + (lane >> 4)) * 4 + 2] = d * rq * rk;
        }
    }
}

template <int NLANES> __device__ __forceinline__ float arN(float x) { return NLANES == 16 ? ar16(x) : (NLANES == 8 ? ar8(x) : ar4(x)); }
template <int MODE, int DKL, int DR> __device__ __forceinline__ void rec_item(KP P, int item, int lane) {
    constexpr int DK = (MODE == 1 || MODE == 4) ? 64 : 128;
    constexpr int NL = DK / DKL;
    constexpr int CW = (64 / NL) * 2;
    constexpr int DV = (MODE == 0 || MODE == 1) ? 128 : (MODE == 4 ? CW : 256);
    constexpr int NCB = DV / CW;
    constexpr int NH = (MODE >= 2 && MODE <= 3) ? 4 : 8;
    constexpr int LD = MODE == 0 ? 3072 : ((MODE == 1 || MODE == 4) ? PE_MAIN : PO_MAIN);
    const int bh = item / NCB, cb = item % NCB, b = bh / NH, h = bh % NH;
    const int r = lane & (NL - 1), dv = cb * CW + (lane / NL) * 2;
    const bf16_t* src = (MODE == 0 ? DOP(bf16_t, DO_ABUF) : WSP(bf16_t, WS_PROJ)) + (size_t)b * TSEQ * LD;
    const int ko = (MODE == 0 ? 1024 + h * 128 : (MODE == 1 || MODE == 4) ? E_KB + h * 64 : MODE == 2 ? O_KC + h * 128 : O_KD + h * 128) + r * DKL;
    const int qo = (MODE == 0 ? h * 128 : (MODE == 1 || MODE == 4) ? E_QB + h * 64 : MODE == 2 ? O_QC + h * 128 : O_QD + h * 128) + r * DKL;
    const int vo = (MODE == 0 ? 2048 + h * 128 : MODE == 1 ? E_VB + h * 128 : MODE == 2 ? O_VC + h * 256 : O_VD + h * 256) + dv;
    float* gsrc = (MODE == 0 ? WSP(float, WS_GA) : WSP(float, WS_GB)) + (size_t)b * TSEQ * 32 + h * 4;
    const float* asrc = WSP(float, WS_ALPHA) + (size_t)b * TSEQ * 512 + h * 128 + r * DKL;
    bf16_t* yb = WSP(bf16_t, WS_Y) + (size_t)b * TSEQ * 2048 + (MODE == 0 ? h * 128 : MODE == 1 ? 1024 + h * 128 : MODE == 2 ? h * 256 : 1024 + h * 256) + dv;
    const float gam = 1.f - exp2f(-5.f - (float)h);
    struct TokIn { u32x4 k0, k1, q0, q1; unsigned v; f32x4 g; f32x4 a0, a1, a2, a3; };
    f32x2 S[DKL];
#pragma unroll
    for (int i = 0; i < DKL; ++i) S[i] = (f32x2){0.f, 0.f};
    float m = 0.f, A = 1.f;
    auto load = [&](TokIn& x, int t) {
        const int tt = t;
        const bf16_t* p = src + (size_t)tt * LD;
        x.k0 = *(const u32x4*)(p + ko); x.q0 = *(const u32x4*)(p + qo);
        if (DKL == 16) { x.k1 = *(const u32x4*)(p + ko + 8); x.q1 = *(const u32x4*)(p + qo + 8); }
        if (MODE != 4) x.v = *(const unsigned*)(p + vo);
        if (MODE == 0) { const f32x3 g3 = *(const f32x3*)(gsrc + (size_t)tt * 32); x.g.x = g3.x; x.g.y = g3.y; x.g.z = g3.z; }
        if (MODE == 1 || MODE == 4) { const f32x2 g2 = *(const f32x2*)(gsrc + (size_t)tt * 32); x.g.x = g2.x; x.g.y = g2.y; }
        if (MODE == 2) { const float* ap = asrc + (size_t)tt * 512; x.a0 = *(const f32x4*)ap; x.a1 = *(const f32x4*)(ap + 4);
            if (DKL == 16) { x.a2 = *(const f32x4*)(ap + 8); x.a3 = *(const f32x4*)(ap + 12); } }
    };
    auto step = [&](const TokIn& x, int t) {
        float k[16], q[16]; unpack8(x.k0, k); unpack8(x.q0, q);
        if (DKL == 16) { unpack8(x.k1, k + 8); unpack8(x.q1, q + 8); }
        f32x2 v = {1.f, 1.f};
        if (MODE != 4) v = (f32x2){bflo(x.v), bfhi(x.v)};
        f32x2 o = {0.f, 0.f};
        if (MODE == 0) {
            const float a = x.g.x, be = x.g.y, qk = x.g.z;
            f32x2 pka[4], pqa[4];
#pragma unroll
            for (int i = 0; i < 4; ++i) { pka[i] = S[i] * k[i]; pqa[i] = S[i] * q[i]; }
#pragma unroll
            for (int i = 4; i < DKL; ++i) { pka[i & 3] += S[i] * k[i]; pqa[i & 3] += S[i] * q[i]; }
            f32x2 pk = (pka[0] + pka[1]) + (pka[2] + pka[3]), pq = (pqa[0] + pqa[1]) + (pqa[2] + pqa[3]);
            { float p0 = pk.x, p1 = pk.y, p2 = pq.x, p3 = pq.y;
              if (NL == 8) ar8x4(p0, p1, p2, p3); else if (NL == 16) ar16x4(p0, p1, p2, p3); else { p0 = arN<NL>(p0); p1 = arN<NL>(p1); p2 = arN<NL>(p2); p3 = arN<NL>(p3); }
              pk = (f32x2){p0, p1}; pq = (f32x2){p2, p3}; }
            float An = a * A;
            const f32x2 u = (v - pk * An) * be;
            o = pq * An + u * qk;
            if (An < 1e-12f) {
#pragma unroll
                for (int i = 0; i < DKL; ++i) S[i] = S[i] * An;
                An = 1.f; }
            const f32x2 uh = u * __builtin_amdgcn_rcpf(An);
#pragma unroll
            for (int i = 0; i < DKL; ++i) S[i] = S[i] + uh * k[i];
            A = An;
        } else if (MODE == 1 || MODE == 4) {
            const float ig = x.g.x, lf = x.g.y;
            const float mn = fmaxf(lf + m, ig); const float dec = __expf(lf + m - mn), isc = __expf(ig - mn) * 0.125f; m = mn;
            const f32x2 u = v * isc;
            f32x2 oa[4] = {o, o, o, o};
#pragma unroll
            for (int i = 0; i < DKL; ++i) { S[i] = S[i] * dec + u * k[i]; oa[i & 3] += S[i] * q[i]; }
            o = (oa[0] + oa[1]) + (oa[2] + oa[3]);
            o.x = arN<NL>(o.x); if (MODE == 1) o.y = arN<NL>(o.y);
        } else if (MODE == 2) {
            const float al[16] = {x.a0.x, x.a0.y, x.a0.z, x.a0.w, x.a1.x, x.a1.y, x.a1.z, x.a1.w, x.a2.x, x.a2.y, x.a2.z, x.a2.w, x.a3.x, x.a3.y, x.a3.z, x.a3.w};
            f32x2 oa[4] = {o, o, o, o};
#pragma unroll
            for (int i = 0; i < DKL; ++i) { S[i] = S[i] * al[i] + v * k[i]; oa[i & 3] += S[i] * q[i]; }
            o = (oa[0] + oa[1]) + (oa[2] + oa[3]);
            if (NL == 16) { float p0 = o.x, p1 = o.y; ar16x2(p0, p1); o = (f32x2){p0, p1}; } else { o.x = arN<NL>(o.x); o.y = arN<NL>(o.y); }
            o *= 0.08838834764831845f;
        } else {
            f32x2 oa[4] = {o, o, o, o};
#pragma unroll
            for (int i = 0; i < DKL; ++i) { S[i] = S[i] * gam + v * k[i]; oa[i & 3] += S[i] * q[i]; }
            o = (oa[0] + oa[1]) + (oa[2] + oa[3]);
            if (NL == 16) { float p0 = o.x, p1 = o.y; ar16x2(p0, p1); o = (f32x2){p0, p1}; } else { o.x = arN<NL>(o.x); o.y = arN<NL>(o.y); }
        }
        if (MODE == 4) { if (lane == 0) gsrc[(size_t)t * 32 + 2] = __builtin_amdgcn_rcpf(fmaxf(fabsf(o.x), __expf(-m))); }
        else if (r == 0) *(unsigned*)(yb + (size_t)t * 2048) = pk2(o.x, o.y);
    };
    TokIn X[DR];
#pragma unroll
    for (int d = 0; d < DR; ++d) load(X[d], d);
    for (int t0 = 0; t0 < TSEQ; t0 += DR) {
#pragma unroll
        for (int d = 0; d < DR; ++d) { const int t = t0 + d;
            if (t < TSEQ) step(X[d], t);
            load(X[d], t + DR); }
    }
    if (MODE == 4) {
        if (lane < NL) {
#pragma unroll
            for (int i = 0; i < DKL; ++i) P->out[OUT_PMN + (size_t)bh * 64 + r * DKL + i] = S[i].x; }
        if (lane == 0) P->out[OUT_PMM + bh] = m;
    } else {
        float* ps = P->out + (MODE == 0 ? OUT_PGDN : MODE == 1 ? OUT_PMC : MODE == 2 ? OUT_PGLA : OUT_PRET) + (size_t)bh * DK * DV;
#pragma unroll
        for (int i = 0; i < DKL; ++i) *(f32x2*)(ps + (size_t)(r * DKL + i) * DV + dv) = (MODE == 0) ? S[i] * A : S[i];
    }
}

__device__ __forceinline__ void gdn_sample_item(KP P, int idx, int lane) {
    const int si = idx >> 3, h = idx & 7, tok = NTP + si;
    const float* Sin = P->in[4] + (size_t)idx * 128 * 128; float* Sout = P->out + OUT_SGDN + (size_t)idx * 128 * 128;
    const bf16_t* ab = DOP(bf16_t, DO_ABUF) + (size_t)tok * 3072 + h * 128;
    const float* ga = WSP(float, WS_GA) + (size_t)tok * 32;
    const unsigned kpk = *(const unsigned*)(ab + 1024 + 2 * lane), qpk = *(const unsigned*)(ab + 2 * lane), vpk = *(const unsigned*)(ab + 2048 + 2 * lane);
    const float a = ga[h * 4], be = ga[h * 4 + 1], qk = ga[h * 4 + 2];
    f32x2 pk = {0.f, 0.f}, pq = {0.f, 0.f};
#pragma unroll 8
    for (int d2 = 0; d2 < 64; ++d2) { const unsigned ku = rdlu(kpk, d2), qu = rdlu(qpk, d2);
        const f32x2 s0 = *(const f32x2*)(Sin + (size_t)(2 * d2) * 128 + 2 * lane), s1 = *(const f32x2*)(Sin + (size_t)(2 * d2 + 1) * 128 + 2 * lane);
        pk += s0 * bflo(ku) + s1 * bfhi(ku); pq += s0 * bflo(qu) + s1 * bfhi(qu); }
    const f32x2 v = {bflo(vpk), bfhi(vpk)};
    const f32x2 u = (v - pk * a) * be; const f32x2 o = pq * a + u * qk;
#pragma unroll 8
    for (int d2 = 0; d2 < 64; ++d2) { const unsigned ku = rdlu(kpk, d2);
        const f32x2 s0 = *(const f32x2*)(Sin + (size_t)(2 * d2) * 128 + 2 * lane), s1 = *(const f32x2*)(Sin + (size_t)(2 * d2 + 1) * 128 + 2 * lane);
        *(f32x2*)(Sout + (size_t)(2 * d2) * 128 + 2 * lane) = s0 * a + u * bflo(ku);
        *(f32x2*)(Sout + (size_t)(2 * d2 + 1) * 128 + 2 * lane) = s1 * a + u * bfhi(ku); }
    *(unsigned*)(WSP(bf16_t, WS_Y) + (size_t)tok * 2048 + h * 128 + 2 * lane) = pk2(o.x, o.y);
}

__device__ __forceinline__ void mlstm_sample_item(KP P, int idx, int lane) {
    const int si = idx >> 3, h = idx & 7, tok = NTP + si;
    const float* Cin = P->in[6] + (size_t)idx * 64 * 128; float* Cout = P->out + OUT_SMC + (size_t)idx * 64 * 128;
    const bf16_t* pr = WSP(bf16_t, WS_PROJ) + (size_t)tok * PE_MAIN;
    float* gb = WSP(float, WS_GB) + (size_t)tok * 32;
    const float m0 = P->in[8][idx], ig = gb[h * 4], lf = gb[h * 4 + 1];
    const float mn = fmaxf(lf + m0, ig); const float dec = expf(lf + m0 - mn), isc = expf(ig - mn) * 0.125f;
    const unsigned kpk = *(const unsigned*)(pr + E_KB + h * 64 + 2 * (lane & 31)), qpk = *(const unsigned*)(pr + E_QB + h * 64 + 2 * (lane & 31));
    const unsigned vpk = *(const unsigned*)(pr + E_VB + h * 128 + 2 * lane);
    const f32x2 uv = (f32x2){bflo(vpk), bfhi(vpk)} * isc;
    f32x2 num = {0.f, 0.f};
#pragma unroll 8
    for (int d2 = 0; d2 < 32; ++d2) { const unsigned ku = rdlu(kpk, d2), qu = rdlu(qpk, d2);
        const f32x2 s0 = *(const f32x2*)(Cin + (size_t)(2 * d2) * 128 + 2 * lane), s1 = *(const f32x2*)(Cin + (size_t)(2 * d2 + 1) * 128 + 2 * lane);
        const f32x2 n0 = s0 * dec + uv * bflo(ku), n1 = s1 * dec + uv * bfhi(ku);
        *(f32x2*)(Cout + (size_t)(2 * d2) * 128 + 2 * lane) = n0; *(f32x2*)(Cout + (size_t)(2 * d2 + 1) * 128 + 2 * lane) = n1;
        num += n0 * bflo(qu) + n1 * bfhi(qu); }
    const float kl = bf1(pr[E_KB + h * 64 + lane]), ql = bf1(pr[E_QB + h * 64 + lane]);
    const float nl = dec * P->in[7][(size_t)idx * 64 + lane] + isc * kl;
    const float den = ar64(nl * ql);
    P->out[OUT_SMN + (size_t)idx * 64 + lane] = nl;
    if (lane == 0) { P->out[OUT_SMM + idx] = mn; gb[h * 4 + 2] = 1.f / fmaxf(fabsf(den), expf(-mn)); }
    *(unsigned*)(WSP(bf16_t, WS_Y) + (size_t)tok * 2048 + 1024 + h * 128 + 2 * lane) = pk2(num.x, num.y);
}

__device__ __forceinline__ void phase_rec_even(KP P, const Ctx& C) {
    const int lane = C.lane;
    { const int slot = C.bid * 4 + (C.wave & 3), nslot = C.nblk * 4;
        if (C.wave < 4) { for (int g = slot; g < 1024; g += nslot) rec_item<0, 8, 8>(P, g, lane); }
        else { for (int q = slot; q < 576; q += nslot) { if (q < 512) rec_item<1, 8, 8>(P, q, lane); else rec_item<4, 8, 8>(P, q - 512, lane); } } }
    unsigned* ctr = WSP(unsigned, WS_CTL);
    for (;;) {
        int idx = 0; if (lane == 0) idx = (int)atomicAdd(ctr, 1u);
        idx = __builtin_amdgcn_readfirstlane(idx);
        if (idx >= 2048) break;
        if (idx < 1024) gdn_sample_item(P, idx, lane); else mlstm_sample_item(P, idx - 1024, lane);
    }
}

__device__ __forceinline__ void phase_post_even(KP P, const Ctx& C) {
    bf16_t* Y = WSP(bf16_t, WS_Y); const bf16_t* proj = WSP(bf16_t, WS_PROJ); const float* GB = WSP(float, WS_GB); const int lane = C.lane;
    for (int tok = C.gw; tok < NTOK; tok += C.ngw) {
#pragma unroll
        for (int i = 0; i < 4; ++i) { const int ch0 = i * 512 + lane * 8; float o[8], z[8], y[8];
            unpack8(*(const u32x4*)(Y + (size_t)tok * 2048 + ch0), o); unpack8(*(const u32x4*)(proj + (size_t)tok * PE_MAIN + E_Z + ch0), z);
            if (i < 2) { float ss = 0.f;
#pragma unroll
                for (int e = 0; e < 8; ++e) ss += o[e] * o[e];
                ss = ar16(ss); const float rs = rsqrtf(ss * (1.f / 128.f) + EPS); const float* w = P->in[19] + (ch0 & 127);
#pragma unroll
                for (int e = 0; e < 8; ++e) y[e] = o[e] * rs * w[e] * siluf_(z[e]);
            } else { const int hh = (ch0 - 1024) >> 7; const float dn = GB[(size_t)tok * 32 + hh * 4 + 2]; float ss = 0.f; float op[8];
                unpack8(*(const u32x4*)(proj + (size_t)tok * PE_MAIN + E_OP + ch0 - 1024), op);
#pragma unroll
                for (int e = 0; e < 8; ++e) { o[e] *= dn; ss += o[e] * o[e]; }
                ss = ar16(ss); const float rs = rsqrtf(ss * (1.f / 128.f) + EPS); const float* w = P->in[21] + (ch0 & 127);
#pragma unroll
                for (int e = 0; e < 8; ++e) y[e] = sigmoidf_(op[e]) * o[e] * rs * w[e] * siluf_(z[e]);
            }
            *(u32x4*)(Y + (size_t)tok * 2048 + ch0) = pack8(y);
        }
    }
}

__device__ __forceinline__ void phase_prep_odd(KP P, const Ctx& C) {
    bf16_t* proj = WSP(bf16_t, WS_PROJ); const float* G = WSP(float, WS_GATES); float* AL = WSP(float, WS_ALPHA); const f32x2* rope = WSP(f32x2, WS_ROPE);
    const float* w2 = P->in[24]; const float* b2 = P->in[25]; const int lane = C.lane;
    for (int tok = C.gw; tok < NTOK; tok += C.ngw) {
        const bool isP = tok < NTP; const int t = isP ? (tok & 2047) : 2048;
        float g[16];
#pragma unroll
        for (int r4 = 0; r4 < 4; ++r4) { const f32x4 gv = *(const f32x4*)(G + (size_t)tok * 16 + r4 * 4); g[r4 * 4] = gv.x; g[r4 * 4 + 1] = gv.y; g[r4 * 4 + 2] = gv.z; g[r4 * 4 + 3] = gv.w; }
        float x[8];
#pragma unroll
        for (int e = 0; e < 8; ++e) x[e] = b2[lane * 8 + e];
#pragma unroll
        for (int r = 0; r < 16; ++r) { const f32x4 wa = *(const f32x4*)(w2 + r * 512 + lane * 8), wb = *(const f32x4*)(w2 + r * 512 + lane * 8 + 4);
            x[0] += g[r] * wa.x; x[1] += g[r] * wa.y; x[2] += g[r] * wa.z; x[3] += g[r] * wa.w; x[4] += g[r] * wb.x; x[5] += g[r] * wb.y; x[6] += g[r] * wb.z; x[7] += g[r] * wb.w; }
        f32x4 a0, a1;
        a0.x = gla_alpha_(x[0]); a0.y = gla_alpha_(x[1]); a0.z = gla_alpha_(x[2]); a0.w = gla_alpha_(x[3]);
        a1.x = gla_alpha_(x[4]); a1.y = gla_alpha_(x[5]); a1.z = gla_alpha_(x[6]); a1.w = gla_alpha_(x[7]);
        *(f32x4*)(AL + (size_t)tok * 512 + lane * 8) = a0; *(f32x4*)(AL + (size_t)tok * 512 + lane * 8 + 4) = a1;
        const f32x2 cs = rope[t * 64 + lane];
        bf16_t* pr = proj + (size_t)tok * PO_MAIN;
#pragma unroll
        for (int h = 0; h < 4; ++h) {
            { bf16_t* q = pr + O_QD + h * 128; const float x1 = bf1(q[lane]), x2 = bf1(q[64 + lane]);
              const unsigned o = pk2(x1 * cs.x - x2 * cs.y, x1 * cs.y + x2 * cs.x); q[lane] = (bf16_t)(o & 0xffffu); q[64 + lane] = (bf16_t)(o >> 16); }
            { bf16_t* k = pr + O_KD + h * 128; const float x1 = bf1(k[lane]) * 0.08838834764831845f, x2 = bf1(k[64 + lane]) * 0.08838834764831845f;
              const unsigned o = pk2(x1 * cs.x - x2 * cs.y, x1 * cs.y + x2 * cs.x); k[lane] = (bf16_t)(o & 0xffffu); k[64 + lane] = (bf16_t)(o >> 16); }
        }
    }
}

template <bool GLA> __device__ __forceinline__ void odd_sample_item(KP P, int idx, int lane) {
    const int si = idx >> 2, h = idx & 3, tok = NTP + si;
    const float* Sin = P->in[GLA ? 9 : 10] + (size_t)idx * 128 * 256; float* Sout = P->out + (GLA ? OUT_SGLA : OUT_SRET) + (size_t)idx * 128 * 256;
    const bf16_t* pr = WSP(bf16_t, WS_PROJ) + (size_t)tok * PO_MAIN;
    const unsigned kpk = *(const unsigned*)(pr + (GLA ? O_KC : O_KD) + h * 128 + 2 * lane), qpk = *(const unsigned*)(pr + (GLA ? O_QC : O_QD) + h * 128 + 2 * lane);
    const u32x2 vpk = *(const u32x2*)(pr + (GLA ? O_VC : O_VD) + h * 256 + 4 * lane);
    const f32x4 v = {bflo(vpk.x), bfhi(vpk.x), bflo(vpk.y), bfhi(vpk.y)};
    const float gam = 1.f - exp2f(-5.f - (float)h);
    f32x2 alp = {gam, gam};
    if (GLA) alp = *(const f32x2*)(WSP(float, WS_ALPHA) + (size_t)tok * 512 + h * 128 + 2 * lane);
    f32x4 o = {0.f, 0.f, 0.f, 0.f};
#pragma unroll 8
    for (int d2 = 0; d2 < 64; ++d2) { const unsigned ku = rdlu(kpk, d2), qu = rdlu(qpk, d2); const float a0 = rdl(alp.x, d2), a1 = rdl(alp.y, d2);
        const f32x4 s0 = *(const f32x4*)(Sin + (size_t)(2 * d2) * 256 + 4 * lane), s1 = *(const f32x4*)(Sin + (size_t)(2 * d2 + 1) * 256 + 4 * lane);
        const f32x4 n0 = s0 * a0 + v * bflo(ku), n1 = s1 * a1 + v * bfhi(ku);
        *(f32x4*)(Sout + (size_t)(2 * d2) * 256 + 4 * lane) = n0; *(f32x4*)(Sout + (size_t)(2 * d2 + 1) * 256 + 4 * lane) = n1;
        o += n0 * bflo(qu) + n1 * bfhi(qu); }
    if (GLA) o *= 0.08838834764831845f;
    u32x2 op; op.x = pk2(o.x, o.y); op.y = pk2(o.z, o.w);
    *(u32x2*)(WSP(bf16_t, WS_Y) + (size_t)tok * 2048 + (GLA ? 0 : 1024) + h * 256 + 4 * lane) = op;
}

__device__ __forceinline__ void phase_rec_odd(KP P, const Ctx& C) {
    const int lane = C.lane;
    { const int slot = C.bid * 4 + (C.wave & 3), nslot = C.nblk * 4;
        if (C.wave < 4) { for (int g = slot; g < 1024; g += nslot) rec_item<2, 8, 8>(P, g, lane); }
        else { for (int g = slot; g < 1024; g += nslot) rec_item<3, 8, 8>(P, g, lane); } }
    unsigned* ctr = WSP(unsigned, WS_CTL) + 64;
    for (;;) {
        int idx = 0; if (lane == 0) idx = (int)atomicAdd(ctr, 1u);
        idx = __builtin_amdgcn_readfirstlane(idx);
        if (idx >= 1024) break;
        if (idx < 512) odd_sample_item<true>(P, idx, lane); else odd_sample_item<false>(P, idx - 512, lane);
    }
}

__device__ __forceinline__ void phase_post_odd(KP P, const Ctx& C) {
    bf16_t* Y = WSP(bf16_t, WS_Y); const bf16_t* proj = WSP(bf16_t, WS_PROJ); const int lane = C.lane;
    for (int tok = C.gw; tok < NTOK; tok += C.ngw) {
#pragma unroll
        for (int i = 0; i < 4; ++i) { const int ch0 = i * 512 + lane * 8; float o[8], z[8], y[8];
            unpack8(*(const u32x4*)(Y + (size_t)tok * 2048 + ch0), o); unpack8(*(const u32x4*)(proj + (size_t)tok * PO_MAIN + O_Z + ch0), z);
            float ss = 0.f;
#pragma unroll
            for (int e = 0; e < 8; ++e) ss += o[e] * o[e];
            ss = ar32(ss); const float rs = rsqrtf(ss * (1.f / 256.f) + EPS); const float* w = P->in[i < 2 ? 26 : 27] + (ch0 & 255);
#pragma unroll
            for (int e = 0; e < 8; ++e) y[e] = o[e] * rs * w[e] * siluf_(z[e]);
            *(u32x4*)(Y + (size_t)tok * 2048 + ch0) = pack8(y);
        }
    }
}

__device__ __forceinline__ void phase_final(KP P, const Ctx& C) {
    const float* fw = P->in[28];
    for (int tok = C.gw; tok < NTOK; tok += C.ngw) {
        float* xr = P->out + (size_t)tok * DM; f32x4 v[4]; float ss = 0.f;
#pragma unroll
        for (int j = 0; j < 4; ++j) { v[j] = ((const f32x4*)xr)[C.lane + 64 * j]; ss += v[j].x * v[j].x + v[j].y * v[j].y + v[j].z * v[j].z + v[j].w * v[j].w; }
        ss = ar64(ss); const float rstd = rsqrtf(ss * (1.f / 1024.f) + EPS);
#pragma unroll
        for (int j = 0; j < 4; ++j) { const int idx = (C.lane + 64 * j) * 4; ((f32x4*)xr)[C.lane + 64 * j] = v[j] * rstd * *(const f32x4*)(fw + idx); }
    }
}

__device__ __forceinline__ void sample_outproj(KP P, const Ctx& C, int layer) {
    const bf16_t* Y = WSP(bf16_t, WS_Y) + (size_t)NTP * 2048; const bf16_t* W = WSP(bf16_t, layer == 0 ? WS_WOUT0 : WS_WOUT1);
    const float* mod = WSP(float, WS_MOD); LAS float* red = (LAS float*)C.lds;
    const int lane = C.lane, w = C.wave;
    for (int task = C.bid; task < 256; task += C.nblk) {
        const int r0 = (task >> 5) * 16, c0 = (task & 31) * 32;
        f32x4 acc0 = {0.f, 0.f, 0.f, 0.f}, acc1 = acc0;
        const bf16_t* ap = Y + (size_t)(r0 + (lane & 15)) * 2048 + w * 256 + (lane >> 4) * 8;
        const bf16_t* bp0 = W + (size_t)(c0 + (lane & 15)) * 2048 + w * 256 + (lane >> 4) * 8; const bf16_t* bp1 = bp0 + (size_t)16 * 2048;
#pragma unroll
        for (int ks = 0; ks < 8; ++ks) { const bf16x8 a = *(const bf16x8*)(ap + ks * 32), b0 = *(const bf16x8*)(bp0 + ks * 32), b1 = *(const bf16x8*)(bp1 + ks * 32);
            acc0 = __builtin_amdgcn_mfma_f32_16x16x32_bf16(a, b0, acc0, 0, 0, 0); acc1 = __builtin_amdgcn_mfma_f32_16x16x32_bf16(a, b1, acc1, 0, 0, 0); }
        __syncthreads();
        *(LAS f32x4*)(red + ((w * 2 + 0) * 64 + lane) * 4) = acc0; *(LAS f32x4*)(red + ((w * 2 + 1) * 64 + lane) * 4) = acc1;
        __syncthreads();
        { const int e = C.tid, tile = e >> 8, idx = e & 255, ln = idx >> 2, j = idx & 3; float sum = 0.f;
#pragma unroll
          for (int ww = 0; ww < 8; ++ww) sum += red[((ww * 2 + tile) * 64 + ln) * 4 + j];
          const int row = r0 + (ln >> 4) * 4 + j, col = c0 + tile * 16 + (ln & 15);
          const float xin = layer == 0 ? P->in[1][(size_t)row * DM + col] : P->out[(size_t)(NTP + row) * DM + col];
          const float gt = mod[(size_t)(8 + row) * 6144 + layer * 3072 + 2048 + col];
          P->out[(size_t)(NTP + row) * DM + col] = xin + gt * sum; }
    }
    __syncthreads();
}

#define XB_XCNT(j)  (256  + 64 * (j))
#define XB_XSUB(j)  (1280 + 64 * (j))
#define XB_XGEN(j)  (2304 + 64 * (j))
#define XB_TOP      3328
#define XB_TOPGEN   3392
__device__ __forceinline__ unsigned xb_ld(unsigned* p) { return __hip_atomic_load(p, __ATOMIC_RELAXED, __HIP_MEMORY_SCOPE_AGENT); }
__device__ __forceinline__ unsigned xb_add(unsigned* p, unsigned v) { return __hip_atomic_fetch_add(p, v, __ATOMIC_RELAXED, __HIP_MEMORY_SCOPE_AGENT); }
__device__ __forceinline__ unsigned xb_xcc_id() { return (unsigned)__builtin_amdgcn_s_getreg((3 << 11) | 20) & 0xFu; }
__device__ __forceinline__ void xcd_bar(unsigned* bar, volatile unsigned* st) {
    asm volatile("s_waitcnt vmcnt(0)" ::: "memory");
    __syncthreads();
    if (threadIdx.x == 0) {
        __builtin_amdgcn_s_waitcnt(0);
        const unsigned x = xb_xcc_id();
        unsigned nloc = st[0], nx = st[1];
        if (nloc == 0u) {
            unsigned cnt, mine, sum;
            for (;;) { cnt = 0u; mine = 0u; sum = 0u;
#pragma unroll
                for (unsigned j = 0; j < 16; ++j) { const unsigned c = xb_ld(&bar[XB_XCNT(j)]); sum += c; cnt += (c > 0u) ? 1u : 0u; mine = (j == x) ? c : mine; }
                if (sum == gridDim.x) break;
                __builtin_amdgcn_s_sleep(1); }
            nloc = mine > 0u ? mine : 1u; nx = cnt > 0u ? cnt : 1u; st[0] = nloc; st[1] = nx;
        }
        const unsigned old = xb_add(&bar[XB_XSUB(x)], 1u);
        const unsigned gen = old / nloc;
        if (old + 1u == (gen + 1u) * nloc) {
            __builtin_amdgcn_fence(__ATOMIC_RELEASE, "agent");
            asm volatile("s_waitcnt vmcnt(0)" ::: "memory");
            const unsigned og = xb_add(&bar[XB_TOP], 1u);
            const unsigned tg = og / nx;
            if (og + 1u == (tg + 1u) * nx) xb_add(&bar[XB_TOPGEN], 1u);
            else { while (xb_ld(&bar[XB_TOPGEN]) == tg) __builtin_amdgcn_s_sleep(1); }
            __builtin_amdgcn_fence(__ATOMIC_ACQUIRE, "agent");
            xb_add(&bar[XB_XGEN(x)], 1u);
            asm volatile("s_waitcnt vmcnt(0)" ::: "memory");
        } else {
            while (xb_ld(&bar[XB_XGEN(x)]) == gen) __builtin_amdgcn_s_sleep(1);
            __builtin_amdgcn_fence(__ATOMIC_ACQUIRE, "agent");
            asm volatile("s_waitcnt vmcnt(0)" ::: "memory");
        }
    }
    __syncthreads();
}

#ifndef PH_MASK
#define PH_MASK 0x7fff
#endif
#define PH_ON(n) (((PH_MASK) >> (n)) & 1)
#ifndef PH_REP
#define PH_REP 0
#endif
#define PH_RP(n) (((PH_REP) >> (n)) & 1)
constexpr int NPHASE = 15;
__global__ void __launch_bounds__(512, 2) fwd_megakernel(Params PV) {
    extern __shared__ __attribute__((aligned(16))) unsigned char shm[];
    __shared__ __attribute__((aligned(16))) unsigned xb_st[4];
    Ctx C; C.lds = (LAS unsigned char*)shm;
    if (threadIdx.x == 0) { xb_st[0] = 0u; xb_st[1] = 0u; if (PV.ph_hi - PV.ph_lo > 1) (void)xb_add(((unsigned*)PV.ws) + XB_XCNT(xb_xcc_id()), 1u); }
    __syncthreads();
    for (int ph = PV.ph_lo; ph < PV.ph_hi; ++ph) {
        KP P = (KP)__builtin_amdgcn_kernarg_segment_ptr(); asm volatile("" : "+s"(P));
        { int tid = threadIdx.x; asm volatile("" : "+v"(tid)); int bid = blockIdx.x; asm volatile("" : "+s"(bid)); int nblk = gridDim.x; asm volatile("" : "+s"(nblk));
          C.tid = tid; C.bid = bid; C.nblk = nblk; C.lane = tid & 63; C.wave = __builtin_amdgcn_readfirstlane(tid >> 6); C.gw = bid * 8 + C.wave; C.ngw = nblk * 8; }
        const bool is_gemm = (ph == 1 || ph == 3 || ph == 7 || ph == 9 || ph == 13);
        if (is_gemm && PH_ON(1)) {
            pg8::Gemm g; pg8::Epi E; E.kind = 0; E.mod = WSP(float, WS_MOD); E.ada_b = P->in[12]; E.P = WSP(bf16_t, WS_PROJ); E.ldp = PE_MAIN; E.ntile_main = 32; E.G = WSP(float, WS_GATES); E.ng = 32;
            E.xp = P->in[0]; E.xs = P->in[1]; E.xo = P->out; E.gate = WSP(float, WS_MOD); E.layer = 0;
            if (ph == 1) { g.A = WSP(bf16_t, WS_CBF); g.Bt = WSP(bf16_t, WS_ADAT); g.M = 256; g.N = 6144; g.K = 1024; E.kind = 0; }
            else if (ph == 3) { g.A = DOP(bf16_t, DO_HBUF); g.Bt = WSP(bf16_t, WS_WIN0); g.M = MPAD; g.N = PE_PAD; g.K = 1024; E.kind = 1; }
            else if (ph == 7) { g.A = WSP(bf16_t, WS_Y); g.Bt = WSP(bf16_t, WS_WOUT0); g.M = NTP; g.N = 1024; g.K = 2048; E.kind = 2; E.layer = 0; }
            else if (ph == 9) { g.A = DOP(bf16_t, DO_HBUF); g.Bt = WSP(bf16_t, WS_WIN1); g.M = MPAD; g.N = PO_PAD; g.K = 1024; E.kind = 1; E.ldp = PO_MAIN; E.ntile_main = 24; E.ng = 16; }
            else { g.A = WSP(bf16_t, WS_Y); g.Bt = WSP(bf16_t, WS_WOUT1); g.M = NTP; g.N = 1024; g.K = 2048; E.kind = 2; E.layer = 1; }
            pg8::StaticOrder S; S.init(g.M, g.N, C.nblk, C.bid);
            for (int rep = 0; rep < 1 + PH_RP(ph); ++rep) { asm volatile("" : "+s"(rep)); pg8::gemm_phase(C.lds, g, S, E, C.tid); }
            if (E.kind == 2) sample_outproj(P, C, E.layer);
            if (ph == 1) { if (C.nblk > 24) { if (C.bid >= 24) prep_weights(P, C, (C.bid - 24) * 8 + C.wave, (C.nblk - 24) * 8); } else prep_weights(P, C, C.gw, C.ngw); }
        } else {
            switch (ph) {
                case 0: if (PH_ON(0)) phase_prep0(P, C); if (PH_RP(0)) { asm volatile("" : "+s"(P)); phase_prep0(P, C); } break;
                case 2: if (PH_ON(2)) phase_hnorm(P, C, 0); if (PH_RP(2)) { asm volatile("" : "+s"(P)); phase_hnorm(P, C, 0); } break;
                case 4: if (PH_ON(4)) phase_prep_even(P, C); if (PH_RP(4)) { asm volatile("" : "+s"(P)); phase_prep_even(P, C); } break;
                case 5: if (PH_ON(5)) phase_rec_even(P, C); if (PH_RP(5)) { asm volatile("" : "+s"(P)); phase_rec_even(P, C); } break;
                case 6: if (PH_ON(6)) phase_post_even(P, C); break;
                case 8: if (PH_ON(8)) phase_hnorm(P, C, 1); if (PH_RP(8)) { asm volatile("" : "+s"(P)); phase_hnorm(P, C, 1); } break;
                case 10: if (PH_ON(10)) phase_prep_odd(P, C); break;
                case 11: if (PH_ON(11)) phase_rec_odd(P, C); if (PH_RP(11)) { asm volatile("" : "+s"(P)); phase_rec_odd(P, C); } break;
                case 12: if (PH_ON(12)) phase_post_odd(P, C); break;
                case 14: if (PH_ON(14)) phase_final(P, C); break;
                default: break;
            }
        }
        if (ph + 1 < PV.ph_hi) {
            if (PV.ph_lo > 0 && ph == PV.ph_lo) cg::this_grid().sync();
            else xcd_bar(WSP(unsigned, WS_CTL), xb_st);
        }
    }
}

extern "C" void kernel_launch(void* const* d_in, const int* in_sizes, int n_in, void* d_out, int out_size, void* d_ws, size_t ws_size, hipStream_t stream) {
    constexpr size_t kDynLds = 131072;
    static int grid_blocks = 0;
    if (!grid_blocks) {
        if (n_in != 29 || ws_size < WS_END) { fprintf(stderr, "kernel_launch: unexpected n_in %d or ws_size %zu (need %zu)\n", n_in, ws_size, (size_t)WS_END); }
        int dev = 0, cus = 0, per_cu = 0;
        hipGetDevice(&dev);
        hipDeviceGetAttribute(&cus, hipDeviceAttributeMultiprocessorCount, dev);
        hipFuncSetAttribute((const void*)fwd_megakernel, hipFuncAttributeMaxDynamicSharedMemorySize, (int)kDynLds);
        hipOccupancyMaxActiveBlocksPerMultiprocessor(&per_cu, (const void*)fwd_megakernel, 512, kDynLds);
        if (per_cu < 1) { fprintf(stderr, "kernel_launch: occupancy query says %d blocks/CU\n", per_cu); per_cu = 1; }
        if (per_cu > 1) per_cu = 1;
        grid_blocks = cus * per_cu;
        (void)hipGetLastError();
    }
    hipMemsetAsync((char*)d_ws + WS_CTL, 0, 16384, stream);
    Params p{};
    for (int i = 0; i < 29; ++i) p.in[i] = (const float*)d_in[i];
    p.out = (float*)d_out; p.ws = (unsigned char*)d_ws;
#if MK_SPLIT
    for (int ph = 0; ph < NPHASE; ++ph) { p.ph_lo = ph; p.ph_hi = ph + 1;
        hipLaunchKernelGGL(fwd_megakernel, dim3(grid_blocks), dim3(512), kDynLds, stream, p); }
#else
    p.ph_lo = 0; p.ph_hi = NPHASE;
    void* args[] = {&p};
    hipError_t e = hipLaunchCooperativeKernel((const void*)fwd_megakernel, dim3(grid_blocks), dim3(512), args, kDynLds, stream);
    if (e != hipSuccess) fprintf(stderr, "cooperative launch failed: %s (grid %d)\n", hipGetErrorString(e), grid_blocks);
#endif
}
```

```cpp
#include <hip/hip_runtime.h>
#include <hip/hip_cooperative_groups.h>
#include <cstdio>
#include <cstdint>
namespace cg = cooperative_groups;

#ifndef MK_SPLIT
#define MK_SPLIT 0
#endif

#define LAS __attribute__((address_space(3)))
typedef unsigned short bf16_t;
typedef short bf16x8 __attribute__((ext_vector_type(8)));
typedef float f32x4 __attribute__((ext_vector_type(4)));
typedef float f32x2 __attribute__((ext_vector_type(2)));
typedef float f32x3 __attribute__((ext_vector_type(3)));
typedef unsigned u32x4 __attribute__((ext_vector_type(4)));
typedef unsigned u32x2 __attribute__((ext_vector_type(2)));

constexpr int DM = 1024, NTP = 16384, NTS = 128, NTOK = NTP + NTS, MPAD = 16640, TSEQ = 2048;
constexpr int NSEQ = 136;
constexpr float EPS = 1e-6f;
constexpr int PE_MAIN = 8192, PE_PAD = 8448, PO_MAIN = 6144, PO_PAD = 6400;
constexpr int E_QA = 0, E_KA = 1024, E_VA = 2048, E_QB = 3072, E_KB = 3584, E_VB = 4096, E_OP = 5120, E_Z = 6144;
constexpr int O_QC = 0, O_KC = 512, O_VC = 1024, O_QD = 2048, O_KD = 2560, O_VD = 3072, O_Z = 4096;
constexpr size_t OUT_Y = 0, OUT_PGDN = 16908288, OUT_PCONV = 17956864, OUT_PMC = 18030592, OUT_PMN = 18554880, OUT_PMM = 18558976,
                 OUT_PGLA = 18559040, OUT_PRET = 19607616, OUT_SGDN = 20656192, OUT_SCONV = 37433408, OUT_SMC = 38613056,
                 OUT_SMN = 47001664, OUT_SMM = 47067200, OUT_SGLA = 47068224, OUT_SRET = 63845440;
constexpr size_t WS_CTL = 0, WS_WIN0 = 16384, WS_WOUT0 = WS_WIN0 + (size_t)PE_PAD * 1024 * 2, WS_WIN1 = WS_WOUT0 + (size_t)1024 * 2048 * 2,
                 WS_WOUT1 = WS_WIN1 + (size_t)PO_PAD * 1024 * 2, WS_ADAT = WS_WOUT1 + (size_t)1024 * 2048 * 2, WS_CBF = WS_ADAT + (size_t)6144 * 1024 * 2,
                 WS_MOD = WS_CBF + (size_t)256 * 1024 * 2, WS_ROPE = WS_MOD + (size_t)NSEQ * 6144 * 4, WS_GATES = WS_ROPE + 1049600,
                 WS_GA = WS_GATES + (size_t)NTOK * 32 * 4, WS_GB = WS_GA + (size_t)NTOK * 32 * 4, WS_PROJ = WS_GB + (size_t)NTOK * 32 * 4,
                 WS_Y = WS_PROJ + (size_t)NTOK * PE_MAIN * 2, WS_END = WS_Y + (size_t)MPAD * 2048 * 2;
constexpr size_t WS_ALPHA = WS_PROJ + (size_t)NTOK * PO_MAIN * 2;
constexpr size_t DO_ABUF = OUT_SGLA * 4;
constexpr size_t DO_HBUF = OUT_SRET * 4 + (size_t)67108864 - (size_t)MPAD * 1024 * 2;

struct Params {
    const float* in[29];
    float* out;
    unsigned char* ws;
    int ph_lo, ph_hi;
};

__device__ __forceinline__ float bflo(unsigned u) { return __uint_as_float(u << 16); }
__device__ __forceinline__ float bfhi(unsigned u) { return __uint_as_float(u & 0xffff0000u); }
__device__ __forceinline__ float bf1(bf16_t b) { return __uint_as_float(((unsigned)b) << 16); }
__device__ __forceinline__ unsigned pk2(float lo, float hi) { unsigned r; asm("v_cvt_pk_bf16_f32 %0, %1, %2" : "=v"(r) : "v"(lo), "v"(hi)); return r; }
__device__ __forceinline__ void unpack8(u32x4 p, float* f) {
    f[0] = bflo(p.x); f[1] = bfhi(p.x); f[2] = bflo(p.y); f[3] = bfhi(p.y); f[4] = bflo(p.z); f[5] = bfhi(p.z); f[6] = bflo(p.w); f[7] = bfhi(p.w);
}
__device__ __forceinline__ u32x4 pack8(const float* f) { u32x4 o; o.x = pk2(f[0], f[1]); o.y = pk2(f[2], f[3]); o.z = pk2(f[4], f[5]); o.w = pk2(f[6], f[7]); return o; }
template <int CTRL> __device__ __forceinline__ float dppf(float x) { return __int_as_float(__builtin_amdgcn_update_dpp(0, __float_as_int(x), CTRL, 0xf, 0xf, true)); }
__device__ __forceinline__ float ar4(float x) { x += dppf<0xB1>(x); x += dppf<0x4E>(x); return x; }
__device__ __forceinline__ float ar8(float x) { x = ar4(x); x += dppf<0x141>(x); return x; }
__device__ __forceinline__ void ar8x4(float& a, float& b, float& c, float& d) {
    asm volatile(
        "s_nop 1\n\t"
        "v_add_f32_dpp %0, %0, %0 quad_perm:[1,0,3,2] row_mask:0xf bank_mask:0xf bound_ctrl:1\n\t"
        "v_add_f32_dpp %1, %1, %1 quad_perm:[1,0,3,2] row_mask:0xf bank_mask:0xf bound_ctrl:1\n\t"
        "v_add_f32_dpp %2, %2, %2 quad_perm:[1,0,3,2] row_mask:0xf bank_mask:0xf bound_ctrl:1\n\t"
        "v_add_f32_dpp %3, %3, %3 quad_perm:[1,0,3,2] row_mask:0xf bank_mask:0xf bound_ctrl:1\n\t"
        "v_add_f32_dpp %0, %0, %0 quad_perm:[2,3,0,1] row_mask:0xf bank_mask:0xf bound_ctrl:1\n\t"
        "v_add_f32_dpp %1, %1, %1 quad_perm:[2,3,0,1] row_mask:0xf bank_mask:0xf bound_ctrl:1\n\t"
        "v_add_f32_dpp %2, %2, %2 quad_perm:[2,3,0,1] row_mask:0xf bank_mask:0xf bound_ctrl:1\n\t"
        "v_add_f32_dpp %3, %3, %3 quad_perm:[2,3,0,1] row_mask:0xf bank_mask:0xf bound_ctrl:1\n\t"
        "v_add_f32_dpp %0, %0, %0 row_half_mirror row_mask:0xf bank_mask:0xf bound_ctrl:1\n\t"
        "v_add_f32_dpp %1, %1, %1 row_half_mirror row_mask:0xf bank_mask:0xf bound_ctrl:1\n\t"
        "v_add_f32_dpp %2, %2, %2 row_half_mirror row_mask:0xf bank_mask:0xf bound_ctrl:1\n\t"
        "v_add_f32_dpp %3, %3, %3 row_half_mirror row_mask:0xf bank_mask:0xf bound_ctrl:1\n\t"
        : "+v"(a), "+v"(b), "+v"(c), "+v"(d));
}
__device__ __forceinline__ void ar16x4(float& a, float& b, float& c, float& d) {
    asm volatile(
        "s_nop 1\n\t"
        "v_add_f32_dpp %0, %0, %0 quad_perm:[1,0,3,2] row_mask:0xf bank_mask:0xf bound_ctrl:1\n\t"
        "v_add_f32_dpp %1, %1, %1 quad_perm:[1,0,3,2] row_mask:0xf bank_mask:0xf bound_ctrl:1\n\t"
        "v_add_f32_dpp %2, %2, %2 quad_perm:[1,0,3,2] row_mask:0xf bank_mask:0xf bound_ctrl:1\n\t"
        "v_add_f32_dpp %3, %3, %3 quad_perm:[1,0,3,2] row_mask:0xf bank_mask:0xf bound_ctrl:1\n\t"
        "v_add_f32_dpp %0, %0, %0 quad_perm:[2,3,0,1] row_mask:0xf bank_mask:0xf bound_ctrl:1\n\t"
        "v_add_f32_dpp %1, %1, %1 quad_perm:[2,3,0,1] row_mask:0xf bank_mask:0xf bound_ctrl:1\n\t"
        "v_add_f32_dpp %2, %2, %2 quad_perm:[2,3,0,1] row_mask:0xf bank_mask:0xf bound_ctrl:1\n\t"
        "v_add_f32_dpp %3, %3, %3 quad_perm:[2,3,0,1] row_mask:0xf bank_mask:0xf bound_ctrl:1\n\t"
        "v_add_f32_dpp %0, %0, %0 row_half_mirror row_mask:0xf bank_mask:0xf bound_ctrl:1\n\t"
        "v_add_f32_dpp %1, %1, %1 row_half_mirror row_mask:0xf bank_mask:0xf bound_ctrl:1\n\t"
        "v_add_f32_dpp %2, %2, %2 row_half_mirror row_mask:0xf bank_mask:0xf bound_ctrl:1\n\t"
        "v_add_f32_dpp %3, %3, %3 row_half_mirror row_mask:0xf bank_mask:0xf bound_ctrl:1\n\t"
        "v_add_f32_dpp %0, %0, %0 row_mirror row_mask:0xf bank_mask:0xf bound_ctrl:1\n\t"
        "v_add_f32_dpp %1, %1, %1 row_mirror row_mask:0xf bank_mask:0xf bound_ctrl:1\n\t"
        "v_add_f32_dpp %2, %2, %2 row_mirror row_mask:0xf bank_mask:0xf bound_ctrl:1\n\t"
        "v_add_f32_dpp %3, %3, %3 row_mirror row_mask:0xf bank_mask:0xf bound_ctrl:1\n\t"
        : "+v"(a), "+v"(b), "+v"(c), "+v"(d));
}
__device__ __forceinline__ void ar16x2(float& a, float& b) {
    asm volatile(
        "s_nop 1\n\t"
        "v_add_f32_dpp %0, %0, %0 quad_perm:[1,0,3,2] row_mask:0xf bank_mask:0xf bound_ctrl:1\n\t"
        "v_add_f32_dpp %1, %1, %1 quad_perm:[1,0,3,2] row_mask:0xf bank_mask:0xf bound_ctrl:1\n\t"
        "s_nop 0\n\t"
        "v_add_f32_dpp %0, %0, %0 quad_perm:[2,3,0,1] row_mask:0xf bank_mask:0xf bound_ctrl:1\n\t"
        "v_add_f32_dpp %1, %1, %1 quad_perm:[2,3,0,1] row_mask:0xf bank_mask:0xf bound_ctrl:1\n\t"
        "s_nop 0\n\t"
        "v_add_f32_dpp %0, %0, %0 row_half_mirror row_mask:0xf bank_mask:0xf bound_ctrl:1\n\t"
        "v_add_f32_dpp %1, %1, %1 row_half_mirror row_mask:0xf bank_mask:0xf bound_ctrl:1\n\t"
        "s_nop 0\n\t"
        "v_add_f32_dpp %0, %0, %0 row_mirror row_mask:0xf bank_mask:0xf bound_ctrl:1\n\t"
        "v_add_f32_dpp %1, %1, %1 row_mirror row_mask:0xf bank_mask:0xf bound_ctrl:1\n\t"
        : "+v"(a), "+v"(b));
}
__device__ __forceinline__ float ar16(float x) { x = ar8(x); x += dppf<0x140>(x); return x; }
__device__ __forceinline__ float ar32(float x) { x = ar16(x); x += __shfl_xor(x, 16); return x; }
__device__ __forceinline__ float ar64(float x) { x = ar32(x); x += __shfl_xor(x, 32); return x; }
__device__ __forceinline__ float sigmoidf_(float x) { return __builtin_amdgcn_rcpf(1.f + __expf(-x)); }
__device__ __forceinline__ float siluf_(float x) { return x * __builtin_amdgcn_rcpf(1.f + __expf(-x)); }
__device__ __forceinline__ float gla_alpha_(float x) { const float t = __expf(-x); const float sp = x < -15.f ? -x : __logf(1.f + t); return __expf(-sp * 0.0625f); }
__device__ __forceinline__ float softplusf_(float x) { return x > 20.f ? x : log1pf(expf(x)); }
__device__ __forceinline__ float rdl(float v, int l) { return __int_as_float(__builtin_amdgcn_readlane(__float_as_int(v), l)); }
__device__ __forceinline__ unsigned rdlu(unsigned v, int l) { return (unsigned)__builtin_amdgcn_readlane((int)v, l); }

__device__ __forceinline__ int map_even(int c) { if (c < 3072) return c; if (c < 5120) return c + 16; if (c < 8192) return c + 32; if (c < 8208) return c - 8192 + 3072; if (c < 8224) return c - 8208 + 5136; return -1; }
__device__ __forceinline__ int map_odd(int c) { if (c < 2048) return c; if (c < 6144) return c + 16; if (c < 6160) return c - 6144 + 2048; return -1; }

namespace pg8 {
constexpr int BM = 256, BK = 64, HALF = 128, HTB = HALF * BK * 2, STAGE_BYTES = 8 * HTB, NXCD = 8, WGM = 8;
__device__ __forceinline__ int lds_byte(int r, int c) { const int st = (r >> 4) * 2 + (c >> 5), rr = r & 15, cc = c & 31, ob = rr * 64 + cc * 2; return st * 1024 + (ob ^ (((ob >> 9) & 1) << 5)); }
__device__ __forceinline__ void stage_rc(int b, int& R, int& C) { const int st = b / 1024, sb = b % 1024, swz = sb ^ (((sb >> 9) & 1) << 5); R = (st >> 1) * 16 + swz / 64; C = (st & 1) * 32 + (swz % 64) / 2; }
struct Unit { int pm, pn; };
struct Gemm { const bf16_t* A; const bf16_t* Bt; int M, N, K; };
struct StaticOrder {
    int nM, nN, nwg, G, c;
    __device__ void init(int M, int N, int G_, int c_) { nM = M / BM; nN = N / BM; nwg = nM * nN; G = G_; c = c_; }
    __device__ bool next(int i, Unit& u) const {
        const long L = (long)i * G + c; if (L >= nwg) return false;
        int wgid = (int)L; { const int q = nwg / NXCD, r = nwg % NXCD, xcd = wgid % NXCD, off = wgid / NXCD; wgid = (xcd < r ? xcd * (q + 1) : r * (q + 1) + (xcd - r) * q) + off; }
        const int nig = WGM * nN, gid = wgid / nig, fm = gid * WGM, gsz = (nM - fm) < WGM ? (nM - fm) : WGM;
        u.pm = fm + ((wgid % nig) % gsz); u.pn = (wgid % nig) / gsz; return true;
    }
};

struct Epi {
    int kind;
    float* mod; const float* ada_b;
    bf16_t* P; int ldp; int ntile_main; float* G; int ng;
    const float* xp; const float* xs; float* xo; const float* gate; int layer;
    __device__ __forceinline__ void operator()(const f32x4 (&acc)[2][2][4][2], const Unit& u, int wr, int wc, int fr, int fq) const {
        const int row0 = u.pm * BM + wr * 64 + fr;
        const int col0 = u.pn * BM + wc * 32 + 8 * fq;
        if (kind == 0) {
#pragma unroll
            for (int ai = 0; ai < 2; ++ai)
#pragma unroll
                for (int m = 0; m < 4; ++m) { const int row = row0 + ai * HALF + m * 16;
                    if (row < NSEQ) {
#pragma unroll
                        for (int bj = 0; bj < 2; ++bj)
#pragma unroll
                            for (int n = 0; n < 2; ++n) { const int c = col0 + bj * HALF + n * 4; const f32x4 b = *(const f32x4*)(ada_b + c);
                                *(f32x4*)(mod + (size_t)row * 6144 + c) = acc[ai][bj][m][n] + b; } } }
        } else if (kind == 1) {
            if (u.pn < ntile_main) {
#pragma unroll
                for (int ai = 0; ai < 2; ++ai)
#pragma unroll
                    for (int m = 0; m < 4; ++m) { const int row = row0 + ai * HALF + m * 16;
                        if (row < NTOK) { bf16_t* rowp = P + (size_t)row * ldp + col0;
#pragma unroll
                            for (int bj = 0; bj < 2; ++bj) { const f32x4 v0 = acc[ai][bj][m][0], v1 = acc[ai][bj][m][1]; u32x4 o;
                                o.x = pk2(v0[0], v0[1]); o.y = pk2(v0[2], v0[3]); o.z = pk2(v1[0], v1[1]); o.w = pk2(v1[2], v1[3]);
                                *(u32x4*)(rowp + bj * HALF) = o; } } }
            } else {
#pragma unroll
                for (int ai = 0; ai < 2; ++ai)
#pragma unroll
                    for (int m = 0; m < 4; ++m) { const int row = row0 + ai * HALF + m * 16;
#pragma unroll
                        for (int bj = 0; bj < 2; ++bj)
#pragma unroll
                            for (int n = 0; n < 2; ++n) { const int c = bj * HALF + wc * 32 + 8 * fq + 4 * n;
                                if (row < NTOK && c < ng) *(f32x4*)(G + (size_t)row * ng + c) = acc[ai][bj][m][n]; } }
            }
        } else {
#pragma unroll
            for (int ai = 0; ai < 2; ++ai)
#pragma unroll
                for (int m = 0; m < 4; ++m) { const int row = row0 + ai * HALF + m * 16;
                    if (row < NTOK) {
                        const int seq = row < NTP ? (row >> 11) : (8 + row - NTP);
                        const float* xin = layer == 0 ? (row < NTP ? xp + (size_t)row * DM : xs + (size_t)(row - NTP) * DM) : xo + (size_t)row * DM;
                        const float* gp = gate + (size_t)seq * 6144 + layer * 3072 + 2048;
                        float* xw = xo + (size_t)row * DM;
#pragma unroll
                        for (int bj = 0; bj < 2; ++bj)
#pragma unroll
                            for (int n = 0; n < 2; ++n) { const int c = col0 + bj * HALF + n * 4;
                                const f32x4 xv = *(const f32x4*)(xin + c), gv = *(const f32x4*)(gp + c);
                                *(f32x4*)(xw + c) = xv + gv * acc[ai][bj][m][n]; } } }
        }
    }
};

__device__ __forceinline__ void gemm_phase(LAS unsigned char* lds, const Gemm g, const StaticOrder& S, const Epi& E, const int tid) {
    const int wid = __builtin_amdgcn_readfirstlane(tid >> 6), lane = tid & 63, wr = wid >> 2, wc = wid & 3, fr = lane & 15, fq = lane >> 4;
    const int K = g.K, nt = K / BK;
    unsigned voffA[2], voffB[2];
#pragma unroll
    for (int i = 0; i < 2; ++i) { int R, C; stage_rc(tid * 16 + i * 8192, R, C); voffA[i] = (unsigned)(R * K + C) * 2u;
        const int rho = R & 31, Rb = (R & ~31) + 8 * ((rho & 15) >> 2) + 4 * (rho >> 4) + (rho & 3);
        voffB[i] = (unsigned)(Rb * K + C) * 2u; }
    const size_t kstep = (size_t)(BK * 2);
    const size_t hstep = (size_t)HALF * K * 2;
    const size_t tstep = 2 * hstep;
    const unsigned ldsw = (unsigned)wid * 1024u;
    const int aoff = lds_byte(wr * 64 + fr, fq * 8), boff = lds_byte(wc * 32 + fr, fq * 8);
#define PG8_SA(b, h) (((b) * 2 + (h)) * HTB)
#define PG8_SB(b, h) ((4 + (b) * 2 + (h)) * HTB)
#define PG8_STAGE(bufoff, gbase, voff) do { _Pragma("unroll") for (int _i = 0; _i < 2; ++_i) \
        __builtin_amdgcn_global_load_lds((const unsigned*)((const char*)(gbase) + (voff)[_i]), (LAS unsigned*)(lds + (bufoff) + ldsw + _i * 8192), 16, 0, 0); } while (0)
#define PG8_LDA(dst, b, h) do { _Pragma("unroll") for (int m = 0; m < 4; ++m) _Pragma("unroll") for (int k = 0; k < 2; ++k) dst[m][k] = *(const LAS bf16x8*)(lds + PG8_SA(b, h) + aoff + m * 2048 + k * 1024); } while (0)
#define PG8_LDB(dst, b, h) do { _Pragma("unroll") for (int n = 0; n < 2; ++n) _Pragma("unroll") for (int k = 0; k < 2; ++k) dst[n][k] = *(const LAS bf16x8*)(lds + PG8_SB(b, h) + boff + n * 2048 + k * 1024); } while (0)
#define PG8_MMA(ai, bj, At, Bt) do { __builtin_amdgcn_s_setprio(1); _Pragma("unroll") for (int m = 0; m < 4; ++m) _Pragma("unroll") for (int n = 0; n < 2; ++n) _Pragma("unroll") for (int k = 0; k < 2; ++k) \
        acc[ai][bj][m][n] = __builtin_amdgcn_mfma_f32_16x16x32_bf16(Bt[n][k], At[m][k], acc[ai][bj][m][n], 0, 0, 0); __builtin_amdgcn_s_setprio(0); } while (0)
#define PG8_WAIT_V(n) asm volatile("s_waitcnt vmcnt(" #n ")" ::: "memory")
#define PG8_WAIT_L(n) asm volatile("s_waitcnt lgkmcnt(" #n ")" ::: "memory")
#define PG8_BAR __builtin_amdgcn_s_barrier()
#define PG8_SCHED __builtin_amdgcn_sched_barrier(0)
    Unit cur, nxt; int ui = 0;
    if (!S.next(0, cur)) return;
    f32x4 acc[2][2][4][2];
#pragma unroll
    for (int a = 0; a < 2; ++a)
#pragma unroll
        for (int b = 0; b < 2; ++b)
#pragma unroll
            for (int m = 0; m < 4; ++m)
#pragma unroll
                for (int n = 0; n < 2; ++n) acc[a][b][m][n] = (f32x4){0.f, 0.f, 0.f, 0.f};
    bf16x8 At[4][2], B0[2][2], B1[2][2];
    const char* cA = (const char*)g.A + (size_t)cur.pm * tstep; const char* cB = (const char*)g.Bt + (size_t)cur.pn * tstep;
    PG8_STAGE(PG8_SB(0, 0), cB, voffB); PG8_STAGE(PG8_SA(0, 0), cA, voffA); PG8_STAGE(PG8_SB(0, 1), cB + hstep, voffB); PG8_STAGE(PG8_SA(0, 1), cA + hstep, voffA);
    if (wr == 1) PG8_BAR;
    PG8_WAIT_V(4); PG8_BAR;
    PG8_STAGE(PG8_SB(1, 0), cB + kstep, voffB); PG8_STAGE(PG8_SA(1, 0), cA + kstep, voffA); PG8_STAGE(PG8_SB(1, 1), cB + hstep + kstep, voffB);
    PG8_WAIT_V(6); PG8_BAR;
    for (;;) {
        const bool has_next = S.next(ui + 1, nxt);
        const char* nA = has_next ? (const char*)g.A + (size_t)nxt.pm * tstep : cA; const char* nB = has_next ? (const char*)g.Bt + (size_t)nxt.pn * tstep : cB;
        for (int t = 0; t < nt; t += 2) {
            const bool last = (t == nt - 2);
            const char* a1 = cA + (size_t)(t + 1) * kstep;
            const char* a2 = last ? nA : cA + (size_t)(t + 2) * kstep; const char* b2 = last ? nB : cB + (size_t)(t + 2) * kstep;
            const char* a3 = a2 + kstep; const char* b3 = b2 + kstep;
            PG8_LDB(B0, 0, 0); PG8_SCHED; PG8_LDA(At, 0, 0); PG8_STAGE(PG8_SA(1, 1), a1 + hstep, voffA);
            PG8_WAIT_L(8); PG8_BAR; PG8_WAIT_L(0); PG8_MMA(0, 0, At, B0); PG8_BAR; PG8_SCHED;
            PG8_LDB(B1, 0, 1); PG8_STAGE(PG8_SB(0, 0), b2, voffB);
            PG8_BAR; PG8_WAIT_L(0); PG8_MMA(0, 1, At, B1); PG8_BAR;
            PG8_LDA(At, 0, 1); PG8_STAGE(PG8_SA(0, 0), a2, voffA);
            PG8_BAR; PG8_WAIT_L(0); PG8_MMA(1, 0, At, B0); PG8_BAR; PG8_SCHED;
            PG8_STAGE(PG8_SB(0, 1), b2 + hstep, voffB);
            PG8_WAIT_V(6); PG8_BAR; PG8_MMA(1, 1, At, B1); PG8_BAR;
            PG8_LDB(B0, 1, 0); PG8_SCHED; PG8_LDA(At, 1, 0); PG8_STAGE(PG8_SA(0, 1), a2 + hstep, voffA);
            PG8_WAIT_L(8); PG8_BAR; PG8_WAIT_L(0); PG8_MMA(0, 0, At, B0); PG8_BAR; PG8_SCHED;
            PG8_LDB(B1, 1, 1); PG8_STAGE(PG8_SB(1, 0), b3, voffB);
            PG8_BAR; PG8_WAIT_L(0); PG8_MMA(0, 1, At, B1); PG8_BAR;
            PG8_LDA(At, 1, 1); PG8_STAGE(PG8_SA(1, 0), a3, voffA);
            PG8_BAR; PG8_WAIT_L(0); PG8_MMA(1, 0, At, B0); PG8_BAR; PG8_SCHED;
            PG8_STAGE(PG8_SB(1, 1), b3 + hstep, voffB);
            PG8_WAIT_V(6); PG8_BAR; PG8_MMA(1, 1, At, B1); PG8_BAR;
        }
        E(acc, cur, wr, wc, fr, fq);
        if (!has_next) break;
#pragma unroll
        for (int a = 0; a < 2; ++a)
#pragma unroll
            for (int b = 0; b < 2; ++b)
#pragma unroll
                for (int m = 0; m < 4; ++m)
#pragma unroll
                    for (int n = 0; n < 2; ++n) acc[a][b][m][n] = (f32x4){0.f, 0.f, 0.f, 0.f};
        cur = nxt; cA = nA; cB = nB; ++ui;
    }
    PG8_WAIT_V(0);
    if (wr == 0) PG8_BAR;
    PG8_BAR;
#undef PG8_SA
#undef PG8_SB
#undef PG8_STAGE
#undef PG8_LDA
#undef PG8_LDB
#undef PG8_MMA
#undef PG8_WAIT_V
#undef PG8_WAIT_L
#undef PG8_BAR
#undef PG8_SCHED
}
}

typedef const __attribute__((address_space(4))) Params* KP;
struct Ctx {
    int lane, wave, gw, ngw, bid, nblk, tid;
    LAS unsigned char* lds;
};
#define WSP(T, off) ((T*)(P->ws + (off)))
#define DOP(T, off) ((T*)((unsigned char*)P->out + (off)))

__device__ __forceinline__ void transpose_item(const float* W, int ldw, bf16_t* WT, int K, int k0, int n0, int mapkind, LAS float* scr, int lane) {
    const int n = n0 + (lane & 31);
    const int sc = mapkind == 0 ? map_even(n) : (mapkind == 1 ? map_odd(n) : n);
#pragma unroll
    for (int i = 0; i < 32; ++i) { const int kk = 2 * i + (lane >> 5); scr[kk * 33 + (lane & 31)] = sc >= 0 ? W[(size_t)(k0 + kk) * ldw + sc] : 0.f; }
    asm volatile("s_waitcnt lgkmcnt(0)" ::: "memory");
    const int c = lane & 7;
#pragma unroll
    for (int j = 0; j < 4; ++j) { const int nn = (lane >> 3) + 8 * j; const LAS float* s = scr + (8 * c) * 33 + nn;
        u32x4 o; o.x = pk2(s[0 * 33], s[1 * 33]); o.y = pk2(s[2 * 33], s[3 * 33]); o.z = pk2(s[4 * 33], s[5 * 33]); o.w = pk2(s[6 * 33], s[7 * 33]);
        *(u32x4*)(WT + (size_t)(n0 + nn) * K + k0 + 8 * c) = o; }
    asm volatile("s_waitcnt lgkmcnt(0)" ::: "memory");
}

__device__ __forceinline__ void prep_weights(KP P, const Ctx& C, int gw, int ngw) {
    LAS float* scr = (LAS float*)(C.lds + C.wave * 8704);
    constexpr int I_WIN0 = 16 * (PE_PAD / 32), I_WIN1 = 16 * (PO_PAD / 32), I_WOUT = 32 * 32;
    constexpr int NIT = I_WIN0 + I_WIN1 + 2 * I_WOUT;
    for (int it = gw; it < NIT; it += ngw) {
        int r = it;
        if (r < I_WIN0) { const int nb = r % (PE_PAD / 32), kb = r / (PE_PAD / 32); transpose_item(P->in[14], 8224, WSP(bf16_t, WS_WIN0), 1024, kb * 64, nb * 32, 0, scr, C.lane); continue; } r -= I_WIN0;
        if (r < I_WIN1) { const int nb = r % (PO_PAD / 32), kb = r / (PO_PAD / 32); transpose_item(P->in[22], 6160, WSP(bf16_t, WS_WIN1), 1024, kb * 64, nb * 32, 1, scr, C.lane); continue; } r -= I_WIN1;
        if (r < I_WOUT) { const int nb = r % 32, kb = r / 32; transpose_item(P->in[15], 1024, WSP(bf16_t, WS_WOUT0), 2048, kb * 64, nb * 32, 2, scr, C.lane); continue; } r -= I_WOUT;
        { const int nb = r % 32, kb = r / 32; transpose_item(P->in[23], 1024, WSP(bf16_t, WS_WOUT1), 2048, kb * 64, nb * 32, 2, scr, C.lane); }
    }
}
__device__ __forceinline__ void phase_prep0(KP P, const Ctx& C) {
    LAS float* scr = (LAS float*)(C.lds + C.wave * 8704);
    constexpr int I_ADA = 2 * 16 * 96;
    for (int r = C.gw; r < I_ADA; r += C.ngw) {
        const int l = r / (16 * 96), rr = r % (16 * 96), nb = rr % 96, kb = rr / 96;
        transpose_item(P->in[11] + (size_t)l * 1024 * 3072, 3072, WSP(bf16_t, WS_ADAT) + (size_t)l * 3072 * 1024, 1024, kb * 64, nb * 32, 2, scr, C.lane);
    }
    const int gt = C.bid * 512 + C.tid, ngt = C.nblk * 512;
    bf16_t* cbf = WSP(bf16_t, WS_CBF);
    for (int i = gt; i < 256 * 512; i += ngt) { const int row = i >> 9, c2 = (i & 511) * 2; float a = 0.f, b = 0.f;
        if (row < NSEQ) { const float* cp = row < 8 ? P->in[2] + row * 1024 : P->in[3] + (row - 8) * 1024; a = siluf_(cp[c2]); b = siluf_(cp[c2 + 1]); }
        *(unsigned*)(cbf + (size_t)row * 1024 + c2) = pk2(a, b); }
    f32x2* rope = WSP(f32x2, WS_ROPE);
    for (int i = gt; i < 2049 * 64; i += ngt) { const int p = i >> 6, fi = i & 63; const float pos = p < 2048 ? (float)p : 16384.f;
        const float inv = expf(-(float)fi * (1.f / 64.f) * 9.210340371976184f); const float ang = pos * inv;
        const double ad = (double)ang; const double n = rint(ad * 0.15915494309189535); const float rr = (float)(ad - n * 6.283185307179586);
        rope[i] = (f32x2){cosf(rr), sinf(rr)}; }
    unsigned* hz = (unsigned*)(DOP(bf16_t, DO_HBUF) + (size_t)NTOK * 1024);
    for (int i = gt; i < 128 * 512; i += ngt) hz[i] = 0u;
    unsigned* yz = (unsigned*)(WSP(bf16_t, WS_Y) + (size_t)NTOK * 2048);
    for (int i = gt; i < 128 * 1024; i += ngt) yz[i] = 0u;
}

__device__ __forceinline__ void phase_hnorm(KP P, const Ctx& C, int layer) {
    const float* mod = WSP(float, WS_MOD); const float* nw = P->in[13] + layer * 1024; bf16_t* hb = DOP(bf16_t, DO_HBUF);
    for (int tok = C.gw; tok < NTOK; tok += C.ngw) {
        const float* xr = layer == 0 ? (tok < NTP ? P->in[0] + (size_t)tok * DM : P->in[1] + (size_t)(tok - NTP) * DM) : P->out + (size_t)tok * DM;
        const int seq = tok < NTP ? (tok >> 11) : (8 + tok - NTP);
        const float* md = mod + (size_t)seq * 6144 + layer * 3072;
        f32x4 v[4]; float ss = 0.f;
#pragma unroll
        for (int j = 0; j < 4; ++j) { v[j] = ((const f32x4*)xr)[C.lane + 64 * j]; ss += v[j].x * v[j].x + v[j].y * v[j].y + v[j].z * v[j].z + v[j].w * v[j].w; }
        ss = ar64(ss); const float rstd = rsqrtf(ss * (1.f / 1024.f) + EPS);
#pragma unroll
        for (int j = 0; j < 4; ++j) { const int idx = (C.lane + 64 * j) * 4;
            const f32x4 w = *(const f32x4*)(nw + idx), sh = *(const f32x4*)(md + idx), sc = *(const f32x4*)(md + 1024 + idx);
            const f32x4 h = v[j] * rstd * w * (sc + 1.f) + sh; u32x2 o; o.x = pk2(h.x, h.y); o.y = pk2(h.z, h.w);
            *(u32x2*)(hb + (size_t)tok * 1024 + idx) = o; }
    }
}

template <int S0, int NS> __device__ __forceinline__ void prep_even_rows(KP P, const Ctx& C, int i, int tok0, int t0) {
    const bf16_t* proj = WSP(bf16_t, WS_PROJ); const float* G = WSP(float, WS_GATES); float* GA = WSP(float, WS_GA); float* GB = WSP(float, WS_GB);
    bf16_t* ab = DOP(bf16_t, DO_ABUF); const float* cw = P->in[16]; const int lane = C.lane;
    f32x4 w[NS][4][2];
#pragma unroll
    for (int s = 0; s < NS; ++s)
#pragma unroll
        for (int j = 0; j < 4; ++j) { const float* wp = cw + j * 3072 + (S0 + s) * 1024 + i * 512 + lane * 8; w[s][j][0] = *(const f32x4*)wp; w[s][j][1] = *(const f32x4*)(wp + 4); }
    u32x4 win[NS][4];
#pragma unroll
    for (int s = 0; s < NS; ++s)
#pragma unroll
        for (int j = 0; j < 3; ++j) { u32x4 rr = {0u, 0u, 0u, 0u};
            if (t0 != 0) rr = *(const u32x4*)(proj + (size_t)(tok0 + j - 3) * PE_MAIN + (S0 + s) * 1024 + i * 512 + lane * 8);
            win[s][j] = rr; }
    u32x4 nxt[NS], nx2[NS];
#pragma unroll
    for (int s = 0; s < NS; ++s) { nxt[s] = *(const u32x4*)(proj + (size_t)tok0 * PE_MAIN + (S0 + s) * 1024 + i * 512 + lane * 8);
        nx2[s] = *(const u32x4*)(proj + (size_t)(tok0 + 1) * PE_MAIN + (S0 + s) * 1024 + i * 512 + lane * 8); }
#pragma unroll 1
    for (int tt = 0; tt < 16; ++tt) { const int tu = 0, tok = tok0 + tt, t = t0 + tt;
#pragma unroll
        for (int s = 0; s < NS; ++s) { if (tt > 0) { win[s][0] = win[s][1]; win[s][1] = win[s][2]; win[s][2] = win[s][3]; }
            win[s][3] = nxt[s]; nxt[s] = nx2[s];
            nx2[s] = *(const u32x4*)(proj + (size_t)(tok + 2) * PE_MAIN + (S0 + s) * 1024 + i * 512 + lane * 8); }
        if (S0 == 0 && i == 0 && lane < 8) { const int h = lane; const float* g = G + (size_t)tok * 32;
            const float beta = sigmoidf_(g[h]); const float a = expf(-expf(P->in[17][h]) * softplusf_(g[8 + h] + P->in[18][h]));
            GA[(size_t)tok * 32 + h * 4] = a; GA[(size_t)tok * 32 + h * 4 + 1] = beta;
            const float ig = g[16 + h] + P->in[20][h], fg = g[24 + h] + P->in[20][8 + h];
            GB[(size_t)tok * 32 + h * 4] = ig; GB[(size_t)tok * 32 + h * 4 + 1] = -softplusf_(-fg); }
        float val[NS][8];
#pragma unroll
        for (int s = 0; s < NS; ++s) { float y[8];
#pragma unroll
            for (int e = 0; e < 8; ++e) y[e] = 0.f;
#pragma unroll
            for (int j = 0; j < 4; ++j) { float u[8]; unpack8(win[s][(tu + j) & 3], u);
                const f32x4 w0 = w[s][j][0], w1 = w[s][j][1];
                y[0] += w0.x * u[0]; y[1] += w0.y * u[1]; y[2] += w0.z * u[2]; y[3] += w0.w * u[3];
                y[4] += w1.x * u[4]; y[5] += w1.y * u[5]; y[6] += w1.z * u[6]; y[7] += w1.w * u[7];
                if (j == 3 && t >= 2045) { float* pc = P->out + OUT_PCONV + ((size_t)(tok >> 11) * 3 + (t - 2045)) * 3072 + (S0 + s) * 1024 + i * 512 + lane * 8;
                    *(f32x4*)pc = (f32x4){u[0], u[1], u[2], u[3]}; *(f32x4*)(pc + 4) = (f32x4){u[4], u[5], u[6], u[7]}; } }
#pragma unroll
            for (int e = 0; e < 8; ++e) val[s][e] = siluf_(y[e]); }
        if (S0 == 0) {
            float sq = 0.f, sk = 0.f, d = 0.f;
#pragma unroll
            for (int e = 0; e < 8; ++e) { sq += val[0][e] * val[0][e]; sk += val[NS - 1][e] * val[NS - 1][e]; d += val[0][e] * val[NS - 1][e]; }
            sq = ar16(sq); sk = ar16(sk); d = ar16(d);
            const float rq = rsqrtf(sq + EPS) * 0.08838834764831845f, rk = rsqrtf(sk + EPS);
#pragma unroll
            for (int e = 0; e < 8; ++e) { val[0][e] *= rq; val[NS - 1][e] *= rk; }
            *(u32x4*)(ab + (size_t)tok * 3072 + i * 512 + lane * 8) = pack8(val[0]);
            *(u32x4*)(ab + (size_t)tok * 3072 + 1024 + i * 512 + lane * 8) = pack8(val[NS - 1]);
            if ((lane & 15) == 0) GA[(size_t)tok * 32 + (4 * i + (lane >> 4)) * 4 + 2] = d * rq * rk;
        } else {
            *(u32x4*)(ab + (size_t)tok * 3072 + 2048 + i * 512 + lane * 8) = pack8(val[0]);
        }
    }
}
__device__ __forceinline__ void phase_prep_even_prompt(KP P, const Ctx& C) {
    for (int wi = C.gw; wi < 2048; wi += C.ngw) {
        const int i = wi & 1, tok0 = (wi >> 1) * 16, t0 = tok0 & 2047;
        prep_even_rows<0, 2>(P, C, i, tok0, t0);
        prep_even_rows<2, 1>(P, C, i, tok0, t0);
    }
}
__device__ __forceinline__ void phase_prep_even(KP P, const Ctx& C) {
    const bf16_t* proj = WSP(bf16_t, WS_PROJ); const float* G = WSP(float, WS_GATES); float* GA = WSP(float, WS_GA); float* GB = WSP(float, WS_GB);
    bf16_t* ab = DOP(bf16_t, DO_ABUF); const float* cw = P->in[16]; const int lane = C.lane;
    phase_prep_even_prompt(P, C);
    for (int tok = NTP + C.gw; tok < NTOK; tok += C.ngw) {
        const bool isP = tok < NTP; const int t = isP ? (tok & 2047) : 0; const int si = tok - NTP;
        if (lane < 8) { const int h = lane; const float* g = G + (size_t)tok * 32;
            const float beta = sigmoidf_(g[h]); const float a = expf(-expf(P->in[17][h]) * softplusf_(g[8 + h] + P->in[18][h]));
            GA[(size_t)tok * 32 + h * 4] = a; GA[(size_t)tok * 32 + h * 4 + 1] = beta;
            const float ig = g[16 + h] + P->in[20][h], fg = g[24 + h] + P->in[20][8 + h];
            GB[(size_t)tok * 32 + h * 4] = ig; GB[(size_t)tok * 32 + h * 4 + 1] = -softplusf_(-fg); }
#pragma unroll 1
        for (int i = 0; i < 2; ++i) {
            float val[3][8];
            u32x4 raw[3][4];
#pragma unroll
            for (int s = 0; s < 3; ++s)
#pragma unroll
                for (int j = 0; j < 4; ++j) { const int back = 3 - j; const int rowi = (isP && t >= back) ? tok - back : tok;
                    u32x4 rr = *(const u32x4*)(proj + (size_t)rowi * PE_MAIN + s * 1024 + i * 512 + lane * 8);
                    if (t < back) rr = (u32x4){0u, 0u, 0u, 0u};
                    raw[s][j] = rr; }
#pragma unroll
            for (int s = 0; s < 3; ++s) { const int c0 = s * 1024 + i * 512 + lane * 8;
                float y[8];
#pragma unroll
                for (int e = 0; e < 8; ++e) y[e] = 0.f;
#pragma unroll
                for (int j = 0; j < 4; ++j) {
                    const int back = 3 - j; float u[8];
                    if (isP || t >= back) unpack8(raw[s][j], u);
                    else if (!isP) { const float* bp = P->in[5] + ((size_t)si * 3 + (t + j)) * 3072 + c0; const f32x4 b0 = *(const f32x4*)bp, b1 = *(const f32x4*)(bp + 4);
                        u[0] = b0.x; u[1] = b0.y; u[2] = b0.z; u[3] = b0.w; u[4] = b1.x; u[5] = b1.y; u[6] = b1.z; u[7] = b1.w; }
                    else {
#pragma unroll
                        for (int e = 0; e < 8; ++e) u[e] = 0.f; }
                    const f32x4 w0 = *(const f32x4*)(cw + j * 3072 + c0), w1 = *(const f32x4*)(cw + j * 3072 + c0 + 4);
                    y[0] += w0.x * u[0]; y[1] += w0.y * u[1]; y[2] += w0.z * u[2]; y[3] += w0.w * u[3];
                    y[4] += w1.x * u[4]; y[5] += w1.y * u[5]; y[6] += w1.z * u[6]; y[7] += w1.w * u[7];
                    if (isP) { if (j == 3 && t >= 2045) { float* pc = P->out + OUT_PCONV + ((size_t)(tok >> 11) * 3 + (t - 2045)) * 3072 + c0;
                            *(f32x4*)pc = (f32x4){u[0], u[1], u[2], u[3]}; *(f32x4*)(pc + 4) = (f32x4){u[4], u[5], u[6], u[7]}; } }
                    else if (j >= 1) { float* sc = P->out + OUT_SCONV + ((size_t)si * 3 + (j - 1)) * 3072 + c0;
                        *(f32x4*)sc = (f32x4){u[0], u[1], u[2], u[3]}; *(f32x4*)(sc + 4) = (f32x4){u[4], u[5], u[6], u[7]}; }
                }
#pragma unroll
                for (int e = 0; e < 8; ++e) val[s][e] = siluf_(y[e]);
            }
            float sq = 0.f, sk = 0.f, d = 0.f;
#pragma unroll
            for (int e = 0; e < 8; ++e) { sq += val[0][e] * val[0][e]; sk += val[1][e] * val[1][e]; d += val[0][e] * val[1][e]; }
            sq = ar16(sq); sk = ar16(sk); d = ar16(d);
            const float rq = rsqrtf(sq + EPS) * 0.08838834764831845f, rk = rsqrtf(sk + EPS);
#pragma unroll
            for (int e = 0; e < 8; ++e) { val[0][e] *= rq; val[1][e] *= rk; }
            *(u32x4*)(ab + (size_t)tok * 3072 + i * 512 + lane * 8) = pack8(val[0]);
            *(u32x4*)(ab + (size_t)tok * 3072 + 1024 + i * 512 + lane * 8) = pack8(val[1]);
            *(u32x4*)(ab + (size_t)tok * 3072 + 2048 + i * 512 + lane * 8) = pack8(val[2]);
            if ((lane & 15) == 0) GA[(size_t)tok * 32 + (4 * i + (lane >> 4)) * 4 + 2] = d * rq * rk;
        }
    }
}

template <int NLANES> __device__ __forceinline__ float arN(float x) { return NLANES == 16 ? ar16(x) : (NLANES == 8 ? ar8(x) : ar4(x)); }
template <int MODE, int DKL, int DR> __device__ __forceinline__ void rec_item(KP P, int item, int lane) {
    constexpr int DK = (MODE == 1 || MODE == 4) ? 64 : 128;
    constexpr int NL = DK / DKL;
    constexpr int CW = (64 / NL) * 2;
    constexpr int DV = (MODE == 0 || MODE == 1) ? 128 : (MODE == 4 ? CW : 256);
    constexpr int NCB = DV / CW;
    constexpr int NH = (MODE >= 2 && MODE <= 3) ? 4 : 8;
    constexpr int LD = MODE == 0 ? 3072 : ((MODE == 1 || MODE == 4) ? PE_MAIN : PO_MAIN);
    const int bh = item / NCB, cb = item % NCB, b = bh / NH, h = bh % NH;
    const int r = lane & (NL - 1), dv = cb * CW + (lane / NL) * 2;
    const bf16_t* src = (MODE == 0 ? DOP(bf16_t, DO_ABUF) : WSP(bf16_t, WS_PROJ)) + (size_t)b * TSEQ * LD;
    const int ko = (MODE == 0 ? 1024 + h * 128 : (MODE == 1 || MODE == 4) ? E_KB + h * 64 : MODE == 2 ? O_KC + h * 128 : O_KD + h * 128) + r * DKL;
    const int qo = (MODE == 0 ? h * 128 : (MODE == 1 || MODE == 4) ? E_QB + h * 64 : MODE == 2 ? O_QC + h * 128 : O_QD + h * 128) + r * DKL;
    const int vo = (MODE == 0 ? 2048 + h * 128 : MODE == 1 ? E_VB + h * 128 : MODE == 2 ? O_VC + h * 256 : O_VD + h * 256) + dv;
    float* gsrc = (MODE == 0 ? WSP(float, WS_GA) : WSP(float, WS_GB)) + (size_t)b * TSEQ * 32 + h * 4;
    const float* asrc = WSP(float, WS_ALPHA) + (size_t)b * TSEQ * 512 + h * 128 + r * DKL;
    bf16_t* yb = WSP(bf16_t, WS_Y) + (size_t)b * TSEQ * 2048 + (MODE == 0 ? h * 128 : MODE == 1 ? 1024 + h * 128 : MODE == 2 ? h * 256 : 1024 + h * 256) + dv;
    const float gam = 1.f - exp2f(-5.f - (float)h);
    struct TokIn { u32x4 k0, k1, q0, q1; unsigned v; f32x4 g; f32x4 a0, a1, a2, a3; };
    f32x2 S[DKL];
#pragma unroll
    for (int i = 0; i < DKL; ++i) S[i] = (f32x2){0.f, 0.f};
    float m = 0.f, A = 1.f;
    auto load = [&](TokIn& x, int t) {
        const int tt = t;
        const bf16_t* p = src + (size_t)tt * LD;
        x.k0 = *(const u32x4*)(p + ko); x.q0 = *(const u32x4*)(p + qo);
        if (DKL == 16) { x.k1 = *(const u32x4*)(p + ko + 8); x.q1 = *(const u32x4*)(p + qo + 8); }
        if (MODE != 4) x.v = *(const unsigned*)(p + vo);
        if (MODE == 0) { const f32x3 g3 = *(const f32x3*)(gsrc + (size_t)tt * 32); x.g.x = g3.x; x.g.y = g3.y; x.g.z = g3.z; }
        if (MODE == 1 || MODE == 4) { const f32x2 g2 = *(const f32x2*)(gsrc + (size_t)tt * 32); x.g.x = g2.x; x.g.y = g2.y; }
        if (MODE == 2) { const float* ap = asrc + (size_t)tt * 512; x.a0 = *(const f32x4*)ap; x.a1 = *(const f32x4*)(ap + 4);
            if (DKL == 16) { x.a2 = *(const f32x4*)(ap + 8); x.a3 = *(const f32x4*)(ap + 12); } }
    };
    auto step = [&](const TokIn& x, int t) {
        float k[16], q[16]; unpack8(x.k0, k); unpack8(x.q0, q);
        if (DKL == 16) { unpack8(x.k1, k + 8); unpack8(x.q1, q + 8); }
        f32x2 v = {1.f, 1.f};
        if (MODE != 4) v = (f32x2){bflo(x.v), bfhi(x.v)};
        f32x2 o = {0.f, 0.f};
        if (MODE == 0) {
            const float a = x.g.x, be = x.g.y, qk = x.g.z;
            f32x2 pka[4], pqa[4];
#pragma unroll
            for (int i = 0; i < 4; ++i) { pka[i] = S[i] * k[i]; pqa[i] = S[i] * q[i]; }
#pragma unroll
            for (int i = 4; i < DKL; ++i) { pka[i & 3] += S[i] * k[i]; pqa[i & 3] += S[i] * q[i]; }
            f32x2 pk = (pka[0] + pka[1]) + (pka[2] + pka[3]), pq = (pqa[0] + pqa[1]) + (pqa[2] + pqa[3]);
            { float p0 = pk.x, p1 = pk.y, p2 = pq.x, p3 = pq.y;
              if (NL == 8) ar8x4(p0, p1, p2, p3); else if (NL == 16) ar16x4(p0, p1, p2, p3); else { p0 = arN<NL>(p0); p1 = arN<NL>(p1); p2 = arN<NL>(p2); p3 = arN<NL>(p3); }
              pk = (f32x2){p0, p1}; pq = (f32x2){p2, p3}; }
            float An = a * A;
            const f32x2 u = (v - pk * An) * be;
            o = pq * An + u * qk;
            if (An < 1e-12f) {
#pragma unroll
                for (int i = 0; i < DKL; ++i) S[i] = S[i] * An;
                An = 1.f; }
            const f32x2 uh = u * __builtin_amdgcn_rcpf(An);
#pragma unroll
            for (int i = 0; i < DKL; ++i) S[i] = S[i] + uh * k[i];
            A = An;
        } else if (MODE == 1 || MODE == 4) {
            const float ig = x.g.x, lf = x.g.y;
            const float mn = fmaxf(lf + m, ig); const float dec = __expf(lf + m - mn), isc = __expf(ig - mn) * 0.125f; m = mn;
            const f32x2 u = v * isc;
            f32x2 oa[4] = {o, o, o, o};
#pragma unroll
            for (int i = 0; i < DKL; ++i) { S[i] = S[i] * dec + u * k[i]; oa[i & 3] += S[i] * q[i]; }
            o = (oa[0] + oa[1]) + (oa[2] + oa[3]);
            o.x = arN<NL>(o.x); if (MODE == 1) o.y = arN<NL>(o.y);
        } else if (MODE == 2) {
            const float al[16] = {x.a0.x, x.a0.y, x.a0.z, x.a0.w, x.a1.x, x.a1.y, x.a1.z, x.a1.w, x.a2.x, x.a2.y, x.a2.z, x.a2.w, x.a3.x, x.a3.y, x.a3.z, x.a3.w};
            f32x2 oa[4] = {o, o, o, o};
#pragma unroll
            for (int i = 0; i < DKL; ++i) { S[i] = S[i] * al[i] + v * k[i]; oa[i & 3] += S[i] * q[i]; }
            o = (oa[0] + oa[1]) + (oa[2] + oa[3]);
            if (NL == 16) { float p0 = o.x, p1 = o.y; ar16x2(p0, p1); o = (f32x2){p0, p1}; } else { o.x = arN<NL>(o.x); o.y = arN<NL>(o.y); }
            o *= 0.08838834764831845f;
        } else {
            f32x2 oa[4] = {o, o, o, o};
#pragma unroll
            for (int i = 0; i < DKL; ++i) { S[i] = S[i] * gam + v * k[i]; oa[i & 3] += S[i] * q[i]; }
            o = (oa[0] + oa[1]) + (oa[2] + oa[3]);
            if (NL == 16) { float p0 = o.x, p1 = o.y; ar16x2(p0, p1); o = (f32x2){p0, p1}; } else { o.x = arN<NL>(o.x); o.y = arN<NL>(o.y); }
        }
        if (MODE == 4) { if (lane == 0) gsrc[(size_t)t * 32 + 2] = __builtin_amdgcn_rcpf(fmaxf(fabsf(o.x), __expf(-m))); }
        else if (r == 0) *(unsigned*)(yb + (size_t)t * 2048) = pk2(o.x, o.y);
    };
    TokIn X[DR];
#pragma unroll
    for (int d = 0; d < DR; ++d) load(X[d], d);
    for (int t0 = 0; t0 < TSEQ; t0 += DR) {
#pragma unroll
        for (int d = 0; d < DR; ++d) { const int t = t0 + d;
            if (t < TSEQ) step(X[d], t);
            load(X[d], t + DR); }
    }
    if (MODE == 4) {
        if (lane < NL) {
#pragma unroll
            for (int i = 0; i < DKL; ++i) P->out[OUT_PMN + (size_t)bh * 64 + r * DKL + i] = S[i].x; }
        if (lane == 0) P->out[OUT_PMM + bh] = m;
    } else {
        float* ps = P->out + (MODE == 0 ? OUT_PGDN : MODE == 1 ? OUT_PMC : MODE == 2 ? OUT_PGLA : OUT_PRET) + (size_t)bh * DK * DV;
#pragma unroll
        for (int i = 0; i < DKL; ++i) *(f32x2*)(ps + (size_t)(r * DKL + i) * DV + dv) = (MODE == 0) ? S[i] * A : S[i];
    }
}

__device__ __forceinline__ void gdn_sample_item(KP P, int idx, int lane) {
    const int si = idx >> 3, h = idx & 7, tok = NTP + si;
    const float* Sin = P->in[4] + (size_t)idx * 128 * 128; float* Sout = P->out + OUT_SGDN + (size_t)idx * 128 * 128;
    const bf16_t* ab = DOP(bf16_t, DO_ABUF) + (size_t)tok * 3072 + h * 128;
    const float* ga = WSP(float, WS_GA) + (size_t)tok * 32;
    const unsigned kpk = *(const unsigned*)(ab + 1024 + 2 * lane), qpk = *(const unsigned*)(ab + 2 * lane), vpk = *(const unsigned*)(ab + 2048 + 2 * lane);
    const float a = ga[h * 4], be = ga[h * 4 + 1], qk = ga[h * 4 + 2];
    f32x2 pk = {0.f, 0.f}, pq = {0.f, 0.f};
#pragma unroll 8
    for (int d2 = 0; d2 < 64; ++d2) { const unsigned ku = rdlu(kpk, d2), qu = rdlu(qpk, d2);
        const f32x2 s0 = *(const f32x2*)(Sin + (size_t)(2 * d2) * 128 + 2 * lane), s1 = *(const f32x2*)(Sin + (size_t)(2 * d2 + 1) * 128 + 2 * lane);
        pk += s0 * bflo(ku) + s1 * bfhi(ku); pq += s0 * bflo(qu) + s1 * bfhi(qu); }
    const f32x2 v = {bflo(vpk), bfhi(vpk)};
    const f32x2 u = (v - pk * a) * be; const f32x2 o = pq * a + u * qk;
#pragma unroll 8
    for (int d2 = 0; d2 < 64; ++d2) { const unsigned ku = rdlu(kpk, d2);
        const f32x2 s0 = *(const f32x2*)(Sin + (size_t)(2 * d2) * 128 + 2 * lane), s1 = *(const f32x2*)(Sin + (size_t)(2 * d2 + 1) * 128 + 2 * lane);
        *(f32x2*)(Sout + (size_t)(2 * d2) * 128 + 2 * lane) = s0 * a + u * bflo(ku);
        *(f32x2*)(Sout + (size_t)(2 * d2 + 1) * 128 + 2 * lane) = s1 * a + u * bfhi(ku); }
    *(unsigned*)(WSP(bf16_t, WS_Y) + (size_t)tok * 2048 + h * 128 + 2 * lane) = pk2(o.x, o.y);
}

__device__ __forceinline__ void mlstm_sample_item(KP P, int idx, int lane) {
    const int si = idx >> 3, h = idx & 7, tok = NTP + si;
    const float* Cin = P->in[6] + (size_t)idx * 64 * 128; float* Cout = P->out + OUT_SMC + (size_t)idx * 64 * 128;
    const bf16_t* pr = WSP(bf16_t, WS_PROJ) + (size_t)tok * PE_MAIN;
    float* gb = WSP(float, WS_GB) + (size_t)tok * 32;
    const float m0 = P->in[8][idx], ig = gb[h * 4], lf = gb[h * 4 + 1];
    const float mn = fmaxf(lf + m0, ig); const float dec = expf(lf + m0 - mn), isc = expf(ig - mn) * 0.125f;
    const unsigned kpk = *(const unsigned*)(pr + E_KB + h * 64 + 2 * (lane & 31)), qpk = *(const unsigned*)(pr + E_QB + h * 64 + 2 * (lane & 31));
    const unsigned vpk = *(const unsigned*)(pr + E_VB + h * 128 + 2 * lane);
    const f32x2 uv = (f32x2){bflo(vpk), bfhi(vpk)} * isc;
    f32x2 num = {0.f, 0.f};
#pragma unroll 8
    for (int d2 = 0; d2 < 32; ++d2) { const unsigned ku = rdlu(kpk, d2), qu = rdlu(qpk, d2);
        const f32x2 s0 = *(const f32x2*)(Cin + (size_t)(2 * d2) * 128 + 2 * lane), s1 = *(const f32x2*)(Cin + (size_t)(2 * d2 + 1) * 128 + 2 * lane);
        const f32x2 n0 = s0 * dec + uv * bflo(ku), n1 = s1 * dec + uv * bfhi(ku);
        *(f32x2*)(Cout + (size_t)(2 * d2) * 128 + 2 * lane) = n0; *(f32x2*)(Cout + (size_t)(2 * d2 + 1) * 128 + 2 * lane) = n1;
        num += n0 * bflo(qu) + n1 * bfhi(qu); }
    const float kl = bf1(pr[E_KB + h * 64 + lane]), ql = bf1(pr[E_QB + h * 64 + lane]);
    const float nl = dec * P->in[7][(size_t)idx * 64 + lane] + isc * kl;
    const float den = ar64(nl * ql);
    P->out[OUT_SMN + (size_t)idx * 64 + lane] = nl;
    if (lane == 0) { P->out[OUT_SMM + idx] = mn; gb[h * 4 + 2] = 1.f / fmaxf(fabsf(den), expf(-mn)); }
    *(unsigned*)(WSP(bf16_t, WS_Y) + (size_t)tok * 2048 + 1024 + h * 128 + 2 * lane) = pk2(num.x, num.y);
}

__device__ __forceinline__ void phase_rec_even(KP P, const Ctx& C) {
    const int lane = C.lane;
    { const int slot = C.bid * 4 + (C.wave & 3), nslot = C.nblk * 4;
        if (C.wave < 4) { for (int g = slot; g < 1024; g += nslot) rec_item<0, 8, 8>(P, g, lane); }
        else { for (int q = slot; q < 576; q += nslot) { if (q < 512) rec_item<1, 8, 8>(P, q, lane); else rec_item<4, 8, 8>(P, q - 512, lane); } } }
    unsigned* ctr = WSP(unsigned, WS_CTL);
    for (;;) {
        int idx = 0; if (lane == 0) idx = (int)atomicAdd(ctr, 1u);
        idx = __builtin_amdgcn_readfirstlane(idx);
        if (idx >= 2048) break;
        if (idx < 1024) gdn_sample_item(P, idx, lane); else mlstm_sample_item(P, idx - 1024, lane);
    }
}

__device__ __forceinline__ void phase_post_even(KP P, const Ctx& C) {
    bf16_t* Y = WSP(bf16_t, WS_Y); const bf16_t* proj = WSP(bf16_t, WS_PROJ); const float* GB = WSP(float, WS_GB); const int lane = C.lane;
    for (int tok = C.gw; tok < NTOK; tok += C.ngw) {
#pragma unroll
        for (int i = 0; i < 4; ++i) { const int ch0 = i * 512 + lane * 8; float o[8], z[8], y[8];
            unpack8(*(const u32x4*)(Y + (size_t)tok * 2048 + ch0), o); unpack8(*(const u32x4*)(proj + (size_t)tok * PE_MAIN + E_Z + ch0), z);
            if (i < 2) { float ss = 0.f;
#pragma unroll
                for (int e = 0; e < 8; ++e) ss += o[e] * o[e];
                ss = ar16(ss); const float rs = rsqrtf(ss * (1.f / 128.f) + EPS); const float* w = P->in[19] + (ch0 & 127);
#pragma unroll
                for (int e = 0; e < 8; ++e) y[e] = o[e] * rs * w[e] * siluf_(z[e]);
            } else { const int hh = (ch0 - 1024) >> 7; const float dn = GB[(size_t)tok * 32 + hh * 4 + 2]; float ss = 0.f; float op[8];
                unpack8(*(const u32x4*)(proj + (size_t)tok * PE_MAIN + E_OP + ch0 - 1024), op);
#pragma unroll
                for (int e = 0; e < 8; ++e) { o[e] *= dn; ss += o[e] * o[e]; }
                ss = ar16(ss); const float rs = rsqrtf(ss * (1.f / 128.f) + EPS); const float* w = P->in[21] + (ch0 & 127);
#pragma unroll
                for (int e = 0; e < 8; ++e) y[e] = sigmoidf_(op[e]) * o[e] * rs * w[e] * siluf_(z[e]);
            }
            *(u32x4*)(Y + (size_t)tok * 2048 + ch0) = pack8(y);
        }
    }
}

__device__ __forceinline__ void phase_prep_odd(KP P, const Ctx& C) {
    bf16_t* proj = WSP(bf16_t, WS_PROJ); const float* G = WSP(float, WS_GATES); float* AL = WSP(float, WS_ALPHA); const f32x2* rope = WSP(f32x2, WS_ROPE);
    const float* w2 = P->in[24]; const float* b2 = P->in[25]; const int lane = C.lane;
    for (int job = C.gw; job < (NTOK / 16) * 2; job += C.ngw) {
        const int half = job & 1, tok0 = (job >> 1) * 16, ch = half * 256 + lane * 4;
        f32x4 w[16];
#pragma unroll
        for (int r = 0; r < 16; ++r) w[r] = *(const f32x4*)(w2 + r * 512 + ch);
        const f32x4 bb = *(const f32x4*)(b2 + ch);
#pragma unroll 4
        for (int tt = 0; tt < 16; ++tt) { const int tok = tok0 + tt;
            f32x4 x = bb;
#pragma unroll
            for (int r4 = 0; r4 < 4; ++r4) { const f32x4 gv = *(const f32x4*)(G + (size_t)tok * 16 + r4 * 4);
                x += w[r4 * 4] * gv.x + w[r4 * 4 + 1] * gv.y + w[r4 * 4 + 2] * gv.z + w[r4 * 4 + 3] * gv.w; }
            f32x4 al; al.x = gla_alpha_(x.x); al.y = gla_alpha_(x.y); al.z = gla_alpha_(x.z); al.w = gla_alpha_(x.w);
            *(f32x4*)(AL + (size_t)tok * 512 + ch) = al; }
    }
    for (int tok = C.gw; tok < NTOK; tok += C.ngw) {
        const bool isP = tok < NTP; const int t = isP ? (tok & 2047) : 2048;
        const f32x2 cs = rope[t * 64 + lane];
        bf16_t* pr = proj + (size_t)tok * PO_MAIN;
#pragma unroll
        for (int h = 0; h < 4; ++h) {
            { bf16_t* q = pr + O_QD + h * 128; const float x1 = bf1(q[lane]), x2 = bf1(q[64 + lane]);
              const unsigned o = pk2(x1 * cs.x - x2 * cs.y, x1 * cs.y + x2 * cs.x); q[lane] = (bf16_t)(o & 0xffffu); q[64 + lane] = (bf16_t)(o >> 16); }
            { bf16_t* k = pr + O_KD + h * 128; const float x1 = bf1(k[lane]) * 0.08838834764831845f, x2 = bf1(k[64 + lane]) * 0.08838834764831845f;
              const unsigned o = pk2(x1 * cs.x - x2 * cs.y, x1 * cs.y + x2 * cs.x); k[lane] = (bf16_t)(o & 0xffffu); k[64 + lane] = (bf16_t)(o >> 16); }
        }
    }
}

template <bool GLA> __device__ __forceinline__ void odd_sample_item(KP P, int idx, int lane) {
    const int si = idx >> 2, h = idx & 3, tok = NTP + si;
    const float* Sin = P->in[GLA ? 9 : 10] + (size_t)idx * 128 * 256; float* Sout = P->out + (GLA ? OUT_SGLA : OUT_SRET) + (size_t)idx * 128 * 256;
    const bf16_t* pr = WSP(bf16_t, WS_PROJ) + (size_t)tok * PO_MAIN;
    const unsigned kpk = *(const unsigned*)(pr + (GLA ? O_KC : O_KD) + h * 128 + 2 * lane), qpk = *(const unsigned*)(pr + (GLA ? O_QC : O_QD) + h * 128 + 2 * lane);
    const u32x2 vpk = *(const u32x2*)(pr + (GLA ? O_VC : O_VD) + h * 256 + 4 * lane);
    const f32x4 v = {bflo(vpk.x), bfhi(vpk.x), bflo(vpk.y), bfhi(vpk.y)};
    const float gam = 1.f - exp2f(-5.f - (float)h);
    f32x2 alp = {gam, gam};
    if (GLA) alp = *(const f32x2*)(WSP(float, WS_ALPHA) + (size_t)tok * 512 + h * 128 + 2 * lane);
    f32x4 o = {0.f, 0.f, 0.f, 0.f};
#pragma unroll 8
    for (int d2 = 0; d2 < 64; ++d2) { const unsigned ku = rdlu(kpk, d2), qu = rdlu(qpk, d2); const float a0 = rdl(alp.x, d2), a1 = rdl(alp.y, d2);
        const f32x4 s0 = *(const f32x4*)(Sin + (size_t)(2 * d2) * 256 + 4 * lane), s1 = *(const f32x4*)(Sin + (size_t)(2 * d2 + 1) * 256 + 4 * lane);
        const f32x4 n0 = s0 * a0 + v * bflo(ku), n1 = s1 * a1 + v * bfhi(ku);
        *(f32x4*)(Sout + (size_t)(2 * d2) * 256 + 4 * lane) = n0; *(f32x4*)(Sout + (size_t)(2 * d2 + 1) * 256 + 4 * lane) = n1;
        o += n0 * bflo(qu) + n1 * bfhi(qu); }
    if (GLA) o *= 0.08838834764831845f;
    u32x2 op; op.x = pk2(o.x, o.y); op.y = pk2(o.z, o.w);
    *(u32x2*)(WSP(bf16_t, WS_Y) + (size_t)tok * 2048 + (GLA ? 0 : 1024) + h * 256 + 4 * lane) = op;
}

__device__ __forceinline__ void phase_rec_odd(KP P, const Ctx& C) {
    const int lane = C.lane;
    { const int slot = C.bid * 4 + (C.wave & 3), nslot = C.nblk * 4;
        if (C.wave < 4) { for (int g = slot; g < 1024; g += nslot) rec_item<2, 8, 8>(P, g, lane); }
        else { for (int g = slot; g < 1024; g += nslot) rec_item<3, 8, 8>(P, g, lane); } }
    unsigned* ctr = WSP(unsigned, WS_CTL) + 64;
    for (;;) {
        int idx = 0; if (lane == 0) idx = (int)atomicAdd(ctr, 1u);
        idx = __builtin_amdgcn_readfirstlane(idx);
        if (idx >= 1024) break;
        if (idx < 512) odd_sample_item<true>(P, idx, lane); else odd_sample_item<false>(P, idx - 512, lane);
    }
}

__device__ __forceinline__ void phase_post_odd(KP P, const Ctx& C) {
    bf16_t* Y = WSP(bf16_t, WS_Y); const bf16_t* proj = WSP(bf16_t, WS_PROJ); const int lane = C.lane;
    for (int tok = C.gw; tok < NTOK; tok += C.ngw) {
#pragma unroll
        for (int i = 0; i < 4; ++i) { const int ch0 = i * 512 + lane * 8; float o[8], z[8], y[8];
            unpack8(*(const u32x4*)(Y + (size_t)tok * 2048 + ch0), o); unpack8(*(const u32x4*)(proj + (size_t)tok * PO_MAIN + O_Z + ch0), z);
            float ss = 0.f;
#pragma unroll
            for (int e = 0; e < 8; ++e) ss += o[e] * o[e];
            ss = ar32(ss); const float rs = rsqrtf(ss * (1.f / 256.f) + EPS); const float* w = P->in[i < 2 ? 26 : 27] + (ch0 & 255);
#pragma unroll
            for (int e = 0; e < 8; ++e) y[e] = o[e] * rs * w[e] * siluf_(z[e]);
            *(u32x4*)(Y + (size_t)tok * 2048 + ch0) = pack8(y);
        }
    }
}

__device__ __forceinline__ void phase_final(KP P, const Ctx& C) {
    const float* fw = P->in[28];
    for (int tok = C.gw; tok < NTOK; tok += C.ngw) {
        float* xr = P->out + (size_t)tok * DM; f32x4 v[4]; float ss = 0.f;
#pragma unroll
        for (int j = 0; j < 4; ++j) { v[j] = ((const f32x4*)xr)[C.lane + 64 * j]; ss += v[j].x * v[j].x + v[j].y * v[j].y + v[j].z * v[j].z + v[j].w * v[j].w; }
        ss = ar64(ss); const float rstd = rsqrtf(ss * (1.f / 1024.f) + EPS);
#pragma unroll
        for (int j = 0; j < 4; ++j) { const int idx = (C.lane + 64 * j) * 4; ((f32x4*)xr)[C.lane + 64 * j] = v[j] * rstd * *(const f32x4*)(fw + idx); }
    }
}

__device__ __forceinline__ void sample_outproj(KP P, const Ctx& C, int layer) {
    const bf16_t* Y = WSP(bf16_t, WS_Y) + (size_t)NTP * 2048; const bf16_t* W = WSP(bf16_t, layer == 0 ? WS_WOUT0 : WS_WOUT1);
    const float* mod = WSP(float, WS_MOD); LAS float* red = (LAS float*)C.lds;
    const int lane = C.lane, w = C.wave;
    for (int task = C.bid; task < 256; task += C.nblk) {
        const int r0 = (task >> 5) * 16, c0 = (task & 31) * 32;
        f32x4 acc0 = {0.f, 0.f, 0.f, 0.f}, acc1 = acc0;
        const bf16_t* ap = Y + (size_t)(r0 + (lane & 15)) * 2048 + w * 256 + (lane >> 4) * 8;
        const bf16_t* bp0 = W + (size_t)(c0 + (lane & 15)) * 2048 + w * 256 + (lane >> 4) * 8; const bf16_t* bp1 = bp0 + (size_t)16 * 2048;
#pragma unroll
        for (int ks = 0; ks < 8; ++ks) { const bf16x8 a = *(const bf16x8*)(ap + ks * 32), b0 = *(const bf16x8*)(bp0 + ks * 32), b1 = *(const bf16x8*)(bp1 + ks * 32);
            acc0 = __builtin_amdgcn_mfma_f32_16x16x32_bf16(a, b0, acc0, 0, 0, 0); acc1 = __builtin_amdgcn_mfma_f32_16x16x32_bf16(a, b1, acc1, 0, 0, 0); }
        __syncthreads();
        *(LAS f32x4*)(red + ((w * 2 + 0) * 64 + lane) * 4) = acc0; *(LAS f32x4*)(red + ((w * 2 + 1) * 64 + lane) * 4) = acc1;
        __syncthreads();
        { const int e = C.tid, tile = e >> 8, idx = e & 255, ln = idx >> 2, j = idx & 3; float sum = 0.f;
#pragma unroll
          for (int ww = 0; ww < 8; ++ww) sum += red[((ww * 2 + tile) * 64 + ln) * 4 + j];
          const int row = r0 + (ln >> 4) * 4 + j, col = c0 + tile * 16 + (ln & 15);
          const float xin = layer == 0 ? P->in[1][(size_t)row * DM + col] : P->out[(size_t)(NTP + row) * DM + col];
          const float gt = mod[(size_t)(8 + row) * 6144 + layer * 3072 + 2048 + col];
          P->out[(size_t)(NTP + row) * DM + col] = xin + gt * sum; }
    }
    __syncthreads();
}

#define XB_XCNT(j)  (256  + 64 * (j))
#define XB_XSUB(j)  (1280 + 64 * (j))
#define XB_XGEN(j)  (2304 + 64 * (j))
#define XB_TOP      3328
#define XB_TOPGEN   3392
__device__ __forceinline__ unsigned xb_ld(unsigned* p) { return __hip_atomic_load(p, __ATOMIC_RELAXED, __HIP_MEMORY_SCOPE_AGENT); }
__device__ __forceinline__ unsigned xb_add(unsigned* p, unsigned v) { return __hip_atomic_fetch_add(p, v, __ATOMIC_RELAXED, __HIP_MEMORY_SCOPE_AGENT); }
__device__ __forceinline__ unsigned xb_xcc_id() { return (unsigned)__builtin_amdgcn_s_getreg((3 << 11) | 20) & 0xFu; }
__device__ __forceinline__ void xcd_bar(unsigned* bar, volatile unsigned* st) {
    asm volatile("s_waitcnt vmcnt(0)" ::: "memory");
    __syncthreads();
    if (threadIdx.x == 0) {
        __builtin_amdgcn_s_waitcnt(0);
        const unsigned x = xb_xcc_id();
        unsigned nloc = st[0], nx = st[1];
        if (nloc == 0u) {
            unsigned cnt, mine, sum;
            for (;;) { cnt = 0u; mine = 0u; sum = 0u;
#pragma unroll
                for (unsigned j = 0; j < 16; ++j) { const unsigned c = xb_ld(&bar[XB_XCNT(j)]); sum += c; cnt += (c > 0u) ? 1u : 0u; mine = (j == x) ? c : mine; }
                if (sum == gridDim.x) break;
                __builtin_amdgcn_s_sleep(1); }
            nloc = mine > 0u ? mine : 1u; nx = cnt > 0u ? cnt : 1u; st[0] = nloc; st[1] = nx;
        }
        const unsigned old = xb_add(&bar[XB_XSUB(x)], 1u);
        const unsigned gen = old / nloc;
        if (old + 1u == (gen + 1u) * nloc) {
            __builtin_amdgcn_fence(__ATOMIC_RELEASE, "agent");
            asm volatile("s_waitcnt vmcnt(0)" ::: "memory");
            const unsigned og = xb_add(&bar[XB_TOP], 1u);
            const unsigned tg = og / nx;
            if (og + 1u == (tg + 1u) * nx) xb_add(&bar[XB_TOPGEN], 1u);
            else { while (xb_ld(&bar[XB_TOPGEN]) == tg) __builtin_amdgcn_s_sleep(1); }
            __builtin_amdgcn_fence(__ATOMIC_ACQUIRE, "agent");
            xb_add(&bar[XB_XGEN(x)], 1u);
            asm volatile("s_waitcnt vmcnt(0)" ::: "memory");
        } else {
            while (xb_ld(&bar[XB_XGEN(x)]) == gen) __builtin_amdgcn_s_sleep(1);
            __builtin_amdgcn_fence(__ATOMIC_ACQUIRE, "agent");
            asm volatile("s_waitcnt vmcnt(0)" ::: "memory");
        }
    }
    __syncthreads();
}

#ifndef PH_MASK
#define PH_MASK 0x7fff
#endif
#define PH_ON(n) (((PH_MASK) >> (n)) & 1)
#ifndef PH_REP
#define PH_REP 0
#endif
#define PH_RP(n) (((PH_REP) >> (n)) & 1)
constexpr int NPHASE = 15;
__global__ void __launch_bounds__(512, 2) fwd_megakernel(Params PV) {
    extern __shared__ __attribute__((aligned(16))) unsigned char shm[];
    __shared__ __attribute__((aligned(16))) unsigned xb_st[4];
    Ctx C; C.lds = (LAS unsigned char*)shm;
    if (threadIdx.x == 0) { xb_st[0] = 0u; xb_st[1] = 0u; if (PV.ph_hi - PV.ph_lo > 1) (void)xb_add(((unsigned*)PV.ws) + XB_XCNT(xb_xcc_id()), 1u); }
    __syncthreads();
    for (int ph = PV.ph_lo; ph < PV.ph_hi; ++ph) {
        KP P = (KP)__builtin_amdgcn_kernarg_segment_ptr(); asm volatile("" : "+s"(P));
        { int tid = threadIdx.x; asm volatile("" : "+v"(tid)); int bid = blockIdx.x; asm volatile("" : "+s"(bid)); int nblk = gridDim.x; asm volatile("" : "+s"(nblk));
          C.tid = tid; C.bid = bid; C.nblk = nblk; C.lane = tid & 63; C.wave = __builtin_amdgcn_readfirstlane(tid >> 6); C.gw = bid * 8 + C.wave; C.ngw = nblk * 8; }
        const bool is_gemm = (ph == 1 || ph == 3 || ph == 7 || ph == 9 || ph == 13);
        if (is_gemm && PH_ON(1)) {
            pg8::Gemm g; pg8::Epi E; E.kind = 0; E.mod = WSP(float, WS_MOD); E.ada_b = P->in[12]; E.P = WSP(bf16_t, WS_PROJ); E.ldp = PE_MAIN; E.ntile_main = 32; E.G = WSP(float, WS_GATES); E.ng = 32;
            E.xp = P->in[0]; E.xs = P->in[1]; E.xo = P->out; E.gate = WSP(float, WS_MOD); E.layer = 0;
            if (ph == 1) { g.A = WSP(bf16_t, WS_CBF); g.Bt = WSP(bf16_t, WS_ADAT); g.M = 256; g.N = 6144; g.K = 1024; E.kind = 0; }
            else if (ph == 3) { g.A = DOP(bf16_t, DO_HBUF); g.Bt = WSP(bf16_t, WS_WIN0); g.M = MPAD; g.N = PE_PAD; g.K = 1024; E.kind = 1; }
            else if (ph == 7) { g.A = WSP(bf16_t, WS_Y); g.Bt = WSP(bf16_t, WS_WOUT0); g.M = NTP; g.N = 1024; g.K = 2048; E.kind = 2; E.layer = 0; }
            else if (ph == 9) { g.A = DOP(bf16_t, DO_HBUF); g.Bt = WSP(bf16_t, WS_WIN1); g.M = MPAD; g.N = PO_PAD; g.K = 1024; E.kind = 1; E.ldp = PO_MAIN; E.ntile_main = 24; E.ng = 16; }
            else { g.A = WSP(bf16_t, WS_Y); g.Bt = WSP(bf16_t, WS_WOUT1); g.M = NTP; g.N = 1024; g.K = 2048; E.kind = 2; E.layer = 1; }
            pg8::StaticOrder S; S.init(g.M, g.N, C.nblk, C.bid);
            for (int rep = 0; rep < 1 + PH_RP(ph); ++rep) { asm volatile("" : "+s"(rep)); pg8::gemm_phase(C.lds, g, S, E, C.tid); }
            if (E.kind == 2) sample_outproj(P, C, E.layer);
            if (ph == 1) { if (C.nblk > 24) { if (C.bid >= 24) prep_weights(P, C, (C.bid - 24) * 8 + C.wave, (C.nblk - 24) * 8); } else prep_weights(P, C, C.gw, C.ngw); }
        } else {
            switch (ph) {
                case 0: if (PH_ON(0)) phase_prep0(P, C); if (PH_RP(0)) { asm volatile("" : "+s"(P)); phase_prep0(P, C); } break;
                case 2: if (PH_ON(2)) phase_hnorm(P, C, 0); if (PH_RP(2)) { asm volatile("" : "+s"(P)); phase_hnorm(P, C, 0); } break;
                case 4: if (PH_ON(4)) phase_prep_even(P, C); if (PH_RP(4)) { asm volatile("" : "+s"(P)); phase_prep_even(P, C); } break;
                case 5: if (PH_ON(5)) phase_rec_even(P, C); if (PH_RP(5)) { asm volatile("" : "+s"(P)); phase_rec_even(P, C); } break;
                case 6: if (PH_ON(6)) phase_post_even(P, C); break;
                case 8: if (PH_ON(8)) phase_hnorm(P, C, 1); if (PH_RP(8)) { asm volatile("" : "+s"(P)); phase_hnorm(P, C, 1); } break;
                case 10: if (PH_ON(10)) phase_prep_odd(P, C); break;
                case 11: if (PH_ON(11)) phase_rec_odd(P, C); if (PH_RP(11)) { asm volatile("" : "+s"(P)); phase_rec_odd(P, C); } break;
                case 12: if (PH_ON(12)) phase_post_odd(P, C); break;
                case 14: if (PH_ON(14)) phase_final(P, C); break;
                default: break;
            }
        }
        if (ph + 1 < PV.ph_hi) {
            if (PV.ph_lo > 0 && ph == PV.ph_lo) cg::this_grid().sync();
            else xcd_bar(WSP(unsigned, WS_CTL), xb_st);
        }
    }
}

extern "C" void kernel_launch(void* const* d_in, const int* in_sizes, int n_in, void* d_out, int out_size, void* d_ws, size_t ws_size, hipStream_t stream) {
    constexpr size_t kDynLds = 131072;
    static int grid_blocks = 0;
    if (!grid_blocks) {
        if (n_in != 29 || ws_size < WS_END) { fprintf(stderr, "kernel_launch: unexpected n_in %d or ws_size %zu (need %zu)\n", n_in, ws_size, (size_t)WS_END); }
        int dev = 0, cus = 0, per_cu = 0;
        hipGetDevice(&dev);
        hipDeviceGetAttribute(&cus, hipDeviceAttributeMultiprocessorCount, dev);
        hipFuncSetAttribute((const void*)fwd_megakernel, hipFuncAttributeMaxDynamicSharedMemorySize, (int)kDynLds);
        hipOccupancyMaxActiveBlocksPerMultiprocessor(&per_cu, (const void*)fwd_megakernel, 512, kDynLds);
        if (per_cu < 1) { fprintf(stderr, "kernel_launch: occupancy query says %d blocks/CU\n", per_cu); per_cu = 1; }
        if (per_cu > 1) per_cu = 1;
        grid_blocks = cus * per_cu;
        (void)hipGetLastError();
    }
    hipMemsetAsync((char*)d_ws + WS_CTL, 0, 16384, stream);
    Params p{};
    for (int i = 0; i < 29; ++i) p.in[i] = (const float*)d_in[i];
    p.out = (float*)d_out; p.ws = (unsigned char*)d_ws;
#if MK_SPLIT
    for (int ph = 0; ph < NPHASE; ++ph) { p.ph_lo = ph; p.ph_hi = ph + 1;
        hipLaunchKernelGGL(fwd_megakernel, dim3(grid_blocks), dim3(512), kDynLds, stream, p); }
#else
    p.ph_lo = 0; p.ph_hi = NPHASE;
    void* args[] = {&p};
    hipError_t e = hipLaunchCooperativeKernel((const void*)fwd_megakernel, dim3(grid_blocks), dim3(512), args, kDynLds, stream);
    if (e != hipSuccess) fprintf(stderr, "cooperative launch failed: %s (grid %d)\n", hipGetErrorString(e), grid_blocks);
#endif
}
```

```cpp
#include <hip/hip_runtime.h>
#include <hip/hip_cooperative_groups.h>
#include <cstdio>
#include <cstdint>
namespace cg = cooperative_groups;

#ifndef MK_SPLIT
#define MK_SPLIT 0
#endif

#define LAS __attribute__((address_space(3)))
typedef unsigned short bf16_t;
typedef short bf16x8 __attribute__((ext_vector_type(8)));
typedef float f32x4 __attribute__((ext_vector_type(4)));
typedef float f32x2 __attribute__((ext_vector_type(2)));
typedef float f32x3 __attribute__((ext_vector_type(3)));
typedef unsigned u32x4 __attribute__((ext_vector_type(4)));
typedef unsigned u32x2 __attribute__((ext_vector_type(2)));

constexpr int DM = 1024, NTP = 16384, NTS = 128, NTOK = NTP + NTS, MPAD = 16640, TSEQ = 2048;
constexpr int NSEQ = 136;
constexpr float EPS = 1e-6f;
constexpr int PE_MAIN = 8192, PE_PAD = 8448, PO_MAIN = 6144, PO_PAD = 6400;
constexpr int E_QA = 0, E_KA = 1024, E_VA = 2048, E_QB = 3072, E_KB = 3584, E_VB = 4096, E_OP = 5120, E_Z = 6144;
constexpr int O_QC = 0, O_KC = 512, O_VC = 1024, O_QD = 2048, O_KD = 2560, O_VD = 3072, O_Z = 4096;
constexpr size_t OUT_Y = 0, OUT_PGDN = 16908288, OUT_PCONV = 17956864, OUT_PMC = 18030592, OUT_PMN = 18554880, OUT_PMM = 18558976,
                 OUT_PGLA = 18559040, OUT_PRET = 19607616, OUT_SGDN = 20656192, OUT_SCONV = 37433408, OUT_SMC = 38613056,
                 OUT_SMN = 47001664, OUT_SMM = 47067200, OUT_SGLA = 47068224, OUT_SRET = 63845440;
constexpr size_t WS_CTL = 0, WS_WIN0 = 16384, WS_WOUT0 = WS_WIN0 + (size_t)PE_PAD * 1024 * 2, WS_WIN1 = WS_WOUT0 + (size_t)1024 * 2048 * 2,
                 WS_WOUT1 = WS_WIN1 + (size_t)PO_PAD * 1024 * 2, WS_ADAT = WS_WOUT1 + (size_t)1024 * 2048 * 2, WS_CBF = WS_ADAT + (size_t)6144 * 1024 * 2,
                 WS_MOD = WS_CBF + (size_t)256 * 1024 * 2, WS_ROPE = WS_MOD + (size_t)NSEQ * 6144 * 4, WS_GATES = WS_ROPE + 1049600,
                 WS_GA = WS_GATES + (size_t)NTOK * 32 * 4, WS_GB = WS_GA + (size_t)NTOK * 32 * 4, WS_PROJ = WS_GB + (size_t)NTOK * 32 * 4,
                 WS_Y = WS_PROJ + (size_t)NTOK * PE_MAIN * 2, WS_END = WS_Y + (size_t)MPAD * 2048 * 2;
constexpr size_t WS_ALPHA = WS_PROJ + (size_t)NTOK * PO_MAIN * 2;
constexpr size_t DO_ABUF = OUT_SGLA * 4;
constexpr size_t DO_HBUF = OUT_SRET * 4 + (size_t)67108864 - (size_t)MPAD * 1024 * 2;

struct Params {
    const float* in[29];
    float* out;
    unsigned char* ws;
    int ph_lo, ph_hi;
};

__device__ __forceinline__ float bflo(unsigned u) { return __uint_as_float(u << 16); }
__device__ __forceinline__ float bfhi(unsigned u) { return __uint_as_float(u & 0xffff0000u); }
__device__ __forceinline__ float bf1(bf16_t b) { return __uint_as_float(((unsigned)b) << 16); }
__device__ __forceinline__ unsigned pk2(float lo, float hi) { unsigned r; asm("v_cvt_pk_bf16_f32 %0, %1, %2" : "=v"(r) : "v"(lo), "v"(hi)); return r; }
__device__ __forceinline__ void unpack8(u32x4 p, float* f) {
    f[0] = bflo(p.x); f[1] = bfhi(p.x); f[2] = bflo(p.y); f[3] = bfhi(p.y); f[4] = bflo(p.z); f[5] = bfhi(p.z); f[6] = bflo(p.w); f[7] = bfhi(p.w);
}
__device__ __forceinline__ u32x4 pack8(const float* f) { u32x4 o; o.x = pk2(f[0], f[1]); o.y = pk2(f[2], f[3]); o.z = pk2(f[4], f[5]); o.w = pk2(f[6], f[7]); return o; }
template <int CTRL> __device__ __forceinline__ float dppf(float x) { return __int_as_float(__builtin_amdgcn_update_dpp(0, __float_as_int(x), CTRL, 0xf, 0xf, true)); }
__device__ __forceinline__ float ar4(float x) { x += dppf<0xB1>(x); x += dppf<0x4E>(x); return x; }
__device__ __forceinline__ float ar8(float x) { x = ar4(x); x += dppf<0x141>(x); return x; }
__device__ __forceinline__ void ar8x4(float& a, float& b, float& c, float& d) {
    asm volatile(
        "s_nop 1\n\t"
        "v_add_f32_dpp %0, %0, %0 quad_perm:[1,0,3,2] row_mask:0xf bank_mask:0xf bound_ctrl:1\n\t"
        "v_add_f32_dpp %1, %1, %1 quad_perm:[1,0,3,2] row_mask:0xf bank_mask:0xf bound_ctrl:1\n\t"
        "v_add_f32_dpp %2, %2, %2 quad_perm:[1,0,3,2] row_mask:0xf bank_mask:0xf bound_ctrl:1\n\t"
        "v_add_f32_dpp %3, %3, %3 quad_perm:[1,0,3,2] row_mask:0xf bank_mask:0xf bound_ctrl:1\n\t"
        "v_add_f32_dpp %0, %0, %0 quad_perm:[2,3,0,1] row_mask:0xf bank_mask:0xf bound_ctrl:1\n\t"
        "v_add_f32_dpp %1, %1, %1 quad_perm:[2,3,0,1] row_mask:0xf bank_mask:0xf bound_ctrl:1\n\t"
        "v_add_f32_dpp %2, %2, %2 quad_perm:[2,3,0,1] row_mask:0xf bank_mask:0xf bound_ctrl:1\n\t"
        "v_add_f32_dpp %3, %3, %3 quad_perm:[2,3,0,1] row_mask:0xf bank_mask:0xf bound_ctrl:1\n\t"
        "v_add_f32_dpp %0, %0, %0 row_half_mirror row_mask:0xf bank_mask:0xf bound_ctrl:1\n\t"
        "v_add_f32_dpp %1, %1, %1 row_half_mirror row_mask:0xf bank_mask:0xf bound_ctrl:1\n\t"
        "v_add_f32_dpp %2, %2, %2 row_half_mirror row_mask:0xf bank_mask:0xf bound_ctrl:1\n\t"
        "v_add_f32_dpp %3, %3, %3 row_half_mirror row_mask:0xf bank_mask:0xf bound_ctrl:1\n\t"
        : "+v"(a), "+v"(b), "+v"(c), "+v"(d));
}
__device__ __forceinline__ void ar16x4(float& a, float& b, float& c, float& d) {
    asm volatile(
        "s_nop 1\n\t"
        "v_add_f32_dpp %0, %0, %0 quad_perm:[1,0,3,2] row_mask:0xf bank_mask:0xf bound_ctrl:1\n\t"
        "v_add_f32_dpp %1, %1, %1 quad_perm:[1,0,3,2] row_mask:0xf bank_mask:0xf bound_ctrl:1\n\t"
        "v_add_f32_dpp %2, %2, %2 quad_perm:[1,0,3,2] row_mask:0xf bank_mask:0xf bound_ctrl:1\n\t"
        "v_add_f32_dpp %3, %3, %3 quad_perm:[1,0,3,2] row_mask:0xf bank_mask:0xf bound_ctrl:1\n\t"
        "v_add_f32_dpp %0, %0, %0 quad_perm:[2,3,0,1] row_mask:0xf bank_mask:0xf bound_ctrl:1\n\t"
        "v_add_f32_dpp %1, %1, %1 quad_perm:[2,3,0,1] row_mask:0xf bank_mask:0xf bound_ctrl:1\n\t"
        "v_add_f32_dpp %2, %2, %2 quad_perm:[2,3,0,1] row_mask:0xf bank_mask:0xf bound_ctrl:1\n\t"
        "v_add_f32_dpp %3, %3, %3 quad_perm:[2,3,0,1] row_mask:0xf bank_mask:0xf bound_ctrl:1\n\t"
        "v_add_f32_dpp %0, %0, %0 row_half_mirror row_mask:0xf bank_mask:0xf bound_ctrl:1\n\t"
        "v_add_f32_dpp %1, %1, %1 row_half_mirror row_mask:0xf bank_mask:0xf bound_ctrl:1\n\t"
        "v_add_f32_dpp %2, %2, %2 row_half_mirror row_mask:0xf bank_mask:0xf bound_ctrl:1\n\t"
        "v_add_f32_dpp %3, %3, %3 row_half_mirror row_mask:0xf bank_mask:0xf bound_ctrl:1\n\t"
        "v_add_f32_dpp %0, %0, %0 row_mirror row_mask:0xf bank_mask:0xf bound_ctrl:1\n\t"
        "v_add_f32_dpp %1, %1, %1 row_mirror row_mask:0xf bank_mask:0xf bound_ctrl:1\n\t"
        "v_add_f32_dpp %2, %2, %2 row_mirror row_mask:0xf bank_mask:0xf bound_ctrl:1\n\t"
        "v_add_f32_dpp %3, %3, %3 row_mirror row_mask:0xf bank_mask:0xf bound_ctrl:1\n\t"
        : "+v"(a), "+v"(b), "+v"(c), "+v"(d));
}
__device__ __forceinline__ void ar16x2(float& a, float& b) {
    asm volatile(
        "s_nop 1\n\t"
        "v_add_f32_dpp %0, %0, %0 quad_perm:[1,0,3,2] row_mask:0xf bank_mask:0xf bound_ctrl:1\n\t"
        "v_add_f32_dpp %1, %1, %1 quad_perm:[1,0,3,2] row_mask:0xf bank_mask:0xf bound_ctrl:1\n\t"
        "s_nop 0\n\t"
        "v_add_f32_dpp %0, %0, %0 quad_perm:[2,3,0,1] row_mask:0xf bank_mask:0xf bound_ctrl:1\n\t"
        "v_add_f32_dpp %1, %1, %1 quad_perm:[2,3,0,1] row_mask:0xf bank_mask:0xf bound_ctrl:1\n\t"
        "s_nop 0\n\t"
        "v_add_f32_dpp %0, %0, %0 row_half_mirror row_mask:0xf bank_mask:0xf bound_ctrl:1\n\t"
        "v_add_f32_dpp %1, %1, %1 row_half_mirror row_mask:0xf bank_mask:0xf bound_ctrl:1\n\t"
        "s_nop 0\n\t"
        "v_add_f32_dpp %0, %0, %0 row_mirror row_mask:0xf bank_mask:0xf bound_ctrl:1\n\t"
        "v_add_f32_dpp %1, %1, %1 row_mirror row_mask:0xf bank_mask:0xf bound_ctrl:1\n\t"
        : "+v"(a), "+v"(b));
}
__device__ __forceinline__ float ar16(float x) { x = ar8(x); x += dppf<0x140>(x); return x; }
__device__ __forceinline__ float ar32(float x) { x = ar16(x); x += __shfl_xor(x, 16); return x; }
__device__ __forceinline__ float ar64(float x) { x = ar32(x); x += __shfl_xor(x, 32); return x; }
__device__ __forceinline__ float sigmoidf_(float x) { return __builtin_amdgcn_rcpf(1.f + __expf(-x)); }
__device__ __forceinline__ float siluf_(float x) { return x * __builtin_amdgcn_rcpf(1.f + __expf(-x)); }
__device__ __forceinline__ float gla_alpha_(float x) { const float t = __expf(-x); const float sp = x < -15.f ? -x : __logf(1.f + t); return __expf(-sp * 0.0625f); }
__device__ __forceinline__ float softplusf_(float x) { return x > 20.f ? x : log1pf(expf(x)); }
__device__ __forceinline__ float rdl(float v, int l) { return __int_as_float(__builtin_amdgcn_readlane(__float_as_int(v), l)); }
__device__ __forceinline__ unsigned rdlu(unsigned v, int l) { return (unsigned)__builtin_amdgcn_readlane((int)v, l); }

__device__ __forceinline__ int map_even(int c) { if (c < 3072) return c; if (c < 5120) return c + 16; if (c < 8192) return c + 32; if (c < 8208) return c - 8192 + 3072; if (c < 8224) return c - 8208 + 5136; return -1; }
__device__ __forceinline__ int map_odd(int c) { if (c < 2048) return c; if (c < 6144) return c + 16; if (c < 6160) return c - 6144 + 2048; return -1; }

namespace pg8 {
constexpr int BM = 256, BK = 64, HALF = 128, HTB = HALF * BK * 2, STAGE_BYTES = 8 * HTB, NXCD = 8, WGM = 8;
__device__ __forceinline__ int lds_byte(int r, int c) { const int st = (r >> 4) * 2 + (c >> 5), rr = r & 15, cc = c & 31, ob = rr * 64 + cc * 2; return st * 1024 + (ob ^ (((ob >> 9) & 1) << 5)); }
__device__ __forceinline__ void stage_rc(int b, int& R, int& C) { const int st = b / 1024, sb = b % 1024, swz = sb ^ (((sb >> 9) & 1) << 5); R = (st >> 1) * 16 + swz / 64; C = (st & 1) * 32 + (swz % 64) / 2; }
struct Unit { int pm, pn; };
struct Gemm { const bf16_t* A; const bf16_t* Bt; int M, N, K; };
struct StaticOrder {
    int nM, nN, nwg, G, c;
    __device__ void init(int M, int N, int G_, int c_) { nM = M / BM; nN = N / BM; nwg = nM * nN; G = G_; c = c_; }
    __device__ bool next(int i, Unit& u) const {
        const long L = (long)i * G + c; if (L >= nwg) return false;
        int wgid = (int)L; { const int q = nwg / NXCD, r = nwg % NXCD, xcd = wgid % NXCD, off = wgid / NXCD; wgid = (xcd < r ? xcd * (q + 1) : r * (q + 1) + (xcd - r) * q) + off; }
        const int nig = WGM * nN, gid = wgid / nig, fm = gid * WGM, gsz = (nM - fm) < WGM ? (nM - fm) : WGM;
        u.pm = fm + ((wgid % nig) % gsz); u.pn = (wgid % nig) / gsz; return true;
    }
};

struct Epi {
    int kind;
    float* mod; const float* ada_b;
    bf16_t* P; int ldp; int ntile_main; float* G; int ng;
    const float* xp; const float* xs; float* xo; const float* gate; int layer;
    __device__ __forceinline__ void operator()(const f32x4 (&acc)[2][2][4][2], const Unit& u, int wr, int wc, int fr, int fq) const {
        const int row0 = u.pm * BM + wr * 64 + fr;
        const int col0 = u.pn * BM + wc * 32 + 8 * fq;
        if (kind == 0) {
#pragma unroll
            for (int ai = 0; ai < 2; ++ai)
#pragma unroll
                for (int m = 0; m < 4; ++m) { const int row = row0 + ai * HALF + m * 16;
                    if (row < NSEQ) {
#pragma unroll
                        for (int bj = 0; bj < 2; ++bj)
#pragma unroll
                            for (int n = 0; n < 2; ++n) { const int c = col0 + bj * HALF + n * 4; const f32x4 b = *(const f32x4*)(ada_b + c);
                                *(f32x4*)(mod + (size_t)row * 6144 + c) = acc[ai][bj][m][n] + b; } } }
        } else if (kind == 1) {
            if (u.pn < ntile_main) {
#pragma unroll
                for (int ai = 0; ai < 2; ++ai)
#pragma unroll
                    for (int m = 0; m < 4; ++m) { const int row = row0 + ai * HALF + m * 16;
                        if (row < NTOK) { bf16_t* rowp = P + (size_t)row * ldp + col0;
#pragma unroll
                            for (int bj = 0; bj < 2; ++bj) { const f32x4 v0 = acc[ai][bj][m][0], v1 = acc[ai][bj][m][1]; u32x4 o;
                                o.x = pk2(v0[0], v0[1]); o.y = pk2(v0[2], v0[3]); o.z = pk2(v1[0], v1[1]); o.w = pk2(v1[2], v1[3]);
                                *(u32x4*)(rowp + bj * HALF) = o; } } }
            } else {
#pragma unroll
                for (int ai = 0; ai < 2; ++ai)
#pragma unroll
                    for (int m = 0; m < 4; ++m) { const int row = row0 + ai * HALF + m * 16;
#pragma unroll
                        for (int bj = 0; bj < 2; ++bj)
#pragma unroll
                            for (int n = 0; n < 2; ++n) { const int c = bj * HALF + wc * 32 + 8 * fq + 4 * n;
                                if (row < NTOK && c < ng) *(f32x4*)(G + (size_t)row * ng + c) = acc[ai][bj][m][n]; } }
            }
        } else {
#pragma unroll
            for (int ai = 0; ai < 2; ++ai)
#pragma unroll
                for (int m = 0; m < 4; ++m) { const int row = row0 + ai * HALF + m * 16;
                    if (row < NTOK) {
                        const int seq = row < NTP ? (row >> 11) : (8 + row - NTP);
                        const float* xin = layer == 0 ? (row < NTP ? xp + (size_t)row * DM : xs + (size_t)(row - NTP) * DM) : xo + (size_t)row * DM;
                        const float* gp = gate + (size_t)seq * 6144 + layer * 3072 + 2048;
                        float* xw = xo + (size_t)row * DM;
#pragma unroll
                        for (int bj = 0; bj < 2; ++bj)
#pragma unroll
                            for (int n = 0; n < 2; ++n) { const int c = col0 + bj * HALF + n * 4;
                                const f32x4 xv = *(const f32x4*)(xin + c), gv = *(const f32x4*)(gp + c);
                                *(f32x4*)(xw + c) = xv + gv * acc[ai][bj][m][n]; } } }
        }
    }
};

__device__ __forceinline__ void gemm_phase(LAS unsigned char* lds, const Gemm g, const StaticOrder& S, const Epi& E, const int tid) {
    const int wid = __builtin_amdgcn_readfirstlane(tid >> 6), lane = tid & 63, wr = wid >> 2, wc = wid & 3, fr = lane & 15, fq = lane >> 4;
    const int K = g.K, nt = K / BK;
    unsigned voffA[2], voffB[2];
#pragma unroll
    for (int i = 0; i < 2; ++i) { int R, C; stage_rc(tid * 16 + i * 8192, R, C); voffA[i] = (unsigned)(R * K + C) * 2u;
        const int rho = R & 31, Rb = (R & ~31) + 8 * ((rho & 15) >> 2) + 4 * (rho >> 4) + (rho & 3);
        voffB[i] = (unsigned)(Rb * K + C) * 2u; }
    const size_t kstep = (size_t)(BK * 2);
    const size_t hstep = (size_t)HALF * K * 2;
    const size_t tstep = 2 * hstep;
    const unsigned ldsw = (unsigned)wid * 1024u;
    const int aoff = lds_byte(wr * 64 + fr, fq * 8), boff = lds_byte(wc * 32 + fr, fq * 8);
#define PG8_SA(b, h) (((b) * 2 + (h)) * HTB)
#define PG8_SB(b, h) ((4 + (b) * 2 + (h)) * HTB)
#define PG8_STAGE(bufoff, gbase, voff) do { _Pragma("unroll") for (int _i = 0; _i < 2; ++_i) \
        __builtin_amdgcn_global_load_lds((const unsigned*)((const char*)(gbase) + (voff)[_i]), (LAS unsigned*)(lds + (bufoff) + ldsw + _i * 8192), 16, 0, 0); } while (0)
#define PG8_LDA(dst, b, h) do { _Pragma("unroll") for (int m = 0; m < 4; ++m) _Pragma("unroll") for (int k = 0; k < 2; ++k) dst[m][k] = *(const LAS bf16x8*)(lds + PG8_SA(b, h) + aoff + m * 2048 + k * 1024); } while (0)
#define PG8_LDB(dst, b, h) do { _Pragma("unroll") for (int n = 0; n < 2; ++n) _Pragma("unroll") for (int k = 0; k < 2; ++k) dst[n][k] = *(const LAS bf16x8*)(lds + PG8_SB(b, h) + boff + n * 2048 + k * 1024); } while (0)
#define PG8_MMA(ai, bj, At, Bt) do { __builtin_amdgcn_s_setprio(1); _Pragma("unroll") for (int m = 0; m < 4; ++m) _Pragma("unroll") for (int n = 0; n < 2; ++n) _Pragma("unroll") for (int k = 0; k < 2; ++k) \
        acc[ai][bj][m][n] = __builtin_amdgcn_mfma_f32_16x16x32_bf16(Bt[n][k], At[m][k], acc[ai][bj][m][n], 0, 0, 0); __builtin_amdgcn_s_setprio(0); } while (0)
#define PG8_WAIT_V(n) asm volatile("s_waitcnt vmcnt(" #n ")" ::: "memory")
#define PG8_WAIT_L(n) asm volatile("s_waitcnt lgkmcnt(" #n ")" ::: "memory")
#define PG8_BAR __builtin_amdgcn_s_barrier()
#define PG8_SCHED __builtin_amdgcn_sched_barrier(0)
    Unit cur, nxt; int ui = 0;
    if (!S.next(0, cur)) return;
    f32x4 acc[2][2][4][2];
#pragma unroll
    for (int a = 0; a < 2; ++a)
#pragma unroll
        for (int b = 0; b < 2; ++b)
#pragma unroll
            for (int m = 0; m < 4; ++m)
#pragma unroll
                for (int n = 0; n < 2; ++n) acc[a][b][m][n] = (f32x4){0.f, 0.f, 0.f, 0.f};
    bf16x8 At[4][2], B0[2][2], B1[2][2];
    const char* cA = (const char*)g.A + (size_t)cur.pm * tstep; const char* cB = (const char*)g.Bt + (size_t)cur.pn * tstep;
    PG8_STAGE(PG8_SB(0, 0), cB, voffB); PG8_STAGE(PG8_SB(0, 1), cB + hstep, voffB); PG8_STAGE(PG8_SA(0, 0), cA, voffA); PG8_STAGE(PG8_SA(0, 1), cA + hstep, voffA);
    if (wr == 1) PG8_BAR;
    PG8_WAIT_V(2); PG8_BAR;
    PG8_STAGE(PG8_SB(1, 0), cB + kstep, voffB); PG8_STAGE(PG8_SA(1, 0), cA + kstep, voffA); PG8_STAGE(PG8_SB(1, 1), cB + hstep + kstep, voffB);
    PG8_WAIT_V(6); PG8_BAR;
    for (;;) {
        const bool has_next = S.next(ui + 1, nxt);
        const char* nA = has_next ? (const char*)g.A + (size_t)nxt.pm * tstep : cA; const char* nB = has_next ? (const char*)g.Bt + (size_t)nxt.pn * tstep : cB;
        for (int t = 0; t < nt; t += 2) {
            const bool last = (t == nt - 2);
            const char* a1 = cA + (size_t)(t + 1) * kstep;
            const char* a2 = last ? nA : cA + (size_t)(t + 2) * kstep; const char* b2 = last ? nB : cB + (size_t)(t + 2) * kstep;
            const char* a3 = a2 + kstep; const char* b3 = b2 + kstep;
            PG8_LDB(B0, 0, 0); PG8_LDB(B1, 0, 1); PG8_SCHED; PG8_LDA(At, 0, 0); PG8_STAGE(PG8_SA(1, 1), a1 + hstep, voffA);
            PG8_WAIT_V(8); PG8_WAIT_L(0); PG8_BAR; PG8_MMA(0, 0, At, B0); PG8_MMA(0, 1, At, B1); PG8_BAR; PG8_SCHED;
            PG8_LDA(At, 0, 1); PG8_STAGE(PG8_SB(0, 0), b2, voffB); PG8_STAGE(PG8_SB(0, 1), b2 + hstep, voffB); PG8_STAGE(PG8_SA(0, 0), a2, voffA);
            PG8_WAIT_V(8); PG8_WAIT_L(0); PG8_BAR; PG8_MMA(1, 0, At, B0); PG8_MMA(1, 1, At, B1); PG8_BAR; PG8_SCHED;
            PG8_LDB(B0, 1, 0); PG8_LDB(B1, 1, 1); PG8_SCHED; PG8_LDA(At, 1, 0); PG8_STAGE(PG8_SA(0, 1), a2 + hstep, voffA);
            PG8_WAIT_V(8); PG8_WAIT_L(0); PG8_BAR; PG8_MMA(0, 0, At, B0); PG8_MMA(0, 1, At, B1); PG8_BAR; PG8_SCHED;
            PG8_LDA(At, 1, 1); PG8_STAGE(PG8_SB(1, 0), b3, voffB); PG8_STAGE(PG8_SB(1, 1), b3 + hstep, voffB); PG8_STAGE(PG8_SA(1, 0), a3, voffA);
            PG8_WAIT_V(8); PG8_WAIT_L(0); PG8_BAR; PG8_MMA(1, 0, At, B0); PG8_MMA(1, 1, At, B1); PG8_BAR; PG8_SCHED;
        }
        if (wr == 0) PG8_BAR;
        E(acc, cur, wr, wc, fr, fq);
        if (!has_next) break;
#pragma unroll
        for (int a = 0; a < 2; ++a)
#pragma unroll
            for (int b = 0; b < 2; ++b)
#pragma unroll
                for (int m = 0; m < 4; ++m)
#pragma unroll
                    for (int n = 0; n < 2; ++n) acc[a][b][m][n] = (f32x4){0.f, 0.f, 0.f, 0.f};
        cur = nxt; cA = nA; cB = nB; ++ui;
        if (wr == 1) PG8_BAR;
    }
    PG8_WAIT_V(0);
    PG8_BAR;
#undef PG8_SA
#undef PG8_SB
#undef PG8_STAGE
#undef PG8_LDA
#undef PG8_LDB
#undef PG8_MMA
#undef PG8_WAIT_V
#undef PG8_WAIT_L
#undef PG8_BAR
#undef PG8_SCHED
}
}

typedef const __attribute__((address_space(4))) Params* KP;
struct Ctx {
    int lane, wave, gw, ngw, bid, nblk, tid;
    LAS unsigned char* lds;
};
#define WSP(T, off) ((T*)(P->ws + (off)))
#define DOP(T, off) ((T*)((unsigned char*)P->out + (off)))

__device__ __forceinline__ void transpose_item(const float* W, int ldw, bf16_t* WT, int K, int k0, int n0, int mapkind, LAS float* scr, int lane) {
    const int n = n0 + (lane & 31);
    const int sc = mapkind == 0 ? map_even(n) : (mapkind == 1 ? map_odd(n) : n);
#pragma unroll
    for (int i = 0; i < 32; ++i) { const int kk = 2 * i + (lane >> 5); scr[kk * 33 + (lane & 31)] = sc >= 0 ? W[(size_t)(k0 + kk) * ldw + sc] : 0.f; }
    asm volatile("s_waitcnt lgkmcnt(0)" ::: "memory");
    const int c = lane & 7;
#pragma unroll
    for (int j = 0; j < 4; ++j) { const int nn = (lane >> 3) + 8 * j; const LAS float* s = scr + (8 * c) * 33 + nn;
        u32x4 o; o.x = pk2(s[0 * 33], s[1 * 33]); o.y = pk2(s[2 * 33], s[3 * 33]); o.z = pk2(s[4 * 33], s[5 * 33]); o.w = pk2(s[6 * 33], s[7 * 33]);
        *(u32x4*)(WT + (size_t)(n0 + nn) * K + k0 + 8 * c) = o; }
    asm volatile("s_waitcnt lgkmcnt(0)" ::: "memory");
}

__device__ __forceinline__ void prep_weights(KP P, const Ctx& C, int gw, int ngw) {
    LAS float* scr = (LAS float*)(C.lds + C.wave * 8704);
    constexpr int I_WIN0 = 16 * (PE_PAD / 32), I_WIN1 = 16 * (PO_PAD / 32), I_WOUT = 32 * 32;
    constexpr int NIT = I_WIN0 + I_WIN1 + 2 * I_WOUT;
    for (int it = gw; it < NIT; it += ngw) {
        int r = it;
        if (r < I_WIN0) { const int nb = r % (PE_PAD / 32), kb = r / (PE_PAD / 32); transpose_item(P->in[14], 8224, WSP(bf16_t, WS_WIN0), 1024, kb * 64, nb * 32, 0, scr, C.lane); continue; } r -= I_WIN0;
        if (r < I_WIN1) { const int nb = r % (PO_PAD / 32), kb = r / (PO_PAD / 32); transpose_item(P->in[22], 6160, WSP(bf16_t, WS_WIN1), 1024, kb * 64, nb * 32, 1, scr, C.lane); continue; } r -= I_WIN1;
        if (r < I_WOUT) { const int nb = r % 32, kb = r / 32; transpose_item(P->in[15], 1024, WSP(bf16_t, WS_WOUT0), 2048, kb * 64, nb * 32, 2, scr, C.lane); continue; } r -= I_WOUT;
        { const int nb = r % 32, kb = r / 32; transpose_item(P->in[23], 1024, WSP(bf16_t, WS_WOUT1), 2048, kb * 64, nb * 32, 2, scr, C.lane); }
    }
}
__device__ __forceinline__ void phase_prep0(KP P, const Ctx& C) {
    LAS float* scr = (LAS float*)(C.lds + C.wave * 8704);
    constexpr int I_ADA = 2 * 16 * 96;
    for (int r = C.gw; r < I_ADA; r += C.ngw) {
        const int l = r / (16 * 96), rr = r % (16 * 96), nb = rr % 96, kb = rr / 96;
        transpose_item(P->in[11] + (size_t)l * 1024 * 3072, 3072, WSP(bf16_t, WS_ADAT) + (size_t)l * 3072 * 1024, 1024, kb * 64, nb * 32, 2, scr, C.lane);
    }
    const int gt = C.bid * 512 + C.tid, ngt = C.nblk * 512;
    bf16_t* cbf = WSP(bf16_t, WS_CBF);
    for (int i = gt; i < 256 * 512; i += ngt) { const int row = i >> 9, c2 = (i & 511) * 2; float a = 0.f, b = 0.f;
        if (row < NSEQ) { const float* cp = row < 8 ? P->in[2] + row * 1024 : P->in[3] + (row - 8) * 1024; a = siluf_(cp[c2]); b = siluf_(cp[c2 + 1]); }
        *(unsigned*)(cbf + (size_t)row * 1024 + c2) = pk2(a, b); }
    f32x2* rope = WSP(f32x2, WS_ROPE);
    for (int i = gt; i < 2049 * 64; i += ngt) { const int p = i >> 6, fi = i & 63; const float pos = p < 2048 ? (float)p : 16384.f;
        const float inv = expf(-(float)fi * (1.f / 64.f) * 9.210340371976184f); const float ang = pos * inv;
        const double ad = (double)ang; const double n = rint(ad * 0.15915494309189535); const float rr = (float)(ad - n * 6.283185307179586);
        rope[i] = (f32x2){cosf(rr), sinf(rr)}; }
    unsigned* hz = (unsigned*)(DOP(bf16_t, DO_HBUF) + (size_t)NTOK * 1024);
    for (int i = gt; i < 128 * 512; i += ngt) hz[i] = 0u;
    unsigned* yz = (unsigned*)(WSP(bf16_t, WS_Y) + (size_t)NTOK * 2048);
    for (int i = gt; i < 128 * 1024; i += ngt) yz[i] = 0u;
}

__device__ __forceinline__ void phase_hnorm(KP P, const Ctx& C, int layer) {
    const float* mod = WSP(float, WS_MOD); const float* nw = P->in[13] + layer * 1024; bf16_t* hb = DOP(bf16_t, DO_HBUF);
    for (int tok = C.gw; tok < NTOK; tok += C.ngw) {
        const float* xr = layer == 0 ? (tok < NTP ? P->in[0] + (size_t)tok * DM : P->in[1] + (size_t)(tok - NTP) * DM) : P->out + (size_t)tok * DM;
        const int seq = tok < NTP ? (tok >> 11) : (8 + tok - NTP);
        const float* md = mod + (size_t)seq * 6144 + layer * 3072;
        f32x4 v[4]; float ss = 0.f;
#pragma unroll
        for (int j = 0; j < 4; ++j) { v[j] = ((const f32x4*)xr)[C.lane + 64 * j]; ss += v[j].x * v[j].x + v[j].y * v[j].y + v[j].z * v[j].z + v[j].w * v[j].w; }
        ss = ar64(ss); const float rstd = rsqrtf(ss * (1.f / 1024.f) + EPS);
#pragma unroll
        for (int j = 0; j < 4; ++j) { const int idx = (C.lane + 64 * j) * 4;
            const f32x4 w = *(const f32x4*)(nw + idx), sh = *(const f32x4*)(md + idx), sc = *(const f32x4*)(md + 1024 + idx);
            const f32x4 h = v[j] * rstd * w * (sc + 1.f) + sh; u32x2 o; o.x = pk2(h.x, h.y); o.y = pk2(h.z, h.w);
            *(u32x2*)(hb + (size_t)tok * 1024 + idx) = o; }
    }
}

template <int S0, int NS> __device__ __forceinline__ void prep_even_rows(KP P, const Ctx& C, int i, int tok0, int t0) {
    const bf16_t* proj = WSP(bf16_t, WS_PROJ); const float* G = WSP(float, WS_GATES); float* GA = WSP(float, WS_GA); float* GB = WSP(float, WS_GB);
    bf16_t* ab = DOP(bf16_t, DO_ABUF); const float* cw = P->in[16]; const int lane = C.lane;
    f32x4 w[NS][4][2];
#pragma unroll
    for (int s = 0; s < NS; ++s)
#pragma unroll
        for (int j = 0; j < 4; ++j) { const float* wp = cw + j * 3072 + (S0 + s) * 1024 + i * 512 + lane * 8; w[s][j][0] = *(const f32x4*)wp; w[s][j][1] = *(const f32x4*)(wp + 4); }
    u32x4 win[NS][4];
#pragma unroll
    for (int s = 0; s < NS; ++s)
#pragma unroll
        for (int j = 0; j < 3; ++j) { u32x4 rr = {0u, 0u, 0u, 0u};
            if (t0 != 0) rr = *(const u32x4*)(proj + (size_t)(tok0 + j - 3) * PE_MAIN + (S0 + s) * 1024 + i * 512 + lane * 8);
            win[s][j] = rr; }
    u32x4 nxt[NS], nx2[NS];
#pragma unroll
    for (int s = 0; s < NS; ++s) { nxt[s] = *(const u32x4*)(proj + (size_t)tok0 * PE_MAIN + (S0 + s) * 1024 + i * 512 + lane * 8);
        nx2[s] = *(const u32x4*)(proj + (size_t)(tok0 + 1) * PE_MAIN + (S0 + s) * 1024 + i * 512 + lane * 8); }
#pragma unroll 1
    for (int tt = 0; tt < 16; ++tt) { const int tu = 0, tok = tok0 + tt, t = t0 + tt;
#pragma unroll
        for (int s = 0; s < NS; ++s) { if (tt > 0) { win[s][0] = win[s][1]; win[s][1] = win[s][2]; win[s][2] = win[s][3]; }
            win[s][3] = nxt[s]; nxt[s] = nx2[s];
            nx2[s] = *(const u32x4*)(proj + (size_t)(tok + 2) * PE_MAIN + (S0 + s) * 1024 + i * 512 + lane * 8); }
        if (S0 == 0 && i == 0 && lane < 8) { const int h = lane; const float* g = G + (size_t)tok * 32;
            const float beta = sigmoidf_(g[h]); const float a = expf(-expf(P->in[17][h]) * softplusf_(g[8 + h] + P->in[18][h]));
            GA[(size_t)tok * 32 + h * 4] = a; GA[(size_t)tok * 32 + h * 4 + 1] = beta;
            const float ig = g[16 + h] + P->in[20][h], fg = g[24 + h] + P->in[20][8 + h];
            GB[(size_t)tok * 32 + h * 4] = ig; GB[(size_t)tok * 32 + h * 4 + 1] = -softplusf_(-fg); }
        float val[NS][8];
#pragma unroll
        for (int s = 0; s < NS; ++s) { float y[8];
#pragma unroll
            for (int e = 0; e < 8; ++e) y[e] = 0.f;
#pragma unroll
            for (int j = 0; j < 4; ++j) { float u[8]; unpack8(win[s][(tu + j) & 3], u);
                const f32x4 w0 = w[s][j][0], w1 = w[s][j][1];
                y[0] += w0.x * u[0]; y[1] += w0.y * u[1]; y[2] += w0.z * u[2]; y[3] += w0.w * u[3];
                y[4] += w1.x * u[4]; y[5] += w1.y * u[5]; y[6] += w1.z * u[6]; y[7] += w1.w * u[7];
                if (j == 3 && t >= 2045) { float* pc = P->out + OUT_PCONV + ((size_t)(tok >> 11) * 3 + (t - 2045)) * 3072 + (S0 + s) * 1024 + i * 512 + lane * 8;
                    *(f32x4*)pc = (f32x4){u[0], u[1], u[2], u[3]}; *(f32x4*)(pc + 4) = (f32x4){u[4], u[5], u[6], u[7]}; } }
#pragma unroll
            for (int e = 0; e < 8; ++e) val[s][e] = siluf_(y[e]); }
        if (S0 == 0) {
            float sq = 0.f, sk = 0.f, d = 0.f;
#pragma unroll
            for (int e = 0; e < 8; ++e) { sq += val[0][e] * val[0][e]; sk += val[NS - 1][e] * val[NS - 1][e]; d += val[0][e] * val[NS - 1][e]; }
            sq = ar16(sq); sk = ar16(sk); d = ar16(d);
            const float rq = rsqrtf(sq + EPS) * 0.08838834764831845f, rk = rsqrtf(sk + EPS);
#pragma unroll
            for (int e = 0; e < 8; ++e) { val[0][e] *= rq; val[NS - 1][e] *= rk; }
            *(u32x4*)(ab + (size_t)tok * 3072 + i * 512 + lane * 8) = pack8(val[0]);
            *(u32x4*)(ab + (size_t)tok * 3072 + 1024 + i * 512 + lane * 8) = pack8(val[NS - 1]);
            if ((lane & 15) == 0) GA[(size_t)tok * 32 + (4 * i + (lane >> 4)) * 4 + 2] = d * rq * rk;
        } else {
            *(u32x4*)(ab + (size_t)tok * 3072 + 2048 + i * 512 + lane * 8) = pack8(val[0]);
        }
    }
}
__device__ __forceinline__ void phase_prep_even_prompt(KP P, const Ctx& C) {
    for (int wi = C.gw; wi < 2048; wi += C.ngw) {
        const int i = wi & 1, tok0 = (wi >> 1) * 16, t0 = tok0 & 2047;
        prep_even_rows<0, 2>(P, C, i, tok0, t0);
        prep_even_rows<2, 1>(P, C, i, tok0, t0);
    }
}
__device__ __forceinline__ void phase_prep_even(KP P, const Ctx& C) {
    const bf16_t* proj = WSP(bf16_t, WS_PROJ); const float* G = WSP(float, WS_GATES); float* GA = WSP(float, WS_GA); float* GB = WSP(float, WS_GB);
    bf16_t* ab = DOP(bf16_t, DO_ABUF); const float* cw = P->in[16]; const int lane = C.lane;
    phase_prep_even_prompt(P, C);
    for (int tok = NTP + C.gw; tok < NTOK; tok += C.ngw) {
        const bool isP = tok < NTP; const int t = isP ? (tok & 2047) : 0; const int si = tok - NTP;
        if (lane < 8) { const int h = lane; const float* g = G + (size_t)tok * 32;
            const float beta = sigmoidf_(g[h]); const float a = expf(-expf(P->in[17][h]) * softplusf_(g[8 + h] + P->in[18][h]));
            GA[(size_t)tok * 32 + h * 4] = a; GA[(size_t)tok * 32 + h * 4 + 1] = beta;
            const float ig = g[16 + h] + P->in[20][h], fg = g[24 + h] + P->in[20][8 + h];
            GB[(size_t)tok * 32 + h * 4] = ig; GB[(size_t)tok * 32 + h * 4 + 1] = -softplusf_(-fg); }
#pragma unroll 1
        for (int i = 0; i < 2; ++i) {
            float val[3][8];
            u32x4 raw[3][4];
#pragma unroll
            for (int s = 0; s < 3; ++s)
#pragma unroll
                for (int j = 0; j < 4; ++j) { const int back = 3 - j; const int rowi = (isP && t >= back) ? tok - back : tok;
                    u32x4 rr = *(const u32x4*)(proj + (size_t)rowi * PE_MAIN + s * 1024 + i * 512 + lane * 8);
                    if (t < back) rr = (u32x4){0u, 0u, 0u, 0u};
                    raw[s][j] = rr; }
#pragma unroll
            for (int s = 0; s < 3; ++s) { const int c0 = s * 1024 + i * 512 + lane * 8;
                float y[8];
#pragma unroll
                for (int e = 0; e < 8; ++e) y[e] = 0.f;
#pragma unroll
                for (int j = 0; j < 4; ++j) {
                    const int back = 3 - j; float u[8];
                    if (isP || t >= back) unpack8(raw[s][j], u);
                    else if (!isP) { const float* bp = P->in[5] + ((size_t)si * 3 + (t + j)) * 3072 + c0; const f32x4 b0 = *(const f32x4*)bp, b1 = *(const f32x4*)(bp + 4);
                        u[0] = b0.x; u[1] = b0.y; u[2] = b0.z; u[3] = b0.w; u[4] = b1.x; u[5] = b1.y; u[6] = b1.z; u[7] = b1.w; }
                    else {
#pragma unroll
                        for (int e = 0; e < 8; ++e) u[e] = 0.f; }
                    const f32x4 w0 = *(const f32x4*)(cw + j * 3072 + c0), w1 = *(const f32x4*)(cw + j * 3072 + c0 + 4);
                    y[0] += w0.x * u[0]; y[1] += w0.y * u[1]; y[2] += w0.z * u[2]; y[3] += w0.w * u[3];
                    y[4] += w1.x * u[4]; y[5] += w1.y * u[5]; y[6] += w1.z * u[6]; y[7] += w1.w * u[7];
                    if (isP) { if (j == 3 && t >= 2045) { float* pc = P->out + OUT_PCONV + ((size_t)(tok >> 11) * 3 + (t - 2045)) * 3072 + c0;
                            *(f32x4*)pc = (f32x4){u[0], u[1], u[2], u[3]}; *(f32x4*)(pc + 4) = (f32x4){u[4], u[5], u[6], u[7]}; } }
                    else if (j >= 1) { float* sc = P->out + OUT_SCONV + ((size_t)si * 3 + (j - 1)) * 3072 + c0;
                        *(f32x4*)sc = (f32x4){u[0], u[1], u[2], u[3]}; *(f32x4*)(sc + 4) = (f32x4){u[4], u[5], u[6], u[7]}; }
                }
#pragma unroll
                for (int e = 0; e < 8; ++e) val[s][e] = siluf_(y[e]);
            }
            float sq = 0.f, sk = 0.f, d = 0.f;
#pragma unroll
            for (int e = 0; e < 8; ++e) { sq += val[0][e] * val[0][e]; sk += val[1][e] * val[1][e]; d += val[0][e] * val[1][e]; }
            sq = ar16(sq); sk = ar16(sk); d = ar16(d);
            const float rq = rsqrtf(sq + EPS) * 0.08838834764831845f, rk = rsqrtf(sk + EPS);
#pragma unroll
            for (int e = 0; e < 8; ++e) { val[0][e] *= rq; val[1][e] *= rk; }
            *(u32x4*)(ab + (size_t)tok * 3072 + i * 512 + lane * 8) = pack8(val[0]);
            *(u32x4*)(ab + (size_t)tok * 3072 + 1024 + i * 512 + lane * 8) = pack8(val[1]);
            *(u32x4*)(ab + (size_t)tok * 3072 + 2048 + i * 512 + lane * 8) = pack8(val[2]);
            if ((lane & 15) == 0) GA[(size_t)tok * 32 + (4 * i + (lane >> 4)) * 4 + 2] = d * rq * rk;
        }
    }
}

template <int NLANES> __device__ __forceinline__ float arN(float x) { return NLANES == 16 ? ar16(x) : (NLANES == 8 ? ar8(x) : ar4(x)); }
template <int MODE, int DKL, int DR> __device__ __forceinline__ void rec_item(KP P, int item, int lane) {
    constexpr int DK = (MODE == 1 || MODE == 4) ? 64 : 128;
    constexpr int NL = DK / DKL;
    constexpr int CW = (64 / NL) * 2;
    constexpr int DV = (MODE == 0 || MODE == 1) ? 128 : (MODE == 4 ? CW : 256);
    constexpr int NCB = DV / CW;
    constexpr int NH = (MODE >= 2 && MODE <= 3) ? 4 : 8;
    constexpr int LD = MODE == 0 ? 3072 : ((MODE == 1 || MODE == 4) ? PE_MAIN : PO_MAIN);
    const int bh = item / NCB, cb = item % NCB, b = bh / NH, h = bh % NH;
    const int r = lane & (NL - 1), dv = cb * CW + (lane / NL) * 2;
    const bf16_t* src = (MODE == 0 ? DOP(bf16_t, DO_ABUF) : WSP(bf16_t, WS_PROJ)) + (size_t)b * TSEQ * LD;
    const int ko = (MODE == 0 ? 1024 + h * 128 : (MODE == 1 || MODE == 4) ? E_KB + h * 64 : MODE == 2 ? O_KC + h * 128 : O_KD + h * 128) + r * DKL;
    const int qo = (MODE == 0 ? h * 128 : (MODE == 1 || MODE == 4) ? E_QB + h * 64 : MODE == 2 ? O_QC + h * 128 : O_QD + h * 128) + r * DKL;
    const int vo = (MODE == 0 ? 2048 + h * 128 : MODE == 1 ? E_VB + h * 128 : MODE == 2 ? O_VC + h * 256 : O_VD + h * 256) + dv;
    float* gsrc = (MODE == 0 ? WSP(float, WS_GA) : WSP(float, WS_GB)) + (size_t)b * TSEQ * 32 + h * 4;
    const float* asrc = WSP(float, WS_ALPHA) + (size_t)b * TSEQ * 512 + h * 128 + r * DKL;
    bf16_t* yb = WSP(bf16_t, WS_Y) + (size_t)b * TSEQ * 2048 + (MODE == 0 ? h * 128 : MODE == 1 ? 1024 + h * 128 : MODE == 2 ? h * 256 : 1024 + h * 256) + dv;
    const float gam = 1.f - exp2f(-5.f - (float)h);
    struct TokIn { u32x4 k0, k1, q0, q1; unsigned v; f32x4 g; f32x4 a0, a1, a2, a3; };
    f32x2 S[DKL];
#pragma unroll
    for (int i = 0; i < DKL; ++i) S[i] = (f32x2){0.f, 0.f};
    float m = 0.f, A = 1.f;
    auto load = [&](TokIn& x, int t) {
        const int tt = t;
        const bf16_t* p = src + (size_t)tt * LD;
        x.k0 = *(const u32x4*)(p + ko); x.q0 = *(const u32x4*)(p + qo);
        if (DKL == 16) { x.k1 = *(const u32x4*)(p + ko + 8); x.q1 = *(const u32x4*)(p + qo + 8); }
        if (MODE != 4) x.v = *(const unsigned*)(p + vo);
        if (MODE == 0) { const f32x3 g3 = *(const f32x3*)(gsrc + (size_t)tt * 32); x.g.x = g3.x; x.g.y = g3.y; x.g.z = g3.z; }
        if (MODE == 1 || MODE == 4) { const f32x2 g2 = *(const f32x2*)(gsrc + (size_t)tt * 32); x.g.x = g2.x; x.g.y = g2.y; }
        if (MODE == 2) { const float* ap = asrc + (size_t)tt * 512; x.a0 = *(const f32x4*)ap; x.a1 = *(const f32x4*)(ap + 4);
            if (DKL == 16) { x.a2 = *(const f32x4*)(ap + 8); x.a3 = *(const f32x4*)(ap + 12); } }
    };
    auto step = [&](const TokIn& x, int t) {
        float k[16], q[16]; unpack8(x.k0, k); unpack8(x.q0, q);
        if (DKL == 16) { unpack8(x.k1, k + 8); unpack8(x.q1, q + 8); }
        f32x2 v = {1.f, 1.f};
        if (MODE != 4) v = (f32x2){bflo(x.v), bfhi(x.v)};
        f32x2 o = {0.f, 0.f};
        if (MODE == 0) {
            const float a = x.g.x, be = x.g.y, qk = x.g.z;
            f32x2 pka[4], pqa[4];
#pragma unroll
            for (int i = 0; i < 4; ++i) { pka[i] = S[i] * k[i]; pqa[i] = S[i] * q[i]; }
#pragma unroll
            for (int i = 4; i < DKL; ++i) { pka[i & 3] += S[i] * k[i]; pqa[i & 3] += S[i] * q[i]; }
            f32x2 pk = (pka[0] + pka[1]) + (pka[2] + pka[3]), pq = (pqa[0] + pqa[1]) + (pqa[2] + pqa[3]);
            { float p0 = pk.x, p1 = pk.y, p2 = pq.x, p3 = pq.y;
              if (NL == 8) ar8x4(p0, p1, p2, p3); else if (NL == 16) ar16x4(p0, p1, p2, p3); else { p0 = arN<NL>(p0); p1 = arN<NL>(p1); p2 = arN<NL>(p2); p3 = arN<NL>(p3); }
              pk = (f32x2){p0, p1}; pq = (f32x2){p2, p3}; }
            float An = a * A;
            const f32x2 u = (v - pk * An) * be;
            o = pq * An + u * qk;
            if (An < 1e-12f) {
#pragma unroll
                for (int i = 0; i < DKL; ++i) S[i] = S[i] * An;
                An = 1.f; }
            const f32x2 uh = u * __builtin_amdgcn_rcpf(An);
#pragma unroll
            for (int i = 0; i < DKL; ++i) S[i] = S[i] + uh * k[i];
            A = An;
        } else if (MODE == 1 || MODE == 4) {
            const float ig = x.g.x, lf = x.g.y;
            const float mn = fmaxf(lf + m, ig); const float dec = __expf(lf + m - mn), isc = __expf(ig - mn) * 0.125f; m = mn;
            const f32x2 u = v * isc;
            f32x2 oa[4] = {o, o, o, o};
#pragma unroll
            for (int i = 0; i < DKL; ++i) { S[i] = S[i] * dec + u * k[i]; oa[i & 3] += S[i] * q[i]; }
            o = (oa[0] + oa[1]) + (oa[2] + oa[3]);
            o.x = arN<NL>(o.x); if (MODE == 1) o.y = arN<NL>(o.y);
        } else if (MODE == 2) {
            const float al[16] = {x.a0.x, x.a0.y, x.a0.z, x.a0.w, x.a1.x, x.a1.y, x.a1.z, x.a1.w, x.a2.x, x.a2.y, x.a2.z, x.a2.w, x.a3.x, x.a3.y, x.a3.z, x.a3.w};
            f32x2 oa[4] = {o, o, o, o};
#pragma unroll
            for (int i = 0; i < DKL; ++i) { S[i] = S[i] * al[i] + v * k[i]; oa[i & 3] += S[i] * q[i]; }
            o = (oa[0] + oa[1]) + (oa[2] + oa[3]);
            if (NL == 16) { float p0 = o.x, p1 = o.y; ar16x2(p0, p1); o = (f32x2){p0, p1}; } else { o.x = arN<NL>(o.x); o.y = arN<NL>(o.y); }
            o *= 0.08838834764831845f;
        } else {
            f32x2 oa[4] = {o, o, o, o};
#pragma unroll
            for (int i = 0; i < DKL; ++i) { S[i] = S[i] * gam + v * k[i]; oa[i & 3] += S[i] * q[i]; }
            o = (oa[0] + oa[1]) + (oa[2] + oa[3]);
            if (NL == 16) { float p0 = o.x, p1 = o.y; ar16x2(p0, p1); o = (f32x2){p0, p1}; } else { o.x = arN<NL>(o.x); o.y = arN<NL>(o.y); }
        }
        if (MODE == 4) { if (lane == 0) gsrc[(size_t)t * 32 + 2] = __builtin_amdgcn_rcpf(fmaxf(fabsf(o.x), __expf(-m))); }
        else if (r == 0) *(unsigned*)(yb + (size_t)t * 2048) = pk2(o.x, o.y);
    };
    TokIn X[DR];
#pragma unroll
    for (int d = 0; d < DR; ++d) load(X[d], d);
    for (int t0 = 0; t0 < TSEQ; t0 += DR) {
#pragma unroll
        for (int d = 0; d < DR; ++d) { const int t = t0 + d;
            if (t < TSEQ) step(X[d], t);
            load(X[d], t + DR); }
    }
    if (MODE == 4) {
        if (lane < NL) {
#pragma unroll
            for (int i = 0; i < DKL; ++i) P->out[OUT_PMN + (size_t)bh * 64 + r * DKL + i] = S[i].x; }
        if (lane == 0) P->out[OUT_PMM + bh] = m;
    } else {
        float* ps = P->out + (MODE == 0 ? OUT_PGDN : MODE == 1 ? OUT_PMC : MODE == 2 ? OUT_PGLA : OUT_PRET) + (size_t)bh * DK * DV;
#pragma unroll
        for (int i = 0; i < DKL; ++i) *(f32x2*)(ps + (size_t)(r * DKL + i) * DV + dv) = (MODE == 0) ? S[i] * A : S[i];
    }
}

__device__ __forceinline__ void gdn_sample_item(KP P, int idx, int lane) {
    const int si = idx >> 3, h = idx & 7, tok = NTP + si;
    const float* Sin = P->in[4] + (size_t)idx * 128 * 128; float* Sout = P->out + OUT_SGDN + (size_t)idx * 128 * 128;
    const bf16_t* ab = DOP(bf16_t, DO_ABUF) + (size_t)tok * 3072 + h * 128;
    const float* ga = WSP(float, WS_GA) + (size_t)tok * 32;
    const unsigned kpk = *(const unsigned*)(ab + 1024 + 2 * lane), qpk = *(const unsigned*)(ab + 2 * lane), vpk = *(const unsigned*)(ab + 2048 + 2 * lane);
    const float a = ga[h * 4], be = ga[h * 4 + 1], qk = ga[h * 4 + 2];
    f32x2 pk = {0.f, 0.f}, pq = {0.f, 0.f};
#pragma unroll 8
    for (int d2 = 0; d2 < 64; ++d2) { const unsigned ku = rdlu(kpk, d2), qu = rdlu(qpk, d2);
        const f32x2 s0 = *(const f32x2*)(Sin + (size_t)(2 * d2) * 128 + 2 * lane), s1 = *(const f32x2*)(Sin + (size_t)(2 * d2 + 1) * 128 + 2 * lane);
        pk += s0 * bflo(ku) + s1 * bfhi(ku); pq += s0 * bflo(qu) + s1 * bfhi(qu); }
    const f32x2 v = {bflo(vpk), bfhi(vpk)};
    const f32x2 u = (v - pk * a) * be; const f32x2 o = pq * a + u * qk;
#pragma unroll 8
    for (int d2 = 0; d2 < 64; ++d2) { const unsigned ku = rdlu(kpk, d2);
        const f32x2 s0 = *(const f32x2*)(Sin + (size_t)(2 * d2) * 128 + 2 * lane), s1 = *(const f32x2*)(Sin + (size_t)(2 * d2 + 1) * 128 + 2 * lane);
        *(f32x2*)(Sout + (size_t)(2 * d2) * 128 + 2 * lane) = s0 * a + u * bflo(ku);
        *(f32x2*)(Sout + (size_t)(2 * d2 + 1) * 128 + 2 * lane) = s1 * a + u * bfhi(ku); }
    *(unsigned*)(WSP(bf16_t, WS_Y) + (size_t)tok * 2048 + h * 128 + 2 * lane) = pk2(o.x, o.y);
}

__device__ __forceinline__ void mlstm_sample_item(KP P, int idx, int lane) {
    const int si = idx >> 3, h = idx & 7, tok = NTP + si;
    const float* Cin = P->in[6] + (size_t)idx * 64 * 128; float* Cout = P->out + OUT_SMC + (size_t)idx * 64 * 128;
    const bf16_t* pr = WSP(bf16_t, WS_PROJ) + (size_t)tok * PE_MAIN;
    float* gb = WSP(float, WS_GB) + (size_t)tok * 32;
    const float m0 = P->in[8][idx], ig = gb[h * 4], lf = gb[h * 4 + 1];
    const float mn = fmaxf(lf + m0, ig); const float dec = expf(lf + m0 - mn), isc = expf(ig - mn) * 0.125f;
    const unsigned kpk = *(const unsigned*)(pr + E_KB + h * 64 + 2 * (lane & 31)), qpk = *(const unsigned*)(pr + E_QB + h * 64 + 2 * (lane & 31));
    const unsigned vpk = *(const unsigned*)(pr + E_VB + h * 128 + 2 * lane);
    const f32x2 uv = (f32x2){bflo(vpk), bfhi(vpk)} * isc;
    f32x2 num = {0.f, 0.f};
#pragma unroll 8
    for (int d2 = 0; d2 < 32; ++d2) { const unsigned ku = rdlu(kpk, d2), qu = rdlu(qpk, d2);
        const f32x2 s0 = *(const f32x2*)(Cin + (size_t)(2 * d2) * 128 + 2 * lane), s1 = *(const f32x2*)(Cin + (size_t)(2 * d2 + 1) * 128 + 2 * lane);
        const f32x2 n0 = s0 * dec + uv * bflo(ku), n1 = s1 * dec + uv * bfhi(ku);
        *(f32x2*)(Cout + (size_t)(2 * d2) * 128 + 2 * lane) = n0; *(f32x2*)(Cout + (size_t)(2 * d2 + 1) * 128 + 2 * lane) = n1;
        num += n0 * bflo(qu) + n1 * bfhi(qu); }
    const float kl = bf1(pr[E_KB + h * 64 + lane]), ql = bf1(pr[E_QB + h * 64 + lane]);
    const float nl = dec * P->in[7][(size_t)idx * 64 + lane] + isc * kl;
    const float den = ar64(nl * ql);
    P->out[OUT_SMN + (size_t)idx * 64 + lane] = nl;
    if (lane == 0) { P->out[OUT_SMM + idx] = mn; gb[h * 4 + 2] = 1.f / fmaxf(fabsf(den), expf(-mn)); }
    *(unsigned*)(WSP(bf16_t, WS_Y) + (size_t)tok * 2048 + 1024 + h * 128 + 2 * lane) = pk2(num.x, num.y);
}

__device__ __forceinline__ void phase_rec_even(KP P, const Ctx& C) {
    const int lane = C.lane;
    { const int slot = C.bid * 4 + (C.wave & 3), nslot = C.nblk * 4;
        if (C.wave < 4) { for (int g = slot; g < 1024; g += nslot) rec_item<0, 8, 8>(P, g, lane); }
        else { for (int q = slot; q < 576; q += nslot) { if (q < 512) rec_item<1, 8, 8>(P, q, lane); else rec_item<4, 8, 8>(P, q - 512, lane); } } }
    unsigned* ctr = WSP(unsigned, WS_CTL);
    for (;;) {
        int idx = 0; if (lane == 0) idx = (int)atomicAdd(ctr, 1u);
        idx = __builtin_amdgcn_readfirstlane(idx);
        if (idx >= 2048) break;
        if (idx < 1024) gdn_sample_item(P, idx, lane); else mlstm_sample_item(P, idx - 1024, lane);
    }
}

__device__ __forceinline__ void phase_post_even(KP P, const Ctx& C) {
    bf16_t* Y = WSP(bf16_t, WS_Y); const bf16_t* proj = WSP(bf16_t, WS_PROJ); const float* GB = WSP(float, WS_GB); const int lane = C.lane;
    for (int tok = C.gw; tok < NTOK; tok += C.ngw) {
#pragma unroll
        for (int i = 0; i < 4; ++i) { const int ch0 = i * 512 + lane * 8; float o[8], z[8], y[8];
            unpack8(*(const u32x4*)(Y + (size_t)tok * 2048 + ch0), o); unpack8(*(const u32x4*)(proj + (size_t)tok * PE_MAIN + E_Z + ch0), z);
            if (i < 2) { float ss = 0.f;
#pragma unroll
                for (int e = 0; e < 8; ++e) ss += o[e] * o[e];
                ss = ar16(ss); const float rs = rsqrtf(ss * (1.f / 128.f) + EPS); const float* w = P->in[19] + (ch0 & 127);
#pragma unroll
                for (int e = 0; e < 8; ++e) y[e] = o[e] * rs * w[e] * siluf_(z[e]);
            } else { const int hh = (ch0 - 1024) >> 7; const float dn = GB[(size_t)tok * 32 + hh * 4 + 2]; float ss = 0.f; float op[8];
                unpack8(*(const u32x4*)(proj + (size_t)tok * PE_MAIN + E_OP + ch0 - 1024), op);
#pragma unroll
                for (int e = 0; e < 8; ++e) { o[e] *= dn; ss += o[e] * o[e]; }
                ss = ar16(ss); const float rs = rsqrtf(ss * (1.f / 128.f) + EPS); const float* w = P->in[21] + (ch0 & 127);
#pragma unroll
                for (int e = 0; e < 8; ++e) y[e] = sigmoidf_(op[e]) * o[e] * rs * w[e] * siluf_(z[e]);
            }
            *(u32x4*)(Y + (size_t)tok * 2048 + ch0) = pack8(y);
        }
    }
}

__device__ __forceinline__ void phase_prep_odd(KP P, const Ctx& C) {
    bf16_t* proj = WSP(bf16_t, WS_PROJ); const float* G = WSP(float, WS_GATES); float* AL = WSP(float, WS_ALPHA); const f32x2* rope = WSP(f32x2, WS_ROPE);
    const float* w2 = P->in[24]; const float* b2 = P->in[25]; const int lane = C.lane;
    for (int job = C.gw; job < (NTOK / 16) * 2; job += C.ngw) {
        const int half = job & 1, tok0 = (job >> 1) * 16, ch = half * 256 + lane * 4;
        f32x4 w[16];
#pragma unroll
        for (int r = 0; r < 16; ++r) w[r] = *(const f32x4*)(w2 + r * 512 + ch);
        const f32x4 bb = *(const f32x4*)(b2 + ch);
#pragma unroll 4
        for (int tt = 0; tt < 16; ++tt) { const int tok = tok0 + tt;
            f32x4 x = bb;
#pragma unroll
            for (int r4 = 0; r4 < 4; ++r4) { const f32x4 gv = *(const f32x4*)(G + (size_t)tok * 16 + r4 * 4);
                x += w[r4 * 4] * gv.x + w[r4 * 4 + 1] * gv.y + w[r4 * 4 + 2] * gv.z + w[r4 * 4 + 3] * gv.w; }
            f32x4 al; al.x = gla_alpha_(x.x); al.y = gla_alpha_(x.y); al.z = gla_alpha_(x.z); al.w = gla_alpha_(x.w);
            *(f32x4*)(AL + (size_t)tok * 512 + ch) = al; }
    }
    for (int tok = C.gw; tok < NTOK; tok += C.ngw) {
        const bool isP = tok < NTP; const int t = isP ? (tok & 2047) : 2048;
        const f32x2 cs = rope[t * 64 + lane];
        bf16_t* pr = proj + (size_t)tok * PO_MAIN;
#pragma unroll
        for (int h = 0; h < 4; ++h) {
            { bf16_t* q = pr + O_QD + h * 128; const float x1 = bf1(q[lane]), x2 = bf1(q[64 + lane]);
              const unsigned o = pk2(x1 * cs.x - x2 * cs.y, x1 * cs.y + x2 * cs.x); q[lane] = (bf16_t)(o & 0xffffu); q[64 + lane] = (bf16_t)(o >> 16); }
            { bf16_t* k = pr + O_KD + h * 128; const float x1 = bf1(k[lane]) * 0.08838834764831845f, x2 = bf1(k[64 + lane]) * 0.08838834764831845f;
              const unsigned o = pk2(x1 * cs.x - x2 * cs.y, x1 * cs.y + x2 * cs.x); k[lane] = (bf16_t)(o & 0xffffu); k[64 + lane] = (bf16_t)(o >> 16); }
        }
    }
}

template <bool GLA> __device__ __forceinline__ void odd_sample_item(KP P, int idx, int lane) {
    const int si = idx >> 2, h = idx & 3, tok = NTP + si;
    const float* Sin = P->in[GLA ? 9 : 10] + (size_t)idx * 128 * 256; float* Sout = P->out + (GLA ? OUT_SGLA : OUT_SRET) + (size_t)idx * 128 * 256;
    const bf16_t* pr = WSP(bf16_t, WS_PROJ) + (size_t)tok * PO_MAIN;
    const unsigned kpk = *(const unsigned*)(pr + (GLA ? O_KC : O_KD) + h * 128 + 2 * lane), qpk = *(const unsigned*)(pr + (GLA ? O_QC : O_QD) + h * 128 + 2 * lane);
    const u32x2 vpk = *(const u32x2*)(pr + (GLA ? O_VC : O_VD) + h * 256 + 4 * lane);
    const f32x4 v = {bflo(vpk.x), bfhi(vpk.x), bflo(vpk.y), bfhi(vpk.y)};
    const float gam = 1.f - exp2f(-5.f - (float)h);
    f32x2 alp = {gam, gam};
    if (GLA) alp = *(const f32x2*)(WSP(float, WS_ALPHA) + (size_t)tok * 512 + h * 128 + 2 * lane);
    f32x4 o = {0.f, 0.f, 0.f, 0.f};
#pragma unroll 8
    for (int d2 = 0; d2 < 64; ++d2) { const unsigned ku = rdlu(kpk, d2), qu = rdlu(qpk, d2); const float a0 = rdl(alp.x, d2), a1 = rdl(alp.y, d2);
        const f32x4 s0 = *(const f32x4*)(Sin + (size_t)(2 * d2) * 256 + 4 * lane), s1 = *(const f32x4*)(Sin + (size_t)(2 * d2 + 1) * 256 + 4 * lane);
        const f32x4 n0 = s0 * a0 + v * bflo(ku), n1 = s1 * a1 + v * bfhi(ku);
        *(f32x4*)(Sout + (size_t)(2 * d2) * 256 + 4 * lane) = n0; *(f32x4*)(Sout + (size_t)(2 * d2 + 1) * 256 + 4 * lane) = n1;
        o += n0 * bflo(qu) + n1 * bfhi(qu); }
    if (GLA) o *= 0.08838834764831845f;
    u32x2 op; op.x = pk2(o.x, o.y); op.y = pk2(o.z, o.w);
    *(u32x2*)(WSP(bf16_t, WS_Y) + (size_t)tok * 2048 + (GLA ? 0 : 1024) + h * 256 + 4 * lane) = op;
}

__device__ __forceinline__ void phase_rec_odd(KP P, const Ctx& C) {
    const int lane = C.lane;
    { const int slot = C.bid * 4 + (C.wave & 3), nslot = C.nblk * 4;
        if (C.wave < 4) { for (int g = slot; g < 1024; g += nslot) rec_item<2, 8, 8>(P, g, lane); }
        else { for (int g = slot; g < 1024; g += nslot) rec_item<3, 8, 8>(P, g, lane); } }
    unsigned* ctr = WSP(unsigned, WS_CTL) + 64;
    for (;;) {
        int idx = 0; if (lane == 0) idx = (int)atomicAdd(ctr, 1u);
        idx = __builtin_amdgcn_readfirstlane(idx);
        if (idx >= 1024) break;
        if (idx < 512) odd_sample_item<true>(P, idx, lane); else odd_sample_item<false>(P, idx - 512, lane);
    }
}

__device__ __forceinline__ void phase_post_odd(KP P, const Ctx& C) {
    bf16_t* Y = WSP(bf16_t, WS_Y); const bf16_t* proj = WSP(bf16_t, WS_PROJ); const int lane = C.lane;
    for (int tok = C.gw; tok < NTOK; tok += C.ngw) {
#pragma unroll
        for (int i = 0; i < 4; ++i) { const int ch0 = i * 512 + lane * 8; float o[8], z[8], y[8];
            unpack8(*(const u32x4*)(Y + (size_t)tok * 2048 + ch0), o); unpack8(*(const u32x4*)(proj + (size_t)tok * PO_MAIN + O_Z + ch0), z);
            float ss = 0.f;
#pragma unroll
            for (int e = 0; e < 8; ++e) ss += o[e] * o[e];
            ss = ar32(ss); const float rs = rsqrtf(ss * (1.f / 256.f) + EPS); const float* w = P->in[i < 2 ? 26 : 27] + (ch0 & 255);
#pragma unroll
            for (int e = 0; e < 8; ++e) y[e] = o[e] * rs * w[e] * siluf_(z[e]);
            *(u32x4*)(Y + (size_t)tok * 2048 + ch0) = pack8(y);
        }
    }
}

__device__ __forceinline__ void phase_final(KP P, const Ctx& C) {
    const float* fw = P->in[28];
    for (int tok = C.gw; tok < NTOK; tok += C.ngw) {
        float* xr = P->out + (size_t)tok * DM; f32x4 v[4]; float ss = 0.f;
#pragma unroll
        for (int j = 0; j < 4; ++j) { v[j] = ((const f32x4*)xr)[C.lane + 64 * j]; ss += v[j].x * v[j].x + v[j].y * v[j].y + v[j].z * v[j].z + v[j].w * v[j].w; }
        ss = ar64(ss); const float rstd = rsqrtf(ss * (1.f / 1024.f) + EPS);
#pragma unroll
        for (int j = 0; j < 4; ++j) { const int idx = (C.lane + 64 * j) * 4; ((f32x4*)xr)[C.lane + 64 * j] = v[j] * rstd * *(const f32x4*)(fw + idx); }
    }
}

__device__ __forceinline__ void sample_outproj(KP P, const Ctx& C, int layer) {
    const bf16_t* Y = WSP(bf16_t, WS_Y) + (size_t)NTP * 2048; const bf16_t* W = WSP(bf16_t, layer == 0 ? WS_WOUT0 : WS_WOUT1);
    const float* mod = WSP(float, WS_MOD); LAS float* red = (LAS float*)C.lds;
    const int lane = C.lane, w = C.wave;
    for (int task = C.bid; task < 256; task += C.nblk) {
        const int r0 = (task >> 5) * 16, c0 = (task & 31) * 32;
        f32x4 acc0 = {0.f, 0.f, 0.f, 0.f}, acc1 = acc0;
        const bf16_t* ap = Y + (size_t)(r0 + (lane & 15)) * 2048 + w * 256 + (lane >> 4) * 8;
        const bf16_t* bp0 = W + (size_t)(c0 + (lane & 15)) * 2048 + w * 256 + (lane >> 4) * 8; const bf16_t* bp1 = bp0 + (size_t)16 * 2048;
#pragma unroll
        for (int ks = 0; ks < 8; ++ks) { const bf16x8 a = *(const bf16x8*)(ap + ks * 32), b0 = *(const bf16x8*)(bp0 + ks * 32), b1 = *(const bf16x8*)(bp1 + ks * 32);
            acc0 = __builtin_amdgcn_mfma_f32_16x16x32_bf16(a, b0, acc0, 0, 0, 0); acc1 = __builtin_amdgcn_mfma_f32_16x16x32_bf16(a, b1, acc1, 0, 0, 0); }
        __syncthreads();
        *(LAS f32x4*)(red + ((w * 2 + 0) * 64 + lane) * 4) = acc0; *(LAS f32x4*)(red + ((w * 2 + 1) * 64 + lane) * 4) = acc1;
        __syncthreads();
        { const int e = C.tid, tile = e >> 8, idx = e & 255, ln = idx >> 2, j = idx & 3; float sum = 0.f;
#pragma unroll
          for (int ww = 0; ww < 8; ++ww) sum += red[((ww * 2 + tile) * 64 + ln) * 4 + j];
          const int row = r0 + (ln >> 4) * 4 + j, col = c0 + tile * 16 + (ln & 15);
          const float xin = layer == 0 ? P->in[1][(size_t)row * DM + col] : P->out[(size_t)(NTP + row) * DM + col];
          const float gt = mod[(size_t)(8 + row) * 6144 + layer * 3072 + 2048 + col];
          P->out[(size_t)(NTP + row) * DM + col] = xin + gt * sum; }
    }
    __syncthreads();
}

#define XB_XCNT(j)  (256  + 64 * (j))
#define XB_XSUB(j)  (1280 + 64 * (j))
#define XB_XGEN(j)  (2304 + 64 * (j))
#define XB_TOP      3328
#define XB_TOPGEN   3392
__device__ __forceinline__ unsigned xb_ld(unsigned* p) { return __hip_atomic_load(p, __ATOMIC_RELAXED, __HIP_MEMORY_SCOPE_AGENT); }
__device__ __forceinline__ unsigned xb_add(unsigned* p, unsigned v) { return __hip_atomic_fetch_add(p, v, __ATOMIC_RELAXED, __HIP_MEMORY_SCOPE_AGENT); }
__device__ __forceinline__ unsigned xb_xcc_id() { return (unsigned)__builtin_amdgcn_s_getreg((3 << 11) | 20) & 0xFu; }
__device__ __forceinline__ void xcd_bar(unsigned* bar, volatile unsigned* st) {
    asm volatile("s_waitcnt vmcnt(0)" ::: "memory");
    __syncthreads();
    if (threadIdx.x == 0) {
        __builtin_amdgcn_s_waitcnt(0);
        const unsigned x = xb_xcc_id();
        unsigned nloc = st[0], nx = st[1];
        if (nloc == 0u) {
            unsigned cnt, mine, sum;
            for (;;) { cnt = 0u; mine = 0u; sum = 0u;
#pragma unroll
                for (unsigned j = 0; j < 16; ++j) { const unsigned c = xb_ld(&bar[XB_XCNT(j)]); sum += c; cnt += (c > 0u) ? 1u : 0u; mine = (j == x) ? c : mine; }
                if (sum == gridDim.x) break;
                __builtin_amdgcn_s_sleep(1); }
            nloc = mine > 0u ? mine : 1u; nx = cnt > 0u ? cnt : 1u; st[0] = nloc; st[1] = nx;
        }
        const unsigned old = xb_add(&bar[XB_XSUB(x)], 1u);
        const unsigned gen = old / nloc;
        if (old + 1u == (gen + 1u) * nloc) {
            __builtin_amdgcn_fence(__ATOMIC_RELEASE, "agent");
            asm volatile("s_waitcnt vmcnt(0)" ::: "memory");
            const unsigned og = xb_add(&bar[XB_TOP], 1u);
            const unsigned tg = og / nx;
            if (og + 1u == (tg + 1u) * nx) xb_add(&bar[XB_TOPGEN], 1u);
            else { while (xb_ld(&bar[XB_TOPGEN]) == tg) __builtin_amdgcn_s_sleep(1); }
            __builtin_amdgcn_fence(__ATOMIC_ACQUIRE, "agent");
            xb_add(&bar[XB_XGEN(x)], 1u);
            asm volatile("s_waitcnt vmcnt(0)" ::: "memory");
        } else {
            while (xb_ld(&bar[XB_XGEN(x)]) == gen) __builtin_amdgcn_s_sleep(1);
            __builtin_amdgcn_fence(__ATOMIC_ACQUIRE, "agent");
            asm volatile("s_waitcnt vmcnt(0)" ::: "memory");
        }
    }
    __syncthreads();
}

#ifndef PH_MASK
#define PH_MASK 0x7fff
#endif
#define PH_ON(n) (((PH_MASK) >> (n)) & 1)
#ifndef PH_REP
#define PH_REP 0
#endif
#define PH_RP(n) (((PH_REP) >> (n)) & 1)
constexpr int NPHASE = 15;
__global__ void __launch_bounds__(512, 2) fwd_megakernel(Params PV) {
    extern __shared__ __attribute__((aligned(16))) unsigned char shm[];
    __shared__ __attribute__((aligned(16))) unsigned xb_st[4];
    Ctx C; C.lds = (LAS unsigned char*)shm;
    if (threadIdx.x == 0) { xb_st[0] = 0u; xb_st[1] = 0u; if (PV.ph_hi - PV.ph_lo > 1) (void)xb_add(((unsigned*)PV.ws) + XB_XCNT(xb_xcc_id()), 1u); }
    __syncthreads();
    for (int ph = PV.ph_lo; ph < PV.ph_hi; ++ph) {
        KP P = (KP)__builtin_amdgcn_kernarg_segment_ptr(); asm volatile("" : "+s"(P));
        { int tid = threadIdx.x; asm volatile("" : "+v"(tid)); int bid = blockIdx.x; asm volatile("" : "+s"(bid)); int nblk = gridDim.x; asm volatile("" : "+s"(nblk));
          C.tid = tid; C.bid = bid; C.nblk = nblk; C.lane = tid & 63; C.wave = __builtin_amdgcn_readfirstlane(tid >> 6); C.gw = bid * 8 + C.wave; C.ngw = nblk * 8; }
        const bool is_gemm = (ph == 1 || ph == 3 || ph == 7 || ph == 9 || ph == 13);
        if (is_gemm && PH_ON(1)) {
            pg8::Gemm g; pg8::Epi E; E.kind = 0; E.mod = WSP(float, WS_MOD); E.ada_b = P->in[12]; E.P = WSP(bf16_t, WS_PROJ); E.ldp = PE_MAIN; E.ntile_main = 32; E.G = WSP(float, WS_GATES); E.ng = 32;
            E.xp = P->in[0]; E.xs = P->in[1]; E.xo = P->out; E.gate = WSP(float, WS_MOD); E.layer = 0;
            if (ph == 1) { g.A = WSP(bf16_t, WS_CBF); g.Bt = WSP(bf16_t, WS_ADAT); g.M = 256; g.N = 6144; g.K = 1024; E.kind = 0; }
            else if (ph == 3) { g.A = DOP(bf16_t, DO_HBUF); g.Bt = WSP(bf16_t, WS_WIN0); g.M = MPAD; g.N = PE_PAD; g.K = 1024; E.kind = 1; }
            else if (ph == 7) { g.A = WSP(bf16_t, WS_Y); g.Bt = WSP(bf16_t, WS_WOUT0); g.M = NTP; g.N = 1024; g.K = 2048; E.kind = 2; E.layer = 0; }
            else if (ph == 9) { g.A = DOP(bf16_t, DO_HBUF); g.Bt = WSP(bf16_t, WS_WIN1); g.M = MPAD; g.N = PO_PAD; g.K = 1024; E.kind = 1; E.ldp = PO_MAIN; E.ntile_main = 24; E.ng = 16; }
            else { g.A = WSP(bf16_t, WS_Y); g.Bt = WSP(bf16_t, WS_WOUT1); g.M = NTP; g.N = 1024; g.K = 2048; E.kind = 2; E.layer = 1; }
            pg8::StaticOrder S; S.init(g.M, g.N, C.nblk, C.bid);
            for (int rep = 0; rep < 1 + PH_RP(ph); ++rep) { asm volatile("" : "+s"(rep)); pg8::gemm_phase(C.lds, g, S, E, C.tid); }
            if (E.kind == 2) sample_outproj(P, C, E.layer);
            if (ph == 1) { if (C.nblk > 24) { if (C.bid >= 24) prep_weights(P, C, (C.bid - 24) * 8 + C.wave, (C.nblk - 24) * 8); } else prep_weights(P, C, C.gw, C.ngw); }
        } else {
            switch (ph) {
                case 0: if (PH_ON(0)) phase_prep0(P, C); if (PH_RP(0)) { asm volatile("" : "+s"(P)); phase_prep0(P, C); } break;
                case 2: if (PH_ON(2)) phase_hnorm(P, C, 0); if (PH_RP(2)) { asm volatile("" : "+s"(P)); phase_hnorm(P, C, 0); } break;
                case 4: if (PH_ON(4)) phase_prep_even(P, C); if (PH_RP(4)) { asm volatile("" : "+s"(P)); phase_prep_even(P, C); } break;
                case 5: if (PH_ON(5)) phase_rec_even(P, C); if (PH_RP(5)) { asm volatile("" : "+s"(P)); phase_rec_even(P, C); } break;
                case 6: if (PH_ON(6)) phase_post_even(P, C); break;
                case 8: if (PH_ON(8)) phase_hnorm(P, C, 1); if (PH_RP(8)) { asm volatile("" : "+s"(P)); phase_hnorm(P, C, 1); } break;
                case 10: if (PH_ON(10)) phase_prep_odd(P, C); break;
                case 11: if (PH_ON(11)) phase_rec_odd(P, C); if (PH_RP(11)) { asm volatile("" : "+s"(P)); phase_rec_odd(P, C); } break;
                case 12: if (PH_ON(12)) phase_post_odd(P, C); break;
                case 14: if (PH_ON(14)) phase_final(P, C); break;
                default: break;
            }
        }
        if (ph + 1 < PV.ph_hi) {
            if (PV.ph_lo > 0 && ph == PV.ph_lo) cg::this_grid().sync();
            else xcd_bar(WSP(unsigned, WS_CTL), xb_st);
        }
    }
}

extern "C" void kernel_launch(void* const* d_in, const int* in_sizes, int n_in, void* d_out, int out_size, void* d_ws, size_t ws_size, hipStream_t stream) {
    constexpr size_t kDynLds = 131072;
    static int grid_blocks = 0;
    if (!grid_blocks) {
        if (n_in != 29 || ws_size < WS_END) { fprintf(stderr, "kernel_launch: unexpected n_in %d or ws_size %zu (need %zu)\n", n_in, ws_size, (size_t)WS_END); }
        int dev = 0, cus = 0, per_cu = 0;
        hipGetDevice(&dev);
        hipDeviceGetAttribute(&cus, hipDeviceAttributeMultiprocessorCount, dev);
        hipFuncSetAttribute((const void*)fwd_megakernel, hipFuncAttributeMaxDynamicSharedMemorySize, (int)kDynLds);
        hipOccupancyMaxActiveBlocksPerMultiprocessor(&per_cu, (const void*)fwd_megakernel, 512, kDynLds);
        if (per_cu < 1) { fprintf(stderr, "kernel_launch: occupancy query says %d blocks/CU\n", per_cu); per_cu = 1; }
        if (per_cu > 1) per_cu = 1;
        grid_blocks = cus * per_cu;
        (void)hipGetLastError();
    }
    hipMemsetAsync((char*)d_ws + WS_CTL, 0, 16384, stream);
    Params p{};
    for (int i = 0; i < 29; ++i) p.in[i] = (const float*)d_in[i];
    p.out = (float*)d_out; p.ws = (unsigned char*)d_ws;
#if MK_SPLIT
    for (int ph = 0; ph < NPHASE; ++ph) { p.ph_lo = ph; p.ph_hi = ph + 1;
        hipLaunchKernelGGL(fwd_megakernel, dim3(grid_blocks), dim3(512), kDynLds, stream, p); }
#else
    p.ph_lo = 0; p.ph_hi = NPHASE;
    void* args[] = {&p};
    hipError_t e = hipLaunchCooperativeKernel((const void*)fwd_megakernel, dim3(grid_blocks), dim3(512), args, kDynLds, stream);
    if (e != hipSuccess) fprintf(stderr, "cooperative launch failed: %s (grid %d)\n", hipGetErrorString(e), grid_blocks);
#endif
}
```
